# Optimizing an MI355X kernel written in HIP

```python
import math
import jax, jax.numpy as jnp
from jax import lax
import numpy as np

D_MODEL = 1024
BATCH = 8
SEQ = 2048
DEPTH = 1
DEC_BATCH = 128
DEC_SEQ = 8
PAST_LEN = 16384
PAGE_SIZE = 128

MIX_WIDTH = 2 * D_MODEL
SC_WIDTH = MIX_WIDTH // 2
SC_GROUPS = 16
SC_CONV_K = 3
SSM_WIDTH = MIX_WIDTH - SC_WIDTH
SSM_HEAD_DIM = 64
SSM_HEADS = SSM_WIDTH // SSM_HEAD_DIM
SSM_GROUPS = 4
SSM_STATE = 128
SSM_CONV_K = 4
SSM_CHUNK = 128
XBC_WIDTH = SSM_WIDTH + 2 * SSM_GROUPS * SSM_STATE
IN_PROJ_WIDTH = 3 * SC_WIDTH + SSM_WIDTH + XBC_WIDTH + SSM_HEADS
FFN_HIDDEN = -(-8 * D_MODEL // (3 * 256)) * 256
EPS = 1e-6

kernel_name = "hymba_shortconv_ssd_sandwich_adaln_step"


def rmsnorm(x, g):
    xf = x.astype(jnp.float32)
    y = xf * lax.rsqrt(jnp.mean(xf * xf, axis=-1, keepdims=True) + EPS)
    return y.astype(x.dtype) * g


def causal_dwconv(u, buf, w, b=None):
    K = w.shape[0]
    L = u.shape[1]
    ext = jnp.concatenate([buf.astype(u.dtype), u], axis=1)
    y = w[0] * ext[:, 0:L]
    for k in range(1, K):
        y = y + w[k] * ext[:, k:k + L]
    if b is not None:
        y = y + b
    return y, ext[:, L:]


def ssd_scan(xs, dt, A, Bm, Cm, d_skip, s0):
    b, L, H, P = xs.shape
    G, N = Bm.shape[2], Bm.shape[3]
    R = H // G
    Q = SSM_CHUNK if L % SSM_CHUNK == 0 else L
    nc = L // Q
    x = xs.astype(jnp.float32).reshape(b, nc, Q, G, R, P)
    dtc = dt.reshape(b, nc, Q, G, R)
    Bc = Bm.astype(jnp.float32).reshape(b, nc, Q, G, N)
    Cc = Cm.astype(jnp.float32).reshape(b, nc, Q, G, N)
    acum = jnp.cumsum(dtc * A.reshape(G, R), axis=2)
    xdt = x * dtc[..., None]
    seg = acum[:, :, :, None] - acum[:, :, None, :]
    causal = jnp.tril(jnp.ones((Q, Q), dtype=bool))[:, :, None, None]
    Lmat = jnp.exp(jnp.where(causal, seg, -jnp.inf))
    cb = jnp.einsum('bclgn,bcsgn->bclsg', Cc, Bc)
    y_diag = jnp.einsum('bclsg,bclsgr,bcsgrp->bclgrp', cb, Lmat, xdt)
    decay_to_end = jnp.exp(acum[:, :, -1:] - acum)
    chunk_states = jnp.einsum('bclgn,bclgr,bclgrp->bcgrpn', Bc, decay_to_end, xdt)
    chunk_decay = jnp.exp(acum[:, :, -1])

    def step(s, inp):
        dec, st = inp
        s_new = s * dec[..., None, None] + st
        return s_new, s

    s_init = s0.astype(jnp.float32).reshape(b, G, R, P, N)
    s_final, prev = lax.scan(step, s_init,
                             (jnp.moveaxis(chunk_decay, 1, 0), jnp.moveaxis(chunk_states, 1, 0)))
    prev = jnp.moveaxis(prev, 0, 1)
    y_off = jnp.einsum('bclgn,bcgrpn,bclgr->bclgrp', Cc, prev, jnp.exp(acum))
    y = y_diag + y_off + x * d_skip.astype(jnp.float32).reshape(G, R)[:, :, None]
    return y.reshape(b, L, H, P), s_final.reshape(b, H, P, N)


def hybrid_layer(x, c, sc_buf, ssm_buf, ssm_state,
                 w_ada, b_ada, g_mix_pre, g_mix_post, g_ffn_pre, g_ffn_post,
                 w_in, sc_conv_w, ssm_conv_w, ssm_conv_b, dt_bias, a_log, d_skip,
                 ssm_norm_g, w_out, w_gate, w_up, w_down):
    bsz, L, _ = x.shape
    mod = jax.nn.silu(c) @ w_ada + b_ada
    shift_m, scale_m, gate_m, shift_f, scale_f, gate_f = [m[:, None, :] for m in jnp.split(mod, 6, axis=-1)]

    h = rmsnorm(x, g_mix_pre) * (1 + scale_m) + shift_m
    proj = h @ w_in
    idx = [SC_WIDTH, 2 * SC_WIDTH, 3 * SC_WIDTH, 3 * SC_WIDTH + SSM_WIDTH,
           3 * SC_WIDTH + SSM_WIDTH + XBC_WIDTH]
    sc_b, sc_c, sc_x, z, xbc, dt_raw = jnp.split(proj, idx, axis=-1)

    u = sc_c * sc_x
    uc, new_sc_buf = causal_dwconv(u, sc_buf, sc_conv_w)
    y_sc = sc_b * uc

    xbc_c, new_ssm_buf = causal_dwconv(xbc, ssm_buf, ssm_conv_w, ssm_conv_b)
    xbc_c = jax.nn.silu(xbc_c)
    xs, Bm, Cm = jnp.split(xbc_c, [SSM_WIDTH, SSM_WIDTH + SSM_GROUPS * SSM_STATE], axis=-1)
    xs = xs.reshape(bsz, L, SSM_HEADS, SSM_HEAD_DIM)
    Bm = Bm.reshape(bsz, L, SSM_GROUPS, SSM_STATE)
    Cm = Cm.reshape(bsz, L, SSM_GROUPS, SSM_STATE)
    dt = jax.nn.softplus(dt_raw.astype(jnp.float32) + dt_bias.astype(jnp.float32))
    A = -jnp.exp(a_log.astype(jnp.float32))
    y_ssd, new_state = ssd_scan(xs, dt, A, Bm, Cm, d_skip, ssm_state)
    y_ssd = y_ssd.reshape(bsz, L, SSM_WIDTH).astype(x.dtype)
    yg = (y_ssd * jax.nn.silu(z)).reshape(bsz, L, SSM_GROUPS, SSM_WIDTH // SSM_GROUPS)
    y_ssd = rmsnorm(yg, 1.0).reshape(bsz, L, SSM_WIDTH) * ssm_norm_g

    mix = jnp.concatenate([y_sc, y_ssd], axis=-1) @ w_out
    x = x + gate_m * rmsnorm(mix, g_mix_post)

    h2 = rmsnorm(x, g_ffn_pre) * (1 + scale_f) + shift_f
    f = (jax.nn.silu(h2 @ w_gate) * (h2 @ w_up)) @ w_down
    x = x + gate_f * rmsnorm(f, g_ffn_post)
    return x, new_sc_buf, new_ssm_buf, new_state.astype(ssm_state.dtype)


def setup_inputs(seed: int = 0) -> dict:
    key = jax.random.key(seed)
    ks = jax.random.split(key, 24)

    def nrm(k, shape, scale):
        return jax.random.normal(k, shape, jnp.float32) * scale

    dt0 = jnp.exp(jax.random.uniform(ks[12], (DEPTH, SSM_HEADS), jnp.float32,
                                     minval=math.log(1e-3), maxval=math.log(1e-1)))
    dt_bias = dt0 + jnp.log(-jnp.expm1(-dt0))
    a_log = jnp.log(jax.random.uniform(ks[13], (DEPTH, SSM_HEADS), jnp.float32, minval=1.0, maxval=16.0))
    return {
        "x_prompt": nrm(ks[0], (BATCH, SEQ, D_MODEL), 1.0),
        "x_sample": nrm(ks[1], (DEC_BATCH, DEC_SEQ, D_MODEL), 1.0),
        "c_prompt": nrm(ks[2], (BATCH, D_MODEL), 1.0),
        "c_sample": nrm(ks[3], (DEC_BATCH, D_MODEL), 1.0),
        "state_sc_conv": nrm(ks[4], (DEPTH, DEC_BATCH, SC_CONV_K - 1, SC_WIDTH), 1.0),
        "state_ssm_conv": nrm(ks[5], (DEPTH, DEC_BATCH, SSM_CONV_K - 1, XBC_WIDTH), 1.0),
        "state_ssm": nrm(ks[6], (DEPTH, DEC_BATCH, SSM_HEADS, SSM_HEAD_DIM, SSM_STATE), 0.1),
        "w_ada": nrm(ks[7], (DEPTH, D_MODEL, 6 * D_MODEL), 0.5 * D_MODEL ** -0.5),
        "b_ada": nrm(ks[8], (DEPTH, 6 * D_MODEL), 0.01),
        "g_mix_pre": 1.0 + nrm(ks[9], (DEPTH, D_MODEL), 0.05),
        "g_mix_post": 1.0 + nrm(ks[10], (DEPTH, D_MODEL), 0.05),
        "g_ffn_pre": 1.0 + nrm(ks[11], (DEPTH, D_MODEL), 0.05),
        "g_ffn_post": 1.0 + nrm(ks[14], (DEPTH, D_MODEL), 0.05),
        "w_in": nrm(ks[15], (DEPTH, D_MODEL, IN_PROJ_WIDTH), D_MODEL ** -0.5),
        "sc_conv_w": nrm(ks[16], (DEPTH, SC_CONV_K, SC_WIDTH), SC_CONV_K ** -0.5),
        "ssm_conv_w": nrm(ks[17], (DEPTH, SSM_CONV_K, XBC_WIDTH), SSM_CONV_K ** -0.5),
        "ssm_conv_b": nrm(ks[18], (DEPTH, XBC_WIDTH), 0.01),
        "dt_bias": dt_bias,
        "a_log": a_log,
        "d_skip": 1.0 + nrm(ks[19], (DEPTH, SSM_HEADS), 0.1),
        "ssm_norm_g": 1.0 + nrm(ks[20], (DEPTH, SSM_WIDTH), 0.05),
        "w_out": nrm(ks[21], (DEPTH, MIX_WIDTH, D_MODEL), MIX_WIDTH ** -0.5),
        "w_gate": nrm(ks[22], (DEPTH, D_MODEL, FFN_HIDDEN), D_MODEL ** -0.5),
        "w_up": nrm(ks[23], (DEPTH, D_MODEL, FFN_HIDDEN), D_MODEL ** -0.5),
        "w_down": nrm(jax.random.fold_in(key, 99), (DEPTH, FFN_HIDDEN, D_MODEL), FFN_HIDDEN ** -0.5),
    }


def reference(x_prompt, x_sample, c_prompt, c_sample, state_sc_conv, state_ssm_conv, state_ssm,
              w_ada, b_ada, g_mix_pre, g_mix_post, g_ffn_pre, g_ffn_post, w_in, sc_conv_w,
              ssm_conv_w, ssm_conv_b, dt_bias, a_log, d_skip, ssm_norm_g, w_out, w_gate, w_up, w_down):
    bp = x_prompt.shape[0]
    dt_ = x_prompt.dtype
    xp, xs = x_prompt, x_sample
    p_sc, p_sconv, p_ssm = [], [], []
    s_sc, s_sconv, s_ssm = [], [], []
    for l in range(DEPTH):
        params = (w_ada[l], b_ada[l], g_mix_pre[l], g_mix_post[l], g_ffn_pre[l], g_ffn_post[l],
                  w_in[l], sc_conv_w[l], ssm_conv_w[l], ssm_conv_b[l], dt_bias[l], a_log[l],
                  d_skip[l], ssm_norm_g[l], w_out[l], w_gate[l], w_up[l], w_down[l])
        xp, nb1, nb2, nst = hybrid_layer(
            xp, c_prompt,
            jnp.zeros((bp, SC_CONV_K - 1, SC_WIDTH), dt_),
            jnp.zeros((bp, SSM_CONV_K - 1, XBC_WIDTH), dt_),
            jnp.zeros((bp, SSM_HEADS, SSM_HEAD_DIM, SSM_STATE), state_ssm.dtype),
            *params)
        p_sc.append(nb1); p_sconv.append(nb2); p_ssm.append(nst)
        xs, mb1, mb2, mst = hybrid_layer(
            xs, c_sample, state_sc_conv[l], state_ssm_conv[l], state_ssm[l], *params)
        s_sc.append(mb1); s_sconv.append(mb2); s_ssm.append(mst)
    return (xp, xs,
            jnp.stack(p_sc), jnp.stack(p_sconv), jnp.stack(p_ssm),
            jnp.stack(s_sc), jnp.stack(s_sconv), jnp.stack(s_ssm))
```

```cpp
#include <hip/hip_runtime.h>
#include <cstdio>
#include <cstdint>
namespace pg8 {
#define PG8_LAS __attribute__((address_space(3)))
typedef unsigned short bf16_t;
typedef short bf16x8 __attribute__((ext_vector_type(8)));
typedef float f32x4 __attribute__((ext_vector_type(4)));
typedef unsigned u32x4 __attribute__((ext_vector_type(4)));
constexpr int BM = 256, BK = 64, HALF = 128, HTB = HALF * BK * 2  , STAGE_BYTES = 8 * HTB, NXCD = 8, WGM = 8;

__host__ __device__ __forceinline__ int lds_byte(int r, int c) { const int st = (r >> 4) * 2 + (c >> 5), rr = r & 15, cc = c & 31, ob = rr * 64 + cc * 2; return st * 1024 + (ob ^ (((ob >> 9) & 1) << 5)); }
__host__ __device__ __forceinline__ void stage_rc(int b, int& R, int& C) { const int st = b / 1024, sb = b % 1024, swz = sb ^ (((sb >> 9) & 1) << 5); R = (st >> 1) * 16 + swz / 64; C = (st & 1) * 32 + (swz % 64) / 2; }
__host__ __device__ __forceinline__ int perm32(int rho) { const int n = rho >> 4, i = rho & 15; return 8 * (i >> 2) + 4 * n + (i & 3); }

struct Unit { int pm, pn; };
struct Gemm { const bf16_t* A; const bf16_t* Bt; int M, N, K, lda; };

struct StaticOrder {
    int nM, nN, nwg, G, c;
    __host__ __device__ void init(int M, int N, int G_, int c_) { nM = M / BM; nN = N / BM; nwg = nM * nN; G = G_; c = c_; }
    __host__ __device__ bool next(int i, Unit& u) const {
        const long L = (long)i * G + c; if (L >= nwg) return false;
        int wgid = (int)L; { const int q = nwg / NXCD, r = nwg % NXCD, xcd = wgid % NXCD, off = wgid / NXCD; wgid = (xcd < r ? xcd * (q + 1) : r * (q + 1) + (xcd - r) * q) + off; }
        const int nig = WGM * nN, gid = wgid / nig, fm = gid * WGM, gsz = (nM - fm) < WGM ? (nM - fm) : WGM;
        u.pm = fm + ((wgid % nig) % gsz); u.pn = (wgid % nig) / gsz; return true;
    }
    __device__ __forceinline__ void a_ready(const Unit&) const {}
    __device__ __forceinline__ void done(const Unit&) const {}
};

__device__ __forceinline__ unsigned cvt_pk_bf16(float lo, float hi) { unsigned r; asm volatile("v_cvt_pk_bf16_f32 %0, %1, %2" : "=v"(r) : "v"(lo), "v"(hi)); return r; }

struct EpiF32 {
    static constexpr bool PERM = false, AFTER_DRAIN = false;
    float* C; int ldc;
    __device__ __forceinline__ void operator()(const f32x4 (&acc)[2][2][4][2], const Unit& u, int wr, int wc, int fr, int fq) const {
        const int row0 = u.pm * BM + wr * 64 + fr, col0 = u.pn * BM + wc * 32 + 4 * fq;
#pragma unroll
        for (int ai = 0; ai < 2; ++ai)
#pragma unroll
            for (int m = 0; m < 4; ++m) { float* rowp = C + (size_t)(row0 + ai * HALF + m * 16) * ldc + col0;
#pragma unroll
                for (int bj = 0; bj < 2; ++bj)
#pragma unroll
                    for (int n = 0; n < 2; ++n) *(f32x4*)(rowp + bj * HALF + n * 16) = acc[ai][bj][m][n]; }
    }
};
struct EpiProj {
    static constexpr bool PERM = true, AFTER_DRAIN = false;
    bf16_t* O; int ldc; float* dt; int dt_tile;
    __device__ __forceinline__ void operator()(const f32x4 (&acc)[2][2][4][2], const Unit& u, int wr, int wc, int fr, int fq) const {
        const int row0 = u.pm * BM + wr * 64 + fr;
        if (u.pn == dt_tile) {
            if (wc == 0 && fq < 2) {
#pragma unroll
                for (int ai = 0; ai < 2; ++ai)
#pragma unroll
                    for (int m = 0; m < 4; ++m) { float* rowp = dt + (size_t)(row0 + ai * HALF + m * 16) * 16 + 8 * fq;
                        *(f32x4*)(rowp) = acc[ai][0][m][0]; *(f32x4*)(rowp + 4) = acc[ai][0][m][1]; }
            }
            return;
        }
        const int col0 = u.pn * BM + wc * 32 + 8 * fq;
#pragma unroll
        for (int ai = 0; ai < 2; ++ai)
#pragma unroll
            for (int m = 0; m < 4; ++m) { bf16_t* rowp = O + (size_t)(row0 + ai * HALF + m * 16) * ldc + col0;
#pragma unroll
                for (int bj = 0; bj < 2; ++bj) { const f32x4 v0 = acc[ai][bj][m][0], v1 = acc[ai][bj][m][1];
                    u32x4 w; w.x = cvt_pk_bf16(v0[0], v0[1]); w.y = cvt_pk_bf16(v0[2], v0[3]); w.z = cvt_pk_bf16(v1[0], v1[1]); w.w = cvt_pk_bf16(v1[2], v1[3]);
                    *(u32x4*)(rowp + bj * HALF) = w; } }
    }
};
struct EpiSwiGLU {
    static constexpr bool PERM = true, AFTER_DRAIN = false;
    bf16_t* O; int ldc;
    __device__ __forceinline__ void operator()(const f32x4 (&acc)[2][2][4][2], const Unit& u, int wr, int wc, int fr, int fq) const {
        const int row0 = u.pm * BM + wr * 64 + fr, col0 = u.pn * HALF + wc * 32 + 8 * fq;
#pragma unroll
        for (int ai = 0; ai < 2; ++ai)
#pragma unroll
            for (int m = 0; m < 4; ++m) { bf16_t* rowp = O + (size_t)(row0 + ai * HALF + m * 16) * ldc + col0;
                float r[8];
#pragma unroll
                for (int n = 0; n < 2; ++n)
#pragma unroll
                    for (int i = 0; i < 4; ++i) { const float g = acc[ai][0][m][n][i], up = acc[ai][1][m][n][i];
                        r[n * 4 + i] = g * up * __builtin_amdgcn_rcpf(1.0f + __builtin_amdgcn_exp2f(-1.4426950408889634f * g)); }
                u32x4 w; w.x = cvt_pk_bf16(r[0], r[1]); w.y = cvt_pk_bf16(r[2], r[3]); w.z = cvt_pk_bf16(r[4], r[5]); w.w = cvt_pk_bf16(r[6], r[7]);
                *(u32x4*)(rowp) = w; }
    }
};

template <class Epi, class Sched, bool ALIGN_EPI = false, bool SP2 = false>
__device__ __forceinline__ void gemm_phase(PG8_LAS unsigned char* lds, const Gemm g, const Sched& S, const Epi& E) {
    const int tid = threadIdx.x, wid = __builtin_amdgcn_readfirstlane(tid >> 6), lane = tid & 63, wr = wid >> 2, wc = wid & 3, fr = lane & 15, fq = lane >> 4;
    const int K = g.K, nt = K / BK;
    unsigned voffA[2], voffB[2];
#pragma unroll
    for (int i = 0; i < 2; ++i) { int R, C; stage_rc(tid * 16 + i * 8192, R, C); const int Rb = Epi::PERM ? ((R & ~31) + perm32(R & 31)) : R;
        voffA[i] = (unsigned)(R * g.lda + C) * 2u; voffB[i] = (unsigned)(Rb * K + C) * 2u; }
    const size_t kstep = (size_t)(BK * 2);
    const size_t hstep = (size_t)HALF * K * 2, hstepA = (size_t)HALF * g.lda * 2;
    const size_t tstep = 2 * hstep, tstepA = 2 * hstepA;
    const unsigned ldsw = (unsigned)wid * 1024u;
    const int aoff = lds_byte(wr * 64 + fr, fq * 8), boff = lds_byte(wc * 32 + fr, fq * 8);
#define PG8_SA(b, h) (((b) * 2 + (h)) * HTB)
#define PG8_SB(b, h) ((4 + (b) * 2 + (h)) * HTB)
#define PG8_STAGE(bufoff, gbase, voff) do { _Pragma("unroll") for (int _i = 0; _i < 2; ++_i) \
        __builtin_amdgcn_global_load_lds((const unsigned*)((const char*)(gbase) + (voff)[_i]), (PG8_LAS unsigned*)(lds + (bufoff) + ldsw + _i * 8192), 16, 0, 0); } while (0)
#define PG8_LDA(dst, b, h) do { _Pragma("unroll") for (int m = 0; m < 4; ++m) _Pragma("unroll") for (int k = 0; k < 2; ++k) dst[m][k] = *(const PG8_LAS bf16x8*)(lds + PG8_SA(b, h) + aoff + m * 2048 + k * 1024); } while (0)
#define PG8_LDB(dst, b, h) do { _Pragma("unroll") for (int n = 0; n < 2; ++n) _Pragma("unroll") for (int k = 0; k < 2; ++k) dst[n][k] = *(const PG8_LAS bf16x8*)(lds + PG8_SB(b, h) + boff + n * 2048 + k * 1024); } while (0)
#define PG8_MMA(ai, bj, At, Bt) do { __builtin_amdgcn_s_setprio(1); _Pragma("unroll") for (int m = 0; m < 4; ++m) _Pragma("unroll") for (int n = 0; n < 2; ++n) _Pragma("unroll") for (int k = 0; k < 2; ++k) \
        acc[ai][bj][m][n] = __builtin_amdgcn_mfma_f32_16x16x32_bf16(Bt[n][k], At[m][k], acc[ai][bj][m][n], 0, 0, 0); __builtin_amdgcn_s_setprio(0); } while (0)
#define PG8_WAIT_V(n) asm volatile("s_waitcnt vmcnt(" #n ")" ::: "memory")
#define PG8_WAIT_L(n) asm volatile("s_waitcnt lgkmcnt(" #n ")" ::: "memory")
#define PG8_BAR __builtin_amdgcn_s_barrier()
#define PG8_SCHED __builtin_amdgcn_sched_barrier(0)
    Unit cur, nxt; int ui = 0;
    if (!S.next(0, cur)) return;
    f32x4 acc[2][2][4][2];
#pragma unroll
    for (int a = 0; a < 2; ++a)
#pragma unroll
        for (int b = 0; b < 2; ++b)
#pragma unroll
            for (int m = 0; m < 4; ++m)
#pragma unroll
                for (int n = 0; n < 2; ++n) acc[a][b][m][n] = (f32x4){0.f, 0.f, 0.f, 0.f};
    bf16x8 At[4][2], B0[2][2], B1[2][2];
    const char* cA = (const char*)g.A + (size_t)cur.pm * tstepA; const char* cB = (const char*)g.Bt + (size_t)cur.pn * tstep;
    S.a_ready(cur);
    if constexpr (SP2) {
        PG8_STAGE(PG8_SB(0, 0), cB, voffB); PG8_STAGE(PG8_SB(0, 1), cB + hstep, voffB); PG8_STAGE(PG8_SA(0, 0), cA, voffA); PG8_STAGE(PG8_SA(0, 1), cA + hstepA, voffA);
        if (wr == 1) PG8_BAR;
        PG8_WAIT_V(2); PG8_BAR;
        PG8_STAGE(PG8_SB(1, 0), cB + kstep, voffB); PG8_STAGE(PG8_SA(1, 0), cA + kstep, voffA); PG8_STAGE(PG8_SB(1, 1), cB + hstep + kstep, voffB);
        PG8_WAIT_V(6); PG8_BAR;
    } else {
        PG8_STAGE(PG8_SB(0, 0), cB, voffB); PG8_STAGE(PG8_SA(0, 0), cA, voffA); PG8_STAGE(PG8_SB(0, 1), cB + hstep, voffB); PG8_STAGE(PG8_SA(0, 1), cA + hstepA, voffA);
        if (wr == 1) PG8_BAR;
        PG8_WAIT_V(4); PG8_BAR;
        PG8_STAGE(PG8_SB(1, 0), cB + kstep, voffB); PG8_STAGE(PG8_SA(1, 0), cA + kstep, voffA); PG8_STAGE(PG8_SB(1, 1), cB + hstep + kstep, voffB);
        PG8_WAIT_V(6); PG8_BAR;
    }
    for (;;) {
        const bool has_next = S.next(ui + 1, nxt);
        const char* nA = has_next ? (const char*)g.A + (size_t)nxt.pm * tstepA : cA; const char* nB = has_next ? (const char*)g.Bt + (size_t)nxt.pn * tstep : cB;
        for (int t = 0; t < nt; t += 2) {
            const bool last = (t == nt - 2);
            const char* a1 = cA + (size_t)(t + 1) * kstep;
            const char* a2 = last ? nA : cA + (size_t)(t + 2) * kstep; const char* b2 = last ? nB : cB + (size_t)(t + 2) * kstep;
            const char* a3 = a2 + kstep; const char* b3 = b2 + kstep;
            if (last && has_next) S.a_ready(nxt);
            if constexpr (SP2) {
            PG8_LDB(B0, 0, 0); PG8_LDB(B1, 0, 1); PG8_SCHED; PG8_LDA(At, 0, 0); PG8_STAGE(PG8_SA(1, 1), a1 + hstepA, voffA);
            PG8_WAIT_V(8); PG8_WAIT_L(0); PG8_BAR; PG8_MMA(0, 0, At, B0); PG8_MMA(0, 1, At, B1); PG8_BAR; PG8_SCHED;
            PG8_LDA(At, 0, 1); PG8_STAGE(PG8_SB(0, 0), b2, voffB); PG8_STAGE(PG8_SB(0, 1), b2 + hstep, voffB); PG8_STAGE(PG8_SA(0, 0), a2, voffA);
            PG8_WAIT_V(8); PG8_WAIT_L(0); PG8_BAR; PG8_MMA(1, 0, At, B0); PG8_MMA(1, 1, At, B1); PG8_BAR; PG8_SCHED;
            PG8_LDB(B0, 1, 0); PG8_LDB(B1, 1, 1); PG8_SCHED; PG8_LDA(At, 1, 0); PG8_STAGE(PG8_SA(0, 1), a2 + hstepA, voffA);
            PG8_WAIT_V(8); PG8_WAIT_L(0); PG8_BAR; PG8_MMA(0, 0, At, B0); PG8_MMA(0, 1, At, B1); PG8_BAR; PG8_SCHED;
            PG8_LDA(At, 1, 1); PG8_STAGE(PG8_SB(1, 0), b3, voffB); PG8_STAGE(PG8_SB(1, 1), b3 + hstep, voffB); PG8_STAGE(PG8_SA(1, 0), a3, voffA);
            PG8_WAIT_V(8); PG8_WAIT_L(0); PG8_BAR; PG8_MMA(1, 0, At, B0); PG8_MMA(1, 1, At, B1); PG8_BAR; PG8_SCHED;
            } else {
            PG8_LDB(B0, 0, 0); PG8_SCHED; PG8_LDA(At, 0, 0); PG8_STAGE(PG8_SA(1, 1), a1 + hstepA, voffA);
            PG8_WAIT_L(8); PG8_BAR; PG8_WAIT_L(0); PG8_MMA(0, 0, At, B0); PG8_BAR; PG8_SCHED;
            PG8_LDB(B1, 0, 1); PG8_STAGE(PG8_SB(0, 0), b2, voffB);
            PG8_BAR; PG8_WAIT_L(0); PG8_MMA(0, 1, At, B1); PG8_BAR;
            PG8_LDA(At, 0, 1); PG8_STAGE(PG8_SA(0, 0), a2, voffA);
            PG8_BAR; PG8_WAIT_L(0); PG8_MMA(1, 0, At, B0); PG8_BAR; PG8_SCHED;
            PG8_STAGE(PG8_SB(0, 1), b2 + hstep, voffB);
            PG8_WAIT_V(6); PG8_BAR; PG8_MMA(1, 1, At, B1); PG8_BAR;
            PG8_LDB(B0, 1, 0); PG8_SCHED; PG8_LDA(At, 1, 0); PG8_STAGE(PG8_SA(0, 1), a2 + hstepA, voffA);
            PG8_WAIT_L(8); PG8_BAR; PG8_WAIT_L(0); PG8_MMA(0, 0, At, B0); PG8_BAR; PG8_SCHED;
            PG8_LDB(B1, 1, 1); PG8_STAGE(PG8_SB(1, 0), b3, voffB);
            PG8_BAR; PG8_WAIT_L(0); PG8_MMA(0, 1, At, B1); PG8_BAR;
            PG8_LDA(At, 1, 1); PG8_STAGE(PG8_SA(1, 0), a3, voffA);
            PG8_BAR; PG8_WAIT_L(0); PG8_MMA(1, 0, At, B0); PG8_BAR; PG8_SCHED;
            PG8_STAGE(PG8_SB(1, 1), b3 + hstep, voffB);
            PG8_WAIT_V(6); PG8_BAR; PG8_MMA(1, 1, At, B1); PG8_BAR;
            }
        }
        if constexpr (ALIGN_EPI) { if (wr == 0) PG8_BAR; }
        if constexpr (!Epi::AFTER_DRAIN) { E(acc, cur, wr, wc, fr, fq); S.done(cur); }
        if (!has_next) break;
#pragma unroll
        for (int a = 0; a < 2; ++a)
#pragma unroll
            for (int b = 0; b < 2; ++b)
#pragma unroll
                for (int m = 0; m < 4; ++m)
#pragma unroll
                    for (int n = 0; n < 2; ++n) acc[a][b][m][n] = (f32x4){0.f, 0.f, 0.f, 0.f};
        cur = nxt; cA = nA; cB = nB; ++ui;
        if constexpr (ALIGN_EPI) { if (wr == 1) PG8_BAR; }
    }
    PG8_WAIT_V(0);
    if constexpr (!ALIGN_EPI) { if (wr == 0) PG8_BAR; }
    PG8_BAR;
    if constexpr (Epi::AFTER_DRAIN) { E.fused(acc, cur, wr, wc, fr, fq, lds, wid, lane); S.done(cur); }
#undef PG8_SA
#undef PG8_SB
#undef PG8_STAGE
#undef PG8_LDA
#undef PG8_LDB
#undef PG8_MMA
#undef PG8_WAIT_V
#undef PG8_WAIT_L
#undef PG8_BAR
#undef PG8_SCHED
}}

constexpr int NWAVES = 8, NTHREADS = NWAVES * 64;
constexpr int D = 1024, BATCH_P = 8, SEQ_P = 2048, BATCH_S = 128, SEQ_S = 8;
constexpr int MP = BATCH_P * SEQ_P, MS = BATCH_S * SEQ_S, M = MP + MS;
constexpr int NSEQ = BATCH_P + BATCH_S;
constexpr int SCW = 1024, SSMW = 1024, NH = 16, HP = 64, NG = 4, NS = 128, XBC = 2048;
constexpr int NPROJ = 6160, NPROJ_PAD = 6400, PROJ_LD = 6144;
constexpr int C_SCB = 0, C_SCC = 1024, C_SCX = 2048, C_Z = 3072, C_XBC = 4096;
constexpr int FF = 2816, NGU = 2 * FF;
constexpr float EPS = 1e-6f;
constexpr size_t O_Y = 0, O_SCP = (size_t)M * D, O_CVP = O_SCP + (size_t)BATCH_P * 2 * SCW, O_SSMP = O_CVP + (size_t)BATCH_P * 3 * XBC,
                 O_SCS = O_SSMP + (size_t)BATCH_P * NH * HP * NS, O_CVS = O_SCS + (size_t)BATCH_S * 2 * SCW, O_SSMS = O_CVS + (size_t)BATCH_S * 3 * XBC,
                 O_END = O_SSMS + (size_t)BATCH_S * NH * HP * NS;
static_assert(O_END == 36765696ull, "output size");
constexpr size_t MiB = 1u << 20;
constexpr size_t WS_CTL = 0, CTL_ZERO_BYTES = 1 * MiB;
constexpr size_t WS_MOD = 1 * MiB;
constexpr size_t WS_WIN = 5 * MiB;
constexpr size_t WS_WOUT = 18 * MiB;
constexpr size_t WS_WGU = 22 * MiB;
constexpr size_t WS_WD = 33 * MiB;
constexpr size_t WS_DT = 39 * MiB;
constexpr size_t WS_PROJ = 41 * MiB;
constexpr size_t WS_ACT = 41 * MiB;
constexpr size_t WS_XN2 = 136 * MiB;
constexpr size_t WS_F = 170 * MiB;
constexpr size_t WS_END = 256 * MiB;
static_assert(WS_PROJ + (size_t)M * PROJ_LD * 2 <= WS_END && WS_ACT + (size_t)M * FF * 2 <= WS_XN2 && WS_XN2 + (size_t)M * D * 2 <= WS_F && WS_F + (size_t)M * D * 4 <= WS_END, "d_ws map");
static_assert(WS_WIN + (size_t)NPROJ_PAD * D * 2 <= WS_WOUT && WS_WD + (size_t)D * FF * 2 <= WS_DT && WS_DT + (size_t)M * 16 * 4 <= WS_PROJ, "d_ws map 2");
constexpr int CW_BAR = 4096;
constexpr int RING_OFF = 0, RING_BYTES = 131072;
constexpr int LDSCTL_OFF = RING_BYTES, MISC_OFF = LDSCTL_OFF + 320;
constexpr int LDS_BYTES = 147456;
static_assert(MISC_OFF + 128 <= LDS_BYTES, "LDS map");

#define GAS __attribute__((address_space(1)))
#define LAS __attribute__((address_space(3)))
typedef unsigned short bf16;
typedef unsigned v4u __attribute__((ext_vector_type(4)));
typedef unsigned v2u __attribute__((ext_vector_type(2)));
typedef float f32x4 __attribute__((ext_vector_type(4)));
typedef GAS unsigned gu32;
#define RLX_AGENT __ATOMIC_RELAXED, __HIP_MEMORY_SCOPE_AGENT
#define LDS_WAIT() asm volatile("s_waitcnt lgkmcnt(0)" ::: "memory")
#define VM_WAIT() asm volatile("s_waitcnt vmcnt(0)" ::: "memory")
__device__ __forceinline__ unsigned f2bf(float f) { unsigned u = __builtin_bit_cast(unsigned, f); return (u + 0x7fffu + ((u >> 16) & 1u)) >> 16; }
__device__ __forceinline__ unsigned pk2(float lo, float hi) { return f2bf(lo) | (f2bf(hi) << 16); }
__device__ __forceinline__ float bflo(unsigned u) { return __builtin_bit_cast(float, u << 16); }
__device__ __forceinline__ float bfhi(unsigned u) { return __builtin_bit_cast(float, u & 0xffff0000u); }
__device__ __forceinline__ float bf1(bf16 h) { return __builtin_bit_cast(float, (unsigned)h << 16); }
__device__ __forceinline__ float silu_f(float v) { return v * __builtin_amdgcn_rcpf(1.0f + __builtin_amdgcn_exp2f(-1.4426950408889634f * v)); }
__device__ __forceinline__ float softplus_f(float v) { return v > 20.f ? v : log1pf(__expf(v)); }

#define XB_TMO      128
#define XB_XCNT(j)  (256  + 64 * (j))
#define XB_XSUB(j)  (1280 + 64 * (j))
#define XB_XGEN(j)  (2304 + 64 * (j))
#define XB_TOP      3328
#define XB_TOPGEN   3392
#define XCD_BAR_WORDS 3456
#define XB_SPIN_CAP (1u << 18)
__device__ __forceinline__ unsigned xb_ld(unsigned* p)              { return __hip_atomic_load(p, __ATOMIC_RELAXED, __HIP_MEMORY_SCOPE_AGENT); }
__device__ __forceinline__ unsigned xb_add(unsigned* p, unsigned v) { return __hip_atomic_fetch_add(p, v, __ATOMIC_RELAXED, __HIP_MEMORY_SCOPE_AGENT); }
__device__ __forceinline__ unsigned xb_xcc_id() { return (unsigned)__builtin_amdgcn_s_getreg((3 << 11) | 20) & 0xFu; }
#define XB_SPIN(cond, bar) do { unsigned _sp = 0; while (cond) { __builtin_amdgcn_s_sleep(1); \
    if ((++_sp & 255u) == 0u) { if (xb_ld(&(bar)[XB_TMO])) break; if (_sp > XB_SPIN_CAP) { atomicAdd(&(bar)[XB_TMO], 1u); break; } } } } while (0)
struct XcdBarrier { unsigned* bar; unsigned x; volatile LAS unsigned* st; };
__device__ __forceinline__ XcdBarrier xcd_barrier_post(unsigned* bar, volatile LAS unsigned* st) {
    XcdBarrier b; b.bar = bar; b.x = xb_xcc_id(); b.st = st;
    if (threadIdx.x == 0) (void)xb_add(&bar[XB_XCNT(b.x)], 1u);
    return b;
}
__device__ __forceinline__ void xcd_barrier_complete(unsigned* bar, unsigned x, unsigned& nloc, unsigned& nx) {
    const unsigned G = gridDim.x * gridDim.y * gridDim.z;
    unsigned sum, cnt, mine, sp = 0u;
    for (;;) {
        sum = 0u; cnt = 0u; mine = 0u;
#pragma unroll
        for (unsigned j = 0; j < 16; ++j) { const unsigned c = xb_ld(&bar[XB_XCNT(j)]); sum += c; cnt += (c > 0u) ? 1u : 0u; mine = (j == x) ? c : mine; }
        if (sum == G) break;
        __builtin_amdgcn_s_sleep(1);
        if ((++sp & 255u) == 0u) { if (xb_ld(&bar[XB_TMO])) break; if (sp > XB_SPIN_CAP) { atomicAdd(&bar[XB_TMO], 1u); break; } }
    }
    nloc = mine > 0u ? mine : 1u; nx = cnt > 0u ? cnt : 1u;
}
__device__ __forceinline__ void xcd_barrier(const XcdBarrier& b) {
    asm volatile("s_waitcnt vmcnt(0)" ::: "memory");
    __syncthreads();
    if (threadIdx.x == 0) {
        unsigned* bar = b.bar;
        __builtin_amdgcn_s_waitcnt(0);
        unsigned nloc = b.st[0], nx = b.st[1];
        if (nloc == 0u) { xcd_barrier_complete(bar, b.x, nloc, nx); b.st[0] = nloc; b.st[1] = nx; }
        const unsigned old = xb_add(&bar[XB_XSUB(b.x)], 1u);
        const unsigned gen = old / nloc;
        if (old + 1u == (gen + 1u) * nloc) {
            __builtin_amdgcn_fence(__ATOMIC_RELEASE, "agent");
            asm volatile("s_waitcnt vmcnt(0)" ::: "memory");
            const unsigned og = xb_add(&bar[XB_TOP], 1u);
            const unsigned tg = og / nx;
            if (og + 1u == (tg + 1u) * nx) xb_add(&bar[XB_TOPGEN], 1u);
            else XB_SPIN(xb_ld(&bar[XB_TOPGEN]) == tg, bar);
            __builtin_amdgcn_fence(__ATOMIC_ACQUIRE, "agent");
            xb_add(&bar[XB_XGEN(b.x)], 1u);
            asm volatile("s_waitcnt vmcnt(0)" ::: "memory");
        } else {
            XB_SPIN(xb_ld(&bar[XB_XGEN(b.x)]) == gen, bar);
            __builtin_amdgcn_fence(__ATOMIC_ACQUIRE, "agent");
            asm volatile("s_waitcnt vmcnt(0)" ::: "memory");
        }
    }
    __syncthreads();
}

struct Args { const float* in[25]; float* out; unsigned char* ws; int ph_lo, ph_hi; };
struct Frame {
    LAS unsigned char* lds;
    volatile LAS unsigned* MISC;
    gu32* ctl;
    int tid, lane, wave, G;
    const float *x_p, *x_s, *c_p, *c_s, *st_sc, *st_cv, *st_ssm, *w_ada, *b_ada, *g_mpre, *g_mpost, *g_fpre, *g_fpost, *w_in, *sc_w, *cv_w, *cv_b, *dt_bias, *a_log, *d_skip, *ssm_g, *w_out, *w_gate, *w_up, *w_down;
    float* out;
    float* mod; bf16 *Win_t, *Wout_t, *Wgu_t, *Wd_t; float* dtraw; bf16 *proj, *act, *xn2; float* fbuf;
    bf16* xn1;
    bf16* xbcc;
    float* mix;
};
__device__ __forceinline__ float wave_sum(float v) {
#pragma unroll
    for (int o = 1; o < 64; o <<= 1) v += __shfl_xor(v, o);
    return v;
}
__device__ __forceinline__ const float* x_row(const Frame& F, int m) { return m < MP ? F.x_p + (size_t)m * D : F.x_s + (size_t)(m - MP) * D; }
__device__ __forceinline__ int seq_of(int m) { return m < MP ? (m >> 11) : BATCH_P + ((m - MP) >> 3); }

__device__ __forceinline__ void p0_transpose_item(const float* W, int K, int N, int nblk, bf16* WT, int mode, LAS float* scr, int item, int lane) {
    const int kb = item / nblk, nb = item % nblk, k0 = 64 * kb, n0 = 32 * nb;
    const bool ok = (n0 + (lane & 31)) < N;
#pragma unroll 8
    for (int i = 0; i < 32; ++i) { const int kk = 2 * i + (lane >> 5); scr[kk * 33 + (lane & 31)] = ok ? W[(size_t)(k0 + kk) * N + n0 + (lane & 31)] : 0.f; }
    LDS_WAIT(); asm volatile("" ::: "memory");
    const int c = lane & 7;
    const int r0 = mode == 0 ? n0 : ((n0 >> 7) * 256 + (n0 & 127) + (mode == 2 ? 128 : 0));
#pragma unroll
    for (int j = 0; j < 4; ++j) { const int n = (lane >> 3) + 8 * j; const LAS float* s = scr + (8 * c) * 33 + n;
        v4u o; o.x = pk2(s[0 * 33], s[1 * 33]); o.y = pk2(s[2 * 33], s[3 * 33]); o.z = pk2(s[4 * 33], s[5 * 33]); o.w = pk2(s[6 * 33], s[7 * 33]);
        *(v4u*)(WT + (size_t)(r0 + n) * K + k0 + 8 * c) = o; }
    LDS_WAIT(); asm volatile("" ::: "memory");
}

__device__ __forceinline__ void p0_prologue(Frame& F) {
    {
        LAS float* sc = (LAS float*)(F.lds + RING_OFF);
        for (int it = blockIdx.x; it < 17 * 12; it += F.G) {
            const int sg = it / 12, cb = it % 12, s0 = sg * 8;
            for (int idx = F.tid; idx < 8192; idx += NTHREADS) { const int sl = idx >> 10, k = idx & 1023, s = s0 + sl;
                const float* cp = s < BATCH_P ? F.c_p + (size_t)s * D : F.c_s + (size_t)(s - BATCH_P) * D; sc[k * 8 + sl] = silu_f(cp[k]); }
            __syncthreads();
            const int j = cb * 512 + F.tid; float acc[8];
#pragma unroll
            for (int i = 0; i < 8; ++i) acc[i] = 0.f;
#pragma unroll 8
            for (int k = 0; k < D; ++k) { const float w = F.w_ada[(size_t)k * 6144 + j]; const f32x4 a = *(const LAS f32x4*)(sc + k * 8), b = *(const LAS f32x4*)(sc + k * 8 + 4);
                acc[0] += a[0] * w; acc[1] += a[1] * w; acc[2] += a[2] * w; acc[3] += a[3] * w; acc[4] += b[0] * w; acc[5] += b[1] * w; acc[6] += b[2] * w; acc[7] += b[3] * w; }
            const float bj = F.b_ada[j];
#pragma unroll
            for (int i = 0; i < 8; ++i) F.mod[(size_t)(s0 + i) * 6144 + j] = acc[i] + bj;
            __syncthreads();
        }
    }
    LAS float* scr = (LAS float*)(F.lds + RING_OFF + F.wave * 16384);
    const int gw = blockIdx.x * NWAVES + F.wave, NGW = F.G * NWAVES;
    constexpr int I_IN = (D / 64) * (NPROJ_PAD / 32), I_OUT = (2048 / 64) * (D / 32), I_G = (D / 64) * (FF / 32), I_D = (FF / 64) * (D / 32);
    constexpr int NITEMS = I_IN + I_OUT + 2 * I_G + I_D;
    for (int it = gw; it < NITEMS; it += NGW) {
        int r = it;
        if (r < I_IN) { p0_transpose_item(F.w_in, D, NPROJ, NPROJ_PAD / 32, F.Win_t, 0, scr, r, F.lane); continue; } r -= I_IN;
        if (r < I_OUT) { p0_transpose_item(F.w_out, 2048, D, D / 32, F.Wout_t, 0, scr, r, F.lane); continue; } r -= I_OUT;
        if (r < I_G) { p0_transpose_item(F.w_gate, D, FF, FF / 32, F.Wgu_t, 1, scr, r, F.lane); continue; } r -= I_G;
        if (r < I_G) { p0_transpose_item(F.w_up, D, FF, FF / 32, F.Wgu_t, 2, scr, r, F.lane); continue; } r -= I_G;
        p0_transpose_item(F.w_down, FF, D, D / 32, F.Wd_t, 0, scr, r, F.lane);
    }
}
__device__ __forceinline__ void p1_hrows(Frame& F) {
    const int gw = blockIdx.x * NWAVES + F.wave, NGW = F.G * NWAVES;
    for (int m = gw; m < M; m += NGW) {
        const f32x4* xr = (const f32x4*)x_row(F, m) + F.lane; const float* md = F.mod + (size_t)seq_of(m) * 6144;
        f32x4 v[4]; float ss = 0.f;
#pragma unroll
        for (int j = 0; j < 4; ++j) { v[j] = xr[64 * j]; ss += (v[j].x * v[j].x + v[j].y * v[j].y) + (v[j].z * v[j].z + v[j].w * v[j].w); }
        const float rstd = 1.0f / sqrtf(wave_sum(ss) * (1.f / D) + EPS);
        unsigned long long* o8 = (unsigned long long*)(F.xn1 + (size_t)m * D) + F.lane;
#pragma unroll
        for (int j = 0; j < 4; ++j) { const int col = 256 * j + 4 * F.lane; const f32x4 g = *(const f32x4*)(F.g_mpre + col), sh = *(const f32x4*)(md + col), sc = *(const f32x4*)(md + 1024 + col);
            const f32x4 h = (v[j] * rstd) * g * (sc + 1.0f) + sh;
            o8[64 * j] = (unsigned long long)pk2(h.x, h.y) | ((unsigned long long)pk2(h.z, h.w) << 32); }
    }
}
__device__ __forceinline__ void unpack8(const v4u q, float (&f)[8]) { f[0] = bflo(q.x); f[1] = bfhi(q.x); f[2] = bflo(q.y); f[3] = bfhi(q.y); f[4] = bflo(q.z); f[5] = bfhi(q.z); f[6] = bflo(q.w); f[7] = bfhi(q.w); }
__device__ __forceinline__ void p3_conv(Frame& F) {
    const long total = (long)M * 384;
    for (long idx = (long)blockIdx.x * NTHREADS + F.tid; idx < total; idx += (long)F.G * NTHREADS) {
        const int r = (int)(idx / 384), ch = (int)(idx % 384);
        int b, t, L; bool samp;
        if (r < MP) { b = r >> 11; t = r & 2047; L = SEQ_P; samp = false; } else { const int rr = r - MP; b = rr >> 3; t = rr & 7; L = SEQ_S; samp = true; }
        const bf16* prow = F.proj + (size_t)r * PROJ_LD;
        if (ch < 128) {
            const int c0 = ch * 8;
            float acc[8], e[8];
#pragma unroll
            for (int i = 0; i < 8; ++i) acc[i] = 0.f;
#pragma unroll
            for (int j = 0; j < 3; ++j) {
                const int ee = t + j;
                if (ee < 2) {
                    if (samp) { const float* bp = F.st_sc + ((size_t)b * 2 + ee) * SCW + c0; const f32x4 a = *(const f32x4*)bp, bb = *(const f32x4*)(bp + 4);
                        e[0] = a.x; e[1] = a.y; e[2] = a.z; e[3] = a.w; e[4] = bb.x; e[5] = bb.y; e[6] = bb.z; e[7] = bb.w; }
                    else {
#pragma unroll
                        for (int i = 0; i < 8; ++i) e[i] = 0.f; }
                } else {
                    const bf16* pr = prow + (ptrdiff_t)(j - 2) * PROJ_LD; float cc[8], xx[8];
                    unpack8(*(const v4u*)(pr + C_SCC + c0), cc); unpack8(*(const v4u*)(pr + C_SCX + c0), xx);
#pragma unroll
                    for (int i = 0; i < 8; ++i) e[i] = cc[i] * xx[i];
                }
                const float* wp = F.sc_w + (size_t)j * SCW + c0; const f32x4 w0 = *(const f32x4*)wp, w1 = *(const f32x4*)(wp + 4);
                acc[0] += w0.x * e[0]; acc[1] += w0.y * e[1]; acc[2] += w0.z * e[2]; acc[3] += w0.w * e[3]; acc[4] += w1.x * e[4]; acc[5] += w1.y * e[5]; acc[6] += w1.z * e[6]; acc[7] += w1.w * e[7];
            }
            if (t >= L - 2) { float* op = F.out + (samp ? O_SCS : O_SCP) + ((size_t)b * 2 + (t - (L - 2))) * SCW + c0;
                *(f32x4*)op = (f32x4){e[0], e[1], e[2], e[3]}; *(f32x4*)(op + 4) = (f32x4){e[4], e[5], e[6], e[7]}; }
            float bb[8]; unpack8(*(const v4u*)(prow + C_SCB + c0), bb);
            v4u o; o.x = pk2(bb[0] * acc[0], bb[1] * acc[1]); o.y = pk2(bb[2] * acc[2], bb[3] * acc[3]); o.z = pk2(bb[4] * acc[4], bb[5] * acc[5]); o.w = pk2(bb[6] * acc[6], bb[7] * acc[7]);
            *(v4u*)(F.proj + (size_t)r * PROJ_LD + C_SCB + c0) = o;
        } else {
            const int c0 = (ch - 128) * 8;
            float acc[8], e[8];
            { const f32x4 a = *(const f32x4*)(F.cv_b + c0), bb = *(const f32x4*)(F.cv_b + c0 + 4); acc[0] = a.x; acc[1] = a.y; acc[2] = a.z; acc[3] = a.w; acc[4] = bb.x; acc[5] = bb.y; acc[6] = bb.z; acc[7] = bb.w; }
#pragma unroll
            for (int j = 0; j < 4; ++j) {
                const int ee = t + j;
                if (ee < 3) {
                    if (samp) { const float* bp = F.st_cv + ((size_t)b * 3 + ee) * XBC + c0; const f32x4 a = *(const f32x4*)bp, bb = *(const f32x4*)(bp + 4);
                        e[0] = a.x; e[1] = a.y; e[2] = a.z; e[3] = a.w; e[4] = bb.x; e[5] = bb.y; e[6] = bb.z; e[7] = bb.w; }
                    else {
#pragma unroll
                        for (int i = 0; i < 8; ++i) e[i] = 0.f; }
                } else unpack8(*(const v4u*)(prow + (ptrdiff_t)(j - 3) * PROJ_LD + C_XBC + c0), e);
                const float* wp = F.cv_w + (size_t)j * XBC + c0; const f32x4 w0 = *(const f32x4*)wp, w1 = *(const f32x4*)(wp + 4);
                acc[0] += w0.x * e[0]; acc[1] += w0.y * e[1]; acc[2] += w0.z * e[2]; acc[3] += w0.w * e[3]; acc[4] += w1.x * e[4]; acc[5] += w1.y * e[5]; acc[6] += w1.z * e[6]; acc[7] += w1.w * e[7];
            }
            if (t >= L - 3) { float* op = F.out + (samp ? O_CVS : O_CVP) + ((size_t)b * 3 + (t - (L - 3))) * XBC + c0;
                *(f32x4*)op = (f32x4){e[0], e[1], e[2], e[3]}; *(f32x4*)(op + 4) = (f32x4){e[4], e[5], e[6], e[7]}; }
            v4u o; o.x = pk2(silu_f(acc[0]), silu_f(acc[1])); o.y = pk2(silu_f(acc[2]), silu_f(acc[3])); o.z = pk2(silu_f(acc[4]), silu_f(acc[5])); o.w = pk2(silu_f(acc[6]), silu_f(acc[7]));
            *(v4u*)(F.xbcc + (size_t)r * XBC + c0) = o;
        }
    }
}
__device__ __forceinline__ void p4_scan(Frame& F) {
    const int p = F.tid >> 3, nq = F.tid & 7;
    const int nitems = NSEQ * NH;
    for (int it = blockIdx.x; it < nitems; it += F.G) {
        const int s = it / NH, h = it % NH, g = h >> 2;
        const bool samp = s >= BATCH_P; const int b = samp ? s - BATCH_P : s; const int L = samp ? SEQ_S : SEQ_P; const int row0 = samp ? MP + b * SEQ_S : b * SEQ_P;
        float S[16];
        if (samp) { const float* sp = F.st_ssm + (((size_t)b * NH + h) * HP + p) * NS + nq * 16;
#pragma unroll
            for (int i = 0; i < 4; ++i) { const f32x4 a = *(const f32x4*)(sp + 4 * i); S[4 * i] = a.x; S[4 * i + 1] = a.y; S[4 * i + 2] = a.z; S[4 * i + 3] = a.w; } }
        else {
#pragma unroll
            for (int i = 0; i < 16; ++i) S[i] = 0.f; }
        const float A = -__expf(F.a_log[h]), dtb = F.dt_bias[h], Dh = F.d_skip[h];
        for (int t0 = 0; t0 < L; t0 += 8) {
            v4u Bq[8][2], Cq[8][2]; float xv[8], dtv[8];
#pragma unroll
            for (int u = 0; u < 8; ++u) { const int r = row0 + t0 + u; const bf16* xr = F.xbcc + (size_t)r * XBC;
                Bq[u][0] = *(const v4u*)(xr + 1024 + g * NS + nq * 16); Bq[u][1] = *(const v4u*)(xr + 1024 + g * NS + nq * 16 + 8);
                Cq[u][0] = *(const v4u*)(xr + 1536 + g * NS + nq * 16); Cq[u][1] = *(const v4u*)(xr + 1536 + g * NS + nq * 16 + 8);
                xv[u] = bf1(xr[h * HP + p]); dtv[u] = F.dtraw[(size_t)r * 16 + h]; }
#pragma unroll
            for (int u = 0; u < 8; ++u) {
                const float dt = softplus_f(dtv[u] + dtb), dA = __expf(dt * A), xdt = dt * xv[u];
                float Bf[16], Cf[16]; { float t8[8]; unpack8(Bq[u][0], t8);
#pragma unroll
                    for (int i = 0; i < 8; ++i) Bf[i] = t8[i];
                    unpack8(Bq[u][1], t8);
#pragma unroll
                    for (int i = 0; i < 8; ++i) Bf[8 + i] = t8[i];
                    unpack8(Cq[u][0], t8);
#pragma unroll
                    for (int i = 0; i < 8; ++i) Cf[i] = t8[i];
                    unpack8(Cq[u][1], t8);
#pragma unroll
                    for (int i = 0; i < 8; ++i) Cf[8 + i] = t8[i]; }
                float y = 0.f;
#pragma unroll
                for (int i = 0; i < 16; ++i) { S[i] = S[i] * dA + xdt * Bf[i]; y += Cf[i] * S[i]; }
                y += __shfl_xor(y, 1); y += __shfl_xor(y, 2); y += __shfl_xor(y, 4);
                y += Dh * xv[u];
                if (nq == 0) F.proj[(size_t)(row0 + t0 + u) * PROJ_LD + C_SCX + h * HP + p] = (bf16)f2bf(y);
            }
        }
        float* op = F.out + (samp ? O_SSMS : O_SSMP) + (((size_t)b * NH + h) * HP + p) * NS + nq * 16;
#pragma unroll
        for (int i = 0; i < 4; ++i) *(f32x4*)(op + 4 * i) = (f32x4){S[4 * i], S[4 * i + 1], S[4 * i + 2], S[4 * i + 3]};
    }
}
__device__ __forceinline__ void p5_gatenorm(Frame& F) {
    const int gw = blockIdx.x * NWAVES + F.wave, NGW = F.G * NWAVES;
    for (int it = gw; it < M * NG; it += NGW) {
        const int r = it >> 2, g = it & 3; bf16* prow = F.proj + (size_t)r * PROJ_LD; const int c = g * 256 + 4 * F.lane;
        const v2u yq = *(const v2u*)(prow + C_SCX + c), zq = *(const v2u*)(prow + C_Z + c);
        float v[4]; v[0] = bflo(yq.x) * silu_f(bflo(zq.x)); v[1] = bfhi(yq.x) * silu_f(bfhi(zq.x)); v[2] = bflo(yq.y) * silu_f(bflo(zq.y)); v[3] = bfhi(yq.y) * silu_f(bfhi(zq.y));
        const float ss = wave_sum((v[0] * v[0] + v[1] * v[1]) + (v[2] * v[2] + v[3] * v[3]));
        const float rstd = 1.0f / sqrtf(ss * (1.f / 256.f) + EPS); const f32x4 gg = *(const f32x4*)(F.ssm_g + c);
        v2u o; o.x = pk2(v[0] * rstd * gg.x, v[1] * rstd * gg.y); o.y = pk2(v[2] * rstd * gg.z, v[3] * rstd * gg.w);
        *(v2u*)(prow + C_SCC + c) = o;
    }
}
__device__ __forceinline__ void p7_rows(Frame& F) {
    const int gw = blockIdx.x * NWAVES + F.wave, NGW = F.G * NWAVES;
    for (int m = gw; m < M; m += NGW) {
        const f32x4* xr = (const f32x4*)x_row(F, m) + F.lane; f32x4* mr = (f32x4*)(F.mix + (size_t)m * D) + F.lane; const float* md = F.mod + (size_t)seq_of(m) * 6144;
        f32x4 v[4], x1[4]; float ss = 0.f;
#pragma unroll
        for (int j = 0; j < 4; ++j) { v[j] = mr[64 * j]; ss += (v[j].x * v[j].x + v[j].y * v[j].y) + (v[j].z * v[j].z + v[j].w * v[j].w); }
        const float rstd = 1.0f / sqrtf(wave_sum(ss) * (1.f / D) + EPS); float s2 = 0.f;
#pragma unroll
        for (int j = 0; j < 4; ++j) { const int col = 256 * j + 4 * F.lane; const f32x4 g = *(const f32x4*)(F.g_mpost + col), gt = *(const f32x4*)(md + 2048 + col);
            x1[j] = xr[64 * j] + gt * ((v[j] * rstd) * g); mr[64 * j] = x1[j];
            s2 += (x1[j].x * x1[j].x + x1[j].y * x1[j].y) + (x1[j].z * x1[j].z + x1[j].w * x1[j].w); }
        const float rstd2 = 1.0f / sqrtf(wave_sum(s2) * (1.f / D) + EPS);
        unsigned long long* o8 = (unsigned long long*)(F.xn2 + (size_t)m * D) + F.lane;
#pragma unroll
        for (int j = 0; j < 4; ++j) { const int col = 256 * j + 4 * F.lane; const f32x4 g = *(const f32x4*)(F.g_fpre + col), sh = *(const f32x4*)(md + 3072 + col), sc = *(const f32x4*)(md + 4096 + col);
            const f32x4 h = (x1[j] * rstd2) * g * (sc + 1.0f) + sh;
            o8[64 * j] = (unsigned long long)pk2(h.x, h.y) | ((unsigned long long)pk2(h.z, h.w) << 32); }
    }
}
__device__ __forceinline__ void p10_rows(Frame& F) {
    const int gw = blockIdx.x * NWAVES + F.wave, NGW = F.G * NWAVES;
    for (int m = gw; m < M; m += NGW) {
        const f32x4* fr = (const f32x4*)(F.fbuf + (size_t)m * D) + F.lane; f32x4* yr = (f32x4*)(F.out + (size_t)m * D) + F.lane; const float* md = F.mod + (size_t)seq_of(m) * 6144;
        f32x4 v[4]; float ss = 0.f;
#pragma unroll
        for (int j = 0; j < 4; ++j) { v[j] = fr[64 * j]; ss += (v[j].x * v[j].x + v[j].y * v[j].y) + (v[j].z * v[j].z + v[j].w * v[j].w); }
        const float rstd = 1.0f / sqrtf(wave_sum(ss) * (1.f / D) + EPS);
#pragma unroll
        for (int j = 0; j < 4; ++j) { const int col = 256 * j + 4 * F.lane; const f32x4 g = *(const f32x4*)(F.g_fpost + col), gt = *(const f32x4*)(md + 5120 + col);
            yr[64 * j] = yr[64 * j] + gt * ((v[j] * rstd) * g); }
    }
}

constexpr int NPHASE = 11;
#ifndef MK_ONE_LAUNCH
#define MK_ONE_LAUNCH 0
#endif
__global__ void __launch_bounds__(NTHREADS, 2) hymba_fwd(Args args) {
    extern __shared__ __attribute__((aligned(16))) unsigned char lds[];
    Frame F;
    F.lds = (LAS unsigned char*)lds;
    F.MISC = (volatile LAS unsigned*)(F.lds + MISC_OFF);
    F.tid = threadIdx.x; F.lane = F.tid & 63; F.wave = __builtin_amdgcn_readfirstlane(F.tid >> 6);
    F.G = gridDim.x;
    unsigned char* ws = args.ws;
    F.ctl = (gu32*)(ws + WS_CTL);
    F.x_p = args.in[0]; F.x_s = args.in[1]; F.c_p = args.in[2]; F.c_s = args.in[3]; F.st_sc = args.in[4]; F.st_cv = args.in[5]; F.st_ssm = args.in[6];
    F.w_ada = args.in[7]; F.b_ada = args.in[8]; F.g_mpre = args.in[9]; F.g_mpost = args.in[10]; F.g_fpre = args.in[11]; F.g_fpost = args.in[12];
    F.w_in = args.in[13]; F.sc_w = args.in[14]; F.cv_w = args.in[15]; F.cv_b = args.in[16]; F.dt_bias = args.in[17]; F.a_log = args.in[18]; F.d_skip = args.in[19];
    F.ssm_g = args.in[20]; F.w_out = args.in[21]; F.w_gate = args.in[22]; F.w_up = args.in[23]; F.w_down = args.in[24];
    F.out = args.out;
    F.mod = (float*)(ws + WS_MOD); F.Win_t = (bf16*)(ws + WS_WIN); F.Wout_t = (bf16*)(ws + WS_WOUT); F.Wgu_t = (bf16*)(ws + WS_WGU); F.Wd_t = (bf16*)(ws + WS_WD);
    F.dtraw = (float*)(ws + WS_DT); F.proj = (bf16*)(ws + WS_PROJ); F.act = (bf16*)(ws + WS_ACT); F.xn2 = (bf16*)(ws + WS_XN2); F.fbuf = (float*)(ws + WS_F);
    F.xn1 = (bf16*)(args.out + O_Y); F.xbcc = (bf16*)(args.out + O_Y); F.mix = args.out + O_Y;
    for (int u = F.tid; u < (LDS_BYTES - LDSCTL_OFF) / 4; u += NTHREADS) ((LAS unsigned*)(F.lds + LDSCTL_OFF))[u] = 0u;
    __syncthreads();
    XcdBarrier bar; bar.bar = (unsigned*)(F.ctl + CW_BAR); bar.x = 0; bar.st = nullptr;
    const int lo = args.ph_lo, hi = args.ph_hi;
    if (hi - lo > 1) bar = xcd_barrier_post((unsigned*)(F.ctl + CW_BAR), F.MISC + 8);
#define IN(k) (lo <= (k) && (k) < hi)
#define SEAM(k) do { if (IN(k) && IN((k) + 1)) xcd_barrier(bar); } while (0)

    if (IN(0)) { p0_prologue(F); } SEAM(0);
    if (IN(1)) { p1_hrows(F); } SEAM(1);
    if (IN(2)) {
        pg8::Gemm g{F.xn1, F.Win_t, M, NPROJ_PAD, D, D}; pg8::StaticOrder S; S.init(M, NPROJ_PAD, F.G, (int)blockIdx.x);
        pg8::EpiProj E{F.proj, PROJ_LD, F.dtraw, PROJ_LD / 256};
        pg8::gemm_phase<pg8::EpiProj, pg8::StaticOrder, true, true>(F.lds + RING_OFF, g, S, E);
    } SEAM(2);
    if (IN(3)) { p3_conv(F); } SEAM(3);
    if (IN(4)) { p4_scan(F); } SEAM(4);
    if (IN(5)) { p5_gatenorm(F); } SEAM(5);
    if (IN(6)) {
        pg8::Gemm g{F.proj, F.Wout_t, M, D, 2048, PROJ_LD}; pg8::StaticOrder S; S.init(M, D, F.G, (int)blockIdx.x);
        pg8::EpiF32 E{F.mix, D};
        pg8::gemm_phase<pg8::EpiF32, pg8::StaticOrder, true, true>(F.lds + RING_OFF, g, S, E);
    } SEAM(6);
    if (IN(7)) { p7_rows(F); } SEAM(7);
    if (IN(8)) {
        pg8::Gemm g{F.xn2, F.Wgu_t, M, NGU, D, D}; pg8::StaticOrder S; S.init(M, NGU, F.G, (int)blockIdx.x);
        pg8::EpiSwiGLU E{F.act, FF};
        pg8::gemm_phase<pg8::EpiSwiGLU, pg8::StaticOrder, true, true>(F.lds + RING_OFF, g, S, E);
    } SEAM(8);
    if (IN(9)) {
        pg8::Gemm g{F.act, F.Wd_t, M, D, FF, FF}; pg8::StaticOrder S; S.init(M, D, F.G, (int)blockIdx.x);
        pg8::EpiF32 E{F.fbuf, D};
        pg8::gemm_phase<pg8::EpiF32, pg8::StaticOrder, true, true>(F.lds + RING_OFF, g, S, E);
    } SEAM(9);
    if (IN(10)) { p10_rows(F); }
#undef IN
#undef SEAM
}

extern "C" void kernel_launch(void* const* d_in, const int* in_sizes, int n_in, void* d_out, int out_size, void* d_ws, size_t ws_size, hipStream_t stream) {
    static int grid = 0;
    if (grid == 0) {
        if (n_in != 25 || out_size != (int)O_END || ws_size < WS_END) { fprintf(stderr, "kernel_launch: unexpected sizes n_in %d out %d ws %zu; nothing launched\n", n_in, out_size, ws_size); grid = -1; return; }
        int dev = 0, cus = 0, per_cu = 0;
        if (hipGetDevice(&dev) != hipSuccess || hipDeviceGetAttribute(&cus, hipDeviceAttributeMultiprocessorCount, dev) != hipSuccess) { grid = -1; return; }
        if (hipFuncSetAttribute((const void*)hymba_fwd, hipFuncAttributeMaxDynamicSharedMemorySize, LDS_BYTES) != hipSuccess) { fprintf(stderr, "kernel_launch: hipFuncSetAttribute failed\n"); grid = -1; return; }
        if (hipOccupancyMaxActiveBlocksPerMultiprocessor(&per_cu, (const void*)hymba_fwd, NTHREADS, LDS_BYTES) != hipSuccess || per_cu < 1) { fprintf(stderr, "kernel_launch: occupancy query says %d\n", per_cu); per_cu = 1; }
        (void)hipGetLastError();
        grid = cus;
    }
    if (grid < 0) return;
    (void)hipMemsetAsync((char*)d_ws + WS_CTL, 0, CTL_ZERO_BYTES, stream);
    Args a{};
    for (int i = 0; i < 25; ++i) a.in[i] = (const float*)d_in[i];
    a.out = (float*)d_out; a.ws = (unsigned char*)d_ws;
#if MK_ONE_LAUNCH
    a.ph_lo = 0; a.ph_hi = NPHASE;
    hipLaunchKernelGGL(hymba_fwd, dim3(grid), dim3(NTHREADS), LDS_BYTES, stream, a);
#else
    for (int ph = 0; ph < NPHASE; ++ph) { a.ph_lo = ph; a.ph_hi = ph + 1; hipLaunchKernelGGL(hymba_fwd, dim3(grid), dim3(NTHREADS), LDS_BYTES, stream, a); }
#endif
}
```

```cpp
#include <hip/hip_runtime.h>
#include <cstdio>
#include <cstdint>
namespace pg8 {
#define PG8_LAS __attribute__((address_space(3)))
typedef unsigned short bf16_t;
typedef short bf16x8 __attribute__((ext_vector_type(8)));
typedef float f32x4 __attribute__((ext_vector_type(4)));
typedef unsigned u32x4 __attribute__((ext_vector_type(4)));
constexpr int BM = 256, BK = 64, HALF = 128, HTB = HALF * BK * 2  , STAGE_BYTES = 8 * HTB, NXCD = 8, WGM = 8;

__host__ __device__ __forceinline__ int lds_byte(int r, int c) { const int st = (r >> 4) * 2 + (c >> 5), rr = r & 15, cc = c & 31, ob = rr * 64 + cc * 2; return st * 1024 + (ob ^ (((ob >> 9) & 1) << 5)); }
__host__ __device__ __forceinline__ void stage_rc(int b, int& R, int& C) { const int st = b / 1024, sb = b % 1024, swz = sb ^ (((sb >> 9) & 1) << 5); R = (st >> 1) * 16 + swz / 64; C = (st & 1) * 32 + (swz % 64) / 2; }
__host__ __device__ __forceinline__ int perm32(int rho) { const int n = rho >> 4, i = rho & 15; return 8 * (i >> 2) + 4 * n + (i & 3); }

struct Unit { int pm, pn; };
struct Gemm { const bf16_t* A; const bf16_t* Bt; int M, N, K, lda; };

struct StaticOrder {
    int nM, nN, nwg, G, c;
    __host__ __device__ void init(int M, int N, int G_, int c_) { nM = M / BM; nN = N / BM; nwg = nM * nN; G = G_; c = c_; }
    __host__ __device__ bool next(int i, Unit& u) const {
        const long L = (long)i * G + c; if (L >= nwg) return false;
        int wgid = (int)L; { const int q = nwg / NXCD, r = nwg % NXCD, xcd = wgid % NXCD, off = wgid / NXCD; wgid = (xcd < r ? xcd * (q + 1) : r * (q + 1) + (xcd - r) * q) + off; }
        const int nig = WGM * nN, gid = wgid / nig, fm = gid * WGM, gsz = (nM - fm) < WGM ? (nM - fm) : WGM;
        u.pm = fm + ((wgid % nig) % gsz); u.pn = (wgid % nig) / gsz; return true;
    }
    __device__ __forceinline__ void a_ready(const Unit&) const {}
    __device__ __forceinline__ void done(const Unit&) const {}
};

__device__ __forceinline__ unsigned cvt_pk_bf16(float lo, float hi) { unsigned r; asm volatile("v_cvt_pk_bf16_f32 %0, %1, %2" : "=v"(r) : "v"(lo), "v"(hi)); return r; }

struct EpiF32 {
    static constexpr bool PERM = false, AFTER_DRAIN = false;
    float* C; int ldc;
    __device__ __forceinline__ void operator()(const f32x4 (&acc)[2][2][4][2], const Unit& u, int wr, int wc, int fr, int fq) const {
        const int row0 = u.pm * BM + wr * 64 + fr, col0 = u.pn * BM + wc * 32 + 4 * fq;
#pragma unroll
        for (int ai = 0; ai < 2; ++ai)
#pragma unroll
            for (int m = 0; m < 4; ++m) { float* rowp = C + (size_t)(row0 + ai * HALF + m * 16) * ldc + col0;
#pragma unroll
                for (int bj = 0; bj < 2; ++bj)
#pragma unroll
                    for (int n = 0; n < 2; ++n) *(f32x4*)(rowp + bj * HALF + n * 16) = acc[ai][bj][m][n]; }
    }
};
struct EpiProj {
    static constexpr bool PERM = true, AFTER_DRAIN = false;
    bf16_t* O; int ldc; float* dt; int dt_tile;
    __device__ __forceinline__ void operator()(const f32x4 (&acc)[2][2][4][2], const Unit& u, int wr, int wc, int fr, int fq) const {
        const int row0 = u.pm * BM + wr * 64 + fr;
        if (u.pn == dt_tile) {
            if (wc == 0 && fq < 2) {
#pragma unroll
                for (int ai = 0; ai < 2; ++ai)
#pragma unroll
                    for (int m = 0; m < 4; ++m) { float* rowp = dt + (size_t)(row0 + ai * HALF + m * 16) * 16 + 8 * fq;
                        *(f32x4*)(rowp) = acc[ai][0][m][0]; *(f32x4*)(rowp + 4) = acc[ai][0][m][1]; }
            }
            return;
        }
        const int col0 = u.pn * BM + wc * 32 + 8 * fq;
#pragma unroll
        for (int ai = 0; ai < 2; ++ai)
#pragma unroll
            for (int m = 0; m < 4; ++m) { bf16_t* rowp = O + (size_t)(row0 + ai * HALF + m * 16) * ldc + col0;
#pragma unroll
                for (int bj = 0; bj < 2; ++bj) { const f32x4 v0 = acc[ai][bj][m][0], v1 = acc[ai][bj][m][1];
                    u32x4 w; w.x = cvt_pk_bf16(v0[0], v0[1]); w.y = cvt_pk_bf16(v0[2], v0[3]); w.z = cvt_pk_bf16(v1[0], v1[1]); w.w = cvt_pk_bf16(v1[2], v1[3]);
                    *(u32x4*)(rowp + bj * HALF) = w; } }
    }
};
struct EpiSwiGLU {
    static constexpr bool PERM = true, AFTER_DRAIN = false;
    bf16_t* O; int ldc;
    __device__ __forceinline__ void operator()(const f32x4 (&acc)[2][2][4][2], const Unit& u, int wr, int wc, int fr, int fq) const {
        const int row0 = u.pm * BM + wr * 64 + fr, col0 = u.pn * HALF + wc * 32 + 8 * fq;
#pragma unroll
        for (int ai = 0; ai < 2; ++ai)
#pragma unroll
            for (int m = 0; m < 4; ++m) { bf16_t* rowp = O + (size_t)(row0 + ai * HALF + m * 16) * ldc + col0;
                float r[8];
#pragma unroll
                for (int n = 0; n < 2; ++n)
#pragma unroll
                    for (int i = 0; i < 4; ++i) { const float g = acc[ai][0][m][n][i], up = acc[ai][1][m][n][i];
                        r[n * 4 + i] = g * up * __builtin_amdgcn_rcpf(1.0f + __builtin_amdgcn_exp2f(-1.4426950408889634f * g)); }
                u32x4 w; w.x = cvt_pk_bf16(r[0], r[1]); w.y = cvt_pk_bf16(r[2], r[3]); w.z = cvt_pk_bf16(r[4], r[5]); w.w = cvt_pk_bf16(r[6], r[7]);
                *(u32x4*)(rowp) = w; }
    }
};

template <class Epi, class Sched, bool ALIGN_EPI = false, bool SP2 = false>
__device__ __forceinline__ void gemm_phase(PG8_LAS unsigned char* lds, const Gemm g, const Sched& S, const Epi& E) {
    const int tid = threadIdx.x, wid = __builtin_amdgcn_readfirstlane(tid >> 6), lane = tid & 63, wr = wid >> 2, wc = wid & 3, fr = lane & 15, fq = lane >> 4;
    const int K = g.K, nt = K / BK;
    unsigned voffA[2], voffB[2];
#pragma unroll
    for (int i = 0; i < 2; ++i) { int R, C; stage_rc(tid * 16 + i * 8192, R, C); const int Rb = Epi::PERM ? ((R & ~31) + perm32(R & 31)) : R;
        voffA[i] = (unsigned)(R * g.lda + C) * 2u; voffB[i] = (unsigned)(Rb * K + C) * 2u; }
    const size_t kstep = (size_t)(BK * 2);
    const size_t hstep = (size_t)HALF * K * 2, hstepA = (size_t)HALF * g.lda * 2;
    const size_t tstep = 2 * hstep, tstepA = 2 * hstepA;
    const unsigned ldsw = (unsigned)wid * 1024u;
    const int aoff = lds_byte(wr * 64 + fr, fq * 8), boff = lds_byte(wc * 32 + fr, fq * 8);
#define PG8_SA(b, h) (((b) * 2 + (h)) * HTB)
#define PG8_SB(b, h) ((4 + (b) * 2 + (h)) * HTB)
#define PG8_STAGE(bufoff, gbase, voff) do { _Pragma("unroll") for (int _i = 0; _i < 2; ++_i) \
        __builtin_amdgcn_global_load_lds((const unsigned*)((const char*)(gbase) + (voff)[_i]), (PG8_LAS unsigned*)(lds + (bufoff) + ldsw + _i * 8192), 16, 0, 0); } while (0)
#define PG8_LDA(dst, b, h) do { _Pragma("unroll") for (int m = 0; m < 4; ++m) _Pragma("unroll") for (int k = 0; k < 2; ++k) dst[m][k] = *(const PG8_LAS bf16x8*)(lds + PG8_SA(b, h) + aoff + m * 2048 + k * 1024); } while (0)
#define PG8_LDB(dst, b, h) do { _Pragma("unroll") for (int n = 0; n < 2; ++n) _Pragma("unroll") for (int k = 0; k < 2; ++k) dst[n][k] = *(const PG8_LAS bf16x8*)(lds + PG8_SB(b, h) + boff + n * 2048 + k * 1024); } while (0)
#define PG8_MMA(ai, bj, At, Bt) do { __builtin_amdgcn_s_setprio(1); _Pragma("unroll") for (int m = 0; m < 4; ++m) _Pragma("unroll") for (int n = 0; n < 2; ++n) _Pragma("unroll") for (int k = 0; k < 2; ++k) \
        acc[ai][bj][m][n] = __builtin_amdgcn_mfma_f32_16x16x32_bf16(Bt[n][k], At[m][k], acc[ai][bj][m][n], 0, 0, 0); __builtin_amdgcn_s_setprio(0); } while (0)
#define PG8_WAIT_V(n) asm volatile("s_waitcnt vmcnt(" #n ")" ::: "memory")
#define PG8_WAIT_L(n) asm volatile("s_waitcnt lgkmcnt(" #n ")" ::: "memory")
#define PG8_BAR __builtin_amdgcn_s_barrier()
#define PG8_SCHED __builtin_amdgcn_sched_barrier(0)
    Unit cur, nxt; int ui = 0;
    if (!S.next(0, cur)) return;
    f32x4 acc[2][2][4][2];
#pragma unroll
    for (int a = 0; a < 2; ++a)
#pragma unroll
        for (int b = 0; b < 2; ++b)
#pragma unroll
            for (int m = 0; m < 4; ++m)
#pragma unroll
                for (int n = 0; n < 2; ++n) acc[a][b][m][n] = (f32x4){0.f, 0.f, 0.f, 0.f};
    bf16x8 At[4][2], B0[2][2], B1[2][2];
    const char* cA = (const char*)g.A + (size_t)cur.pm * tstepA; const char* cB = (const char*)g.Bt + (size_t)cur.pn * tstep;
    S.a_ready(cur);
    if constexpr (SP2) {
        PG8_STAGE(PG8_SB(0, 0), cB, voffB); PG8_STAGE(PG8_SB(0, 1), cB + hstep, voffB); PG8_STAGE(PG8_SA(0, 0), cA, voffA); PG8_STAGE(PG8_SA(0, 1), cA + hstepA, voffA);
        if (wr == 1) PG8_BAR;
        PG8_WAIT_V(2); PG8_BAR;
        PG8_STAGE(PG8_SB(1, 0), cB + kstep, voffB); PG8_STAGE(PG8_SA(1, 0), cA + kstep, voffA); PG8_STAGE(PG8_SB(1, 1), cB + hstep + kstep, voffB);
        PG8_WAIT_V(6); PG8_BAR;
    } else {
        PG8_STAGE(PG8_SB(0, 0), cB, voffB); PG8_STAGE(PG8_SA(0, 0), cA, voffA); PG8_STAGE(PG8_SB(0, 1), cB + hstep, voffB); PG8_STAGE(PG8_SA(0, 1), cA + hstepA, voffA);
        if (wr == 1) PG8_BAR;
        PG8_WAIT_V(4); PG8_BAR;
        PG8_STAGE(PG8_SB(1, 0), cB + kstep, voffB); PG8_STAGE(PG8_SA(1, 0), cA + kstep, voffA); PG8_STAGE(PG8_SB(1, 1), cB + hstep + kstep, voffB);
        PG8_WAIT_V(6); PG8_BAR;
    }
    for (;;) {
        const bool has_next = S.next(ui + 1, nxt);
        const char* nA = has_next ? (const char*)g.A + (size_t)nxt.pm * tstepA : cA; const char* nB = has_next ? (const char*)g.Bt + (size_t)nxt.pn * tstep : cB;
        for (int t = 0; t < nt; t += 2) {
            const bool last = (t == nt - 2);
            const char* a1 = cA + (size_t)(t + 1) * kstep;
            const char* a2 = last ? nA : cA + (size_t)(t + 2) * kstep; const char* b2 = last ? nB : cB + (size_t)(t + 2) * kstep;
            const char* a3 = a2 + kstep; const char* b3 = b2 + kstep;
            if (last && has_next) S.a_ready(nxt);
            if constexpr (SP2) {
            PG8_LDB(B0, 0, 0); PG8_LDB(B1, 0, 1); PG8_SCHED; PG8_LDA(At, 0, 0); PG8_STAGE(PG8_SA(1, 1), a1 + hstepA, voffA);
            PG8_WAIT_V(8); PG8_WAIT_L(0); PG8_BAR; PG8_MMA(0, 0, At, B0); PG8_MMA(0, 1, At, B1); PG8_BAR; PG8_SCHED;
            PG8_LDA(At, 0, 1); PG8_STAGE(PG8_SB(0, 0), b2, voffB); PG8_STAGE(PG8_SB(0, 1), b2 + hstep, voffB); PG8_STAGE(PG8_SA(0, 0), a2, voffA);
            PG8_WAIT_V(8); PG8_WAIT_L(0); PG8_BAR; PG8_MMA(1, 0, At, B0); PG8_MMA(1, 1, At, B1); PG8_BAR; PG8_SCHED;
            PG8_LDB(B0, 1, 0); PG8_LDB(B1, 1, 1); PG8_SCHED; PG8_LDA(At, 1, 0); PG8_STAGE(PG8_SA(0, 1), a2 + hstepA, voffA);
            PG8_WAIT_V(8); PG8_WAIT_L(0); PG8_BAR; PG8_MMA(0, 0, At, B0); PG8_MMA(0, 1, At, B1); PG8_BAR; PG8_SCHED;
            PG8_LDA(At, 1, 1); PG8_STAGE(PG8_SB(1, 0), b3, voffB); PG8_STAGE(PG8_SB(1, 1), b3 + hstep, voffB); PG8_STAGE(PG8_SA(1, 0), a3, voffA);
            PG8_WAIT_V(8); PG8_WAIT_L(0); PG8_BAR; PG8_MMA(1, 0, At, B0); PG8_MMA(1, 1, At, B1); PG8_BAR; PG8_SCHED;
            } else {
            PG8_LDB(B0, 0, 0); PG8_SCHED; PG8_LDA(At, 0, 0); PG8_STAGE(PG8_SA(1, 1), a1 + hstepA, voffA);
            PG8_WAIT_L(8); PG8_BAR; PG8_WAIT_L(0); PG8_MMA(0, 0, At, B0); PG8_BAR; PG8_SCHED;
            PG8_LDB(B1, 0, 1); PG8_STAGE(PG8_SB(0, 0), b2, voffB);
            PG8_BAR; PG8_WAIT_L(0); PG8_MMA(0, 1, At, B1); PG8_BAR;
            PG8_LDA(At, 0, 1); PG8_STAGE(PG8_SA(0, 0), a2, voffA);
            PG8_BAR; PG8_WAIT_L(0); PG8_MMA(1, 0, At, B0); PG8_BAR; PG8_SCHED;
            PG8_STAGE(PG8_SB(0, 1), b2 + hstep, voffB);
            PG8_WAIT_V(6); PG8_BAR; PG8_MMA(1, 1, At, B1); PG8_BAR;
            PG8_LDB(B0, 1, 0); PG8_SCHED; PG8_LDA(At, 1, 0); PG8_STAGE(PG8_SA(0, 1), a2 + hstepA, voffA);
            PG8_WAIT_L(8); PG8_BAR; PG8_WAIT_L(0); PG8_MMA(0, 0, At, B0); PG8_BAR; PG8_SCHED;
            PG8_LDB(B1, 1, 1); PG8_STAGE(PG8_SB(1, 0), b3, voffB);
            PG8_BAR; PG8_WAIT_L(0); PG8_MMA(0, 1, At, B1); PG8_BAR;
            PG8_LDA(At, 1, 1); PG8_STAGE(PG8_SA(1, 0), a3, voffA);
            PG8_BAR; PG8_WAIT_L(0); PG8_MMA(1, 0, At, B0); PG8_BAR; PG8_SCHED;
            PG8_STAGE(PG8_SB(1, 1), b3 + hstep, voffB);
            PG8_WAIT_V(6); PG8_BAR; PG8_MMA(1, 1, At, B1); PG8_BAR;
            }
        }
        if constexpr (ALIGN_EPI) { if (wr == 0) PG8_BAR; }
        if constexpr (!Epi::AFTER_DRAIN) { E(acc, cur, wr, wc, fr, fq); S.done(cur); }
        if (!has_next) break;
#pragma unroll
        for (int a = 0; a < 2; ++a)
#pragma unroll
            for (int b = 0; b < 2; ++b)
#pragma unroll
                for (int m = 0; m < 4; ++m)
#pragma unroll
                    for (int n = 0; n < 2; ++n) acc[a][b][m][n] = (f32x4){0.f, 0.f, 0.f, 0.f};
        cur = nxt; cA = nA; cB = nB; ++ui;
        if constexpr (ALIGN_EPI) { if (wr == 1) PG8_BAR; }
    }
    PG8_WAIT_V(0);
    if constexpr (!ALIGN_EPI) { if (wr == 0) PG8_BAR; }
    PG8_BAR;
    if constexpr (Epi::AFTER_DRAIN) { E.fused(acc, cur, wr, wc, fr, fq, lds, wid, lane); S.done(cur); }
#undef PG8_SA
#undef PG8_SB
#undef PG8_STAGE
#undef PG8_LDA
#undef PG8_LDB
#undef PG8_MMA
#undef PG8_WAIT_V
#undef PG8_WAIT_L
#undef PG8_BAR
#undef PG8_SCHED
}}

constexpr int NWAVES = 8, NTHREADS = NWAVES * 64;
constexpr int D = 1024, BATCH_P = 8, SEQ_P = 2048, BATCH_S = 128, SEQ_S = 8;
constexpr int MP = BATCH_P * SEQ_P, MS = BATCH_S * SEQ_S, M = MP + MS;
constexpr int NSEQ = BATCH_P + BATCH_S;
constexpr int SCW = 1024, SSMW = 1024, NH = 16, HP = 64, NG = 4, NS = 128, XBC = 2048;
constexpr int NPROJ = 6160, NPROJ_PAD = 6400, PROJ_LD = 6144;
constexpr int C_SCB = 0, C_SCC = 1024, C_SCX = 2048, C_Z = 3072, C_XBC = 4096;
constexpr int FF = 2816, NGU = 2 * FF;
constexpr float EPS = 1e-6f;
constexpr size_t O_Y = 0, O_SCP = (size_t)M * D, O_CVP = O_SCP + (size_t)BATCH_P * 2 * SCW, O_SSMP = O_CVP + (size_t)BATCH_P * 3 * XBC,
                 O_SCS = O_SSMP + (size_t)BATCH_P * NH * HP * NS, O_CVS = O_SCS + (size_t)BATCH_S * 2 * SCW, O_SSMS = O_CVS + (size_t)BATCH_S * 3 * XBC,
                 O_END = O_SSMS + (size_t)BATCH_S * NH * HP * NS;
static_assert(O_END == 36765696ull, "output size");
constexpr size_t MiB = 1u << 20;
constexpr size_t WS_CTL = 0, CTL_ZERO_BYTES = 1 * MiB;
constexpr size_t WS_MOD = 1 * MiB;
constexpr size_t WS_WIN = 5 * MiB;
constexpr size_t WS_WOUT = 18 * MiB;
constexpr size_t WS_WGU = 22 * MiB;
constexpr size_t WS_WD = 33 * MiB;
constexpr size_t WS_DT = 39 * MiB;
constexpr size_t WS_PROJ = 41 * MiB;
constexpr size_t WS_ACT = 41 * MiB;
constexpr size_t WS_XN2 = 136 * MiB;
constexpr size_t WS_F = 170 * MiB;
constexpr size_t WS_END = 256 * MiB;
static_assert(WS_PROJ + (size_t)M * PROJ_LD * 2 <= WS_END && WS_ACT + (size_t)M * FF * 2 <= WS_XN2 && WS_XN2 + (size_t)M * D * 2 <= WS_F && WS_F + (size_t)M * D * 4 <= WS_END, "d_ws map");
static_assert(WS_WIN + (size_t)NPROJ_PAD * D * 2 <= WS_WOUT && WS_WD + (size_t)D * FF * 2 <= WS_DT && WS_DT + (size_t)M * 16 * 4 <= WS_PROJ, "d_ws map 2");
constexpr int CW_BAR = 4096;
constexpr int RING_OFF = 0, RING_BYTES = 131072;
constexpr int LDSCTL_OFF = RING_BYTES, MISC_OFF = LDSCTL_OFF + 320;
constexpr int LDS_BYTES = 147456;
static_assert(MISC_OFF + 128 <= LDS_BYTES, "LDS map");

#define GAS __attribute__((address_space(1)))
#define LAS __attribute__((address_space(3)))
typedef unsigned short bf16;
typedef unsigned v4u __attribute__((ext_vector_type(4)));
typedef unsigned v2u __attribute__((ext_vector_type(2)));
typedef float f32x4 __attribute__((ext_vector_type(4)));
typedef GAS unsigned gu32;
#define RLX_AGENT __ATOMIC_RELAXED, __HIP_MEMORY_SCOPE_AGENT
#define LDS_WAIT() asm volatile("s_waitcnt lgkmcnt(0)" ::: "memory")
#define VM_WAIT() asm volatile("s_waitcnt vmcnt(0)" ::: "memory")
__device__ __forceinline__ unsigned f2bf(float f) { unsigned u = __builtin_bit_cast(unsigned, f); return (u + 0x7fffu + ((u >> 16) & 1u)) >> 16; }
__device__ __forceinline__ unsigned pk2(float lo, float hi) { return f2bf(lo) | (f2bf(hi) << 16); }
__device__ __forceinline__ float bflo(unsigned u) { return __builtin_bit_cast(float, u << 16); }
__device__ __forceinline__ float bfhi(unsigned u) { return __builtin_bit_cast(float, u & 0xffff0000u); }
__device__ __forceinline__ float bf1(bf16 h) { return __builtin_bit_cast(float, (unsigned)h << 16); }
__device__ __forceinline__ float silu_f(float v) { return v * __builtin_amdgcn_rcpf(1.0f + __builtin_amdgcn_exp2f(-1.4426950408889634f * v)); }
__device__ __forceinline__ float softplus_f(float v) { return v > 20.f ? v : log1pf(__expf(v)); }

#define XB_TMO      128
#define XB_XCNT(j)  (256  + 64 * (j))
#define XB_XSUB(j)  (1280 + 64 * (j))
#define XB_XGEN(j)  (2304 + 64 * (j))
#define XB_TOP      3328
#define XB_TOPGEN   3392
#define XCD_BAR_WORDS 3456
#define XB_SPIN_CAP (1u << 18)
__device__ __forceinline__ unsigned xb_ld(unsigned* p)              { return __hip_atomic_load(p, __ATOMIC_RELAXED, __HIP_MEMORY_SCOPE_AGENT); }
__device__ __forceinline__ unsigned xb_add(unsigned* p, unsigned v) { return __hip_atomic_fetch_add(p, v, __ATOMIC_RELAXED, __HIP_MEMORY_SCOPE_AGENT); }
__device__ __forceinline__ unsigned xb_xcc_id() { return (unsigned)__builtin_amdgcn_s_getreg((3 << 11) | 20) & 0xFu; }
#define XB_SPIN(cond, bar) do { unsigned _sp = 0; while (cond) { __builtin_amdgcn_s_sleep(1); \
    if ((++_sp & 255u) == 0u) { if (xb_ld(&(bar)[XB_TMO])) break; if (_sp > XB_SPIN_CAP) { atomicAdd(&(bar)[XB_TMO], 1u); break; } } } } while (0)
struct XcdBarrier { unsigned* bar; unsigned x; volatile LAS unsigned* st; };
__device__ __forceinline__ XcdBarrier xcd_barrier_post(unsigned* bar, volatile LAS unsigned* st) {
    XcdBarrier b; b.bar = bar; b.x = xb_xcc_id(); b.st = st;
    if (threadIdx.x == 0) (void)xb_add(&bar[XB_XCNT(b.x)], 1u);
    return b;
}
__device__ __forceinline__ void xcd_barrier_complete(unsigned* bar, unsigned x, unsigned& nloc, unsigned& nx) {
    const unsigned G = gridDim.x * gridDim.y * gridDim.z;
    unsigned sum, cnt, mine, sp = 0u;
    for (;;) {
        sum = 0u; cnt = 0u; mine = 0u;
#pragma unroll
        for (unsigned j = 0; j < 16; ++j) { const unsigned c = xb_ld(&bar[XB_XCNT(j)]); sum += c; cnt += (c > 0u) ? 1u : 0u; mine = (j == x) ? c : mine; }
        if (sum == G) break;
        __builtin_amdgcn_s_sleep(1);
        if ((++sp & 255u) == 0u) { if (xb_ld(&bar[XB_TMO])) break; if (sp > XB_SPIN_CAP) { atomicAdd(&bar[XB_TMO], 1u); break; } }
    }
    nloc = mine > 0u ? mine : 1u; nx = cnt > 0u ? cnt : 1u;
}
__device__ __forceinline__ void xcd_barrier(const XcdBarrier& b) {
    asm volatile("s_waitcnt vmcnt(0)" ::: "memory");
    __syncthreads();
    if (threadIdx.x == 0) {
        unsigned* bar = b.bar;
        __builtin_amdgcn_s_waitcnt(0);
        unsigned nloc = b.st[0], nx = b.st[1];
        if (nloc == 0u) { xcd_barrier_complete(bar, b.x, nloc, nx); b.st[0] = nloc; b.st[1] = nx; }
        const unsigned old = xb_add(&bar[XB_XSUB(b.x)], 1u);
        const unsigned gen = old / nloc;
        if (old + 1u == (gen + 1u) * nloc) {
            __builtin_amdgcn_fence(__ATOMIC_RELEASE, "agent");
            asm volatile("s_waitcnt vmcnt(0)" ::: "memory");
            const unsigned og = xb_add(&bar[XB_TOP], 1u);
            const unsigned tg = og / nx;
            if (og + 1u == (tg + 1u) * nx) xb_add(&bar[XB_TOPGEN], 1u);
            else XB_SPIN(xb_ld(&bar[XB_TOPGEN]) == tg, bar);
            __builtin_amdgcn_fence(__ATOMIC_ACQUIRE, "agent");
            xb_add(&bar[XB_XGEN(b.x)], 1u);
            asm volatile("s_waitcnt vmcnt(0)" ::: "memory");
        } else {
            XB_SPIN(xb_ld(&bar[XB_XGEN(b.x)]) == gen, bar);
            __builtin_amdgcn_fence(__ATOMIC_ACQUIRE, "agent");
            asm volatile("s_waitcnt vmcnt(0)" ::: "memory");
        }
    }
    __syncthreads();
}

struct Args { const float* in[25]; float* out; unsigned char* ws; int ph_lo, ph_hi; };
struct Frame {
    LAS unsigned char* lds;
    volatile LAS unsigned* MISC;
    gu32* ctl;
    int tid, lane, wave, G;
    const float *x_p, *x_s, *c_p, *c_s, *st_sc, *st_cv, *st_ssm, *w_ada, *b_ada, *g_mpre, *g_mpost, *g_fpre, *g_fpost, *w_in, *sc_w, *cv_w, *cv_b, *dt_bias, *a_log, *d_skip, *ssm_g, *w_out, *w_gate, *w_up, *w_down;
    float* out;
    float* mod; bf16 *Win_t, *Wout_t, *Wgu_t, *Wd_t; float* dtraw; bf16 *proj, *act, *xn2; float* fbuf;
    bf16* xn1;
    bf16* xbcc;
    float* mix;
};
__device__ __forceinline__ float wave_sum(float v) {
#pragma unroll
    for (int o = 1; o < 64; o <<= 1) v += __shfl_xor(v, o);
    return v;
}
__device__ __forceinline__ const float* x_row(const Frame& F, int m) { return m < MP ? F.x_p + (size_t)m * D : F.x_s + (size_t)(m - MP) * D; }
__device__ __forceinline__ int seq_of(int m) { return m < MP ? (m >> 11) : BATCH_P + ((m - MP) >> 3); }

__device__ __forceinline__ void p0_transpose_item(const float* W, int K, int N, int nblk, bf16* WT, int mode, LAS float* scr, int item, int lane) {
    const int kb = item / nblk, nb = item % nblk, k0 = 64 * kb, n0 = 32 * nb;
    const bool ok = (n0 + (lane & 31)) < N;
#pragma unroll 8
    for (int i = 0; i < 32; ++i) { const int kk = 2 * i + (lane >> 5); scr[kk * 33 + (lane & 31)] = ok ? W[(size_t)(k0 + kk) * N + n0 + (lane & 31)] : 0.f; }
    LDS_WAIT(); asm volatile("" ::: "memory");
    const int c = lane & 7;
    const int r0 = mode == 0 ? n0 : ((n0 >> 7) * 256 + (n0 & 127) + (mode == 2 ? 128 : 0));
#pragma unroll
    for (int j = 0; j < 4; ++j) { const int n = (lane >> 3) + 8 * j; const LAS float* s = scr + (8 * c) * 33 + n;
        v4u o; o.x = pk2(s[0 * 33], s[1 * 33]); o.y = pk2(s[2 * 33], s[3 * 33]); o.z = pk2(s[4 * 33], s[5 * 33]); o.w = pk2(s[6 * 33], s[7 * 33]);
        *(v4u*)(WT + (size_t)(r0 + n) * K + k0 + 8 * c) = o; }
    LDS_WAIT(); asm volatile("" ::: "memory");
}

__device__ __forceinline__ void p0_prologue(Frame& F) {
    {
        LAS float* sc = (LAS float*)(F.lds + RING_OFF);
        for (int it = blockIdx.x; it < 17 * 12; it += F.G) {
            const int sg = it / 12, cb = it % 12, s0 = sg * 8;
            for (int idx = F.tid; idx < 8192; idx += NTHREADS) { const int sl = idx >> 10, k = idx & 1023, s = s0 + sl;
                const float* cp = s < BATCH_P ? F.c_p + (size_t)s * D : F.c_s + (size_t)(s - BATCH_P) * D; sc[k * 8 + sl] = silu_f(cp[k]); }
            __syncthreads();
            const int j = cb * 512 + F.tid; float acc[8];
#pragma unroll
            for (int i = 0; i < 8; ++i) acc[i] = 0.f;
#pragma unroll 8
            for (int k = 0; k < D; ++k) { const float w = F.w_ada[(size_t)k * 6144 + j]; const f32x4 a = *(const LAS f32x4*)(sc + k * 8), b = *(const LAS f32x4*)(sc + k * 8 + 4);
                acc[0] += a[0] * w; acc[1] += a[1] * w; acc[2] += a[2] * w; acc[3] += a[3] * w; acc[4] += b[0] * w; acc[5] += b[1] * w; acc[6] += b[2] * w; acc[7] += b[3] * w; }
            const float bj = F.b_ada[j];
#pragma unroll
            for (int i = 0; i < 8; ++i) F.mod[(size_t)(s0 + i) * 6144 + j] = acc[i] + bj;
            __syncthreads();
        }
    }
    LAS float* scr = (LAS float*)(F.lds + RING_OFF + F.wave * 16384);
    const int gw = blockIdx.x * NWAVES + F.wave, NGW = F.G * NWAVES;
    constexpr int I_IN = (D / 64) * (NPROJ_PAD / 32), I_OUT = (2048 / 64) * (D / 32), I_G = (D / 64) * (FF / 32), I_D = (FF / 64) * (D / 32);
    constexpr int NITEMS = I_IN + I_OUT + 2 * I_G + I_D;
    for (int it = gw; it < NITEMS; it += NGW) {
        int r = it;
        if (r < I_IN) { p0_transpose_item(F.w_in, D, NPROJ, NPROJ_PAD / 32, F.Win_t, 0, scr, r, F.lane); continue; } r -= I_IN;
        if (r < I_OUT) { p0_transpose_item(F.w_out, 2048, D, D / 32, F.Wout_t, 0, scr, r, F.lane); continue; } r -= I_OUT;
        if (r < I_G) { p0_transpose_item(F.w_gate, D, FF, FF / 32, F.Wgu_t, 1, scr, r, F.lane); continue; } r -= I_G;
        if (r < I_G) { p0_transpose_item(F.w_up, D, FF, FF / 32, F.Wgu_t, 2, scr, r, F.lane); continue; } r -= I_G;
        p0_transpose_item(F.w_down, FF, D, D / 32, F.Wd_t, 0, scr, r, F.lane);
    }
}
__device__ __forceinline__ void p1_hrows(Frame& F) {
    const int gw = blockIdx.x * NWAVES + F.wave, NGW = F.G * NWAVES;
    for (int m = gw; m < M; m += NGW) {
        const f32x4* xr = (const f32x4*)x_row(F, m) + F.lane; const float* md = F.mod + (size_t)seq_of(m) * 6144;
        f32x4 v[4]; float ss = 0.f;
#pragma unroll
        for (int j = 0; j < 4; ++j) { v[j] = xr[64 * j]; ss += (v[j].x * v[j].x + v[j].y * v[j].y) + (v[j].z * v[j].z + v[j].w * v[j].w); }
        const float rstd = 1.0f / sqrtf(wave_sum(ss) * (1.f / D) + EPS);
        unsigned long long* o8 = (unsigned long long*)(F.xn1 + (size_t)m * D) + F.lane;
#pragma unroll
        for (int j = 0; j < 4; ++j) { const int col = 256 * j + 4 * F.lane; const f32x4 g = *(const f32x4*)(F.g_mpre + col), sh = *(const f32x4*)(md + col), sc = *(const f32x4*)(md + 1024 + col);
            const f32x4 h = (v[j] * rstd) * g * (sc + 1.0f) + sh;
            o8[64 * j] = (unsigned long long)pk2(h.x, h.y) | ((unsigned long long)pk2(h.z, h.w) << 32); }
    }
}
__device__ __forceinline__ void unpack8(const v4u q, float (&f)[8]) { f[0] = bflo(q.x); f[1] = bfhi(q.x); f[2] = bflo(q.y); f[3] = bfhi(q.y); f[4] = bflo(q.z); f[5] = bfhi(q.z); f[6] = bflo(q.w); f[7] = bfhi(q.w); }
__device__ __forceinline__ void p3_conv(Frame& F) {
    const long total = (long)M * 384;
    for (long idx = (long)blockIdx.x * NTHREADS + F.tid; idx < total; idx += (long)F.G * NTHREADS) {
        const int r = (int)(idx / 384), ch = (int)(idx % 384);
        int b, t, L; bool samp;
        if (r < MP) { b = r >> 11; t = r & 2047; L = SEQ_P; samp = false; } else { const int rr = r - MP; b = rr >> 3; t = rr & 7; L = SEQ_S; samp = true; }
        const bf16* prow = F.proj + (size_t)r * PROJ_LD;
        if (ch < 128) {
            const int c0 = ch * 8;
            float acc[8], e[8];
#pragma unroll
            for (int i = 0; i < 8; ++i) acc[i] = 0.f;
#pragma unroll
            for (int j = 0; j < 3; ++j) {
                const int ee = t + j;
                if (ee < 2) {
                    if (samp) { const float* bp = F.st_sc + ((size_t)b * 2 + ee) * SCW + c0; const f32x4 a = *(const f32x4*)bp, bb = *(const f32x4*)(bp + 4);
                        e[0] = a.x; e[1] = a.y; e[2] = a.z; e[3] = a.w; e[4] = bb.x; e[5] = bb.y; e[6] = bb.z; e[7] = bb.w; }
                    else {
#pragma unroll
                        for (int i = 0; i < 8; ++i) e[i] = 0.f; }
                } else {
                    const bf16* pr = prow + (ptrdiff_t)(j - 2) * PROJ_LD; float cc[8], xx[8];
                    unpack8(*(const v4u*)(pr + C_SCC + c0), cc); unpack8(*(const v4u*)(pr + C_SCX + c0), xx);
#pragma unroll
                    for (int i = 0; i < 8; ++i) e[i] = cc[i] * xx[i];
                }
                const float* wp = F.sc_w + (size_t)j * SCW + c0; const f32x4 w0 = *(const f32x4*)wp, w1 = *(const f32x4*)(wp + 4);
                acc[0] += w0.x * e[0]; acc[1] += w0.y * e[1]; acc[2] += w0.z * e[2]; acc[3] += w0.w * e[3]; acc[4] += w1.x * e[4]; acc[5] += w1.y * e[5]; acc[6] += w1.z * e[6]; acc[7] += w1.w * e[7];
            }
            if (t >= L - 2) { float* op = F.out + (samp ? O_SCS : O_SCP) + ((size_t)b * 2 + (t - (L - 2))) * SCW + c0;
                *(f32x4*)op = (f32x4){e[0], e[1], e[2], e[3]}; *(f32x4*)(op + 4) = (f32x4){e[4], e[5], e[6], e[7]}; }
            float bb[8]; unpack8(*(const v4u*)(prow + C_SCB + c0), bb);
            v4u o; o.x = pk2(bb[0] * acc[0], bb[1] * acc[1]); o.y = pk2(bb[2] * acc[2], bb[3] * acc[3]); o.z = pk2(bb[4] * acc[4], bb[5] * acc[5]); o.w = pk2(bb[6] * acc[6], bb[7] * acc[7]);
            *(v4u*)(F.proj + (size_t)r * PROJ_LD + C_SCB + c0) = o;
        } else {
            const int c0 = (ch - 128) * 8;
            float acc[8], e[8];
            { const f32x4 a = *(const f32x4*)(F.cv_b + c0), bb = *(const f32x4*)(F.cv_b + c0 + 4); acc[0] = a.x; acc[1] = a.y; acc[2] = a.z; acc[3] = a.w; acc[4] = bb.x; acc[5] = bb.y; acc[6] = bb.z; acc[7] = bb.w; }
#pragma unroll
            for (int j = 0; j < 4; ++j) {
                const int ee = t + j;
                if (ee < 3) {
                    if (samp) { const float* bp = F.st_cv + ((size_t)b * 3 + ee) * XBC + c0; const f32x4 a = *(const f32x4*)bp, bb = *(const f32x4*)(bp + 4);
                        e[0] = a.x; e[1] = a.y; e[2] = a.z; e[3] = a.w; e[4] = bb.x; e[5] = bb.y; e[6] = bb.z; e[7] = bb.w; }
                    else {
#pragma unroll
                        for (int i = 0; i < 8; ++i) e[i] = 0.f; }
                } else unpack8(*(const v4u*)(prow + (ptrdiff_t)(j - 3) * PROJ_LD + C_XBC + c0), e);
                const float* wp = F.cv_w + (size_t)j * XBC + c0; const f32x4 w0 = *(const f32x4*)wp, w1 = *(const f32x4*)(wp + 4);
                acc[0] += w0.x * e[0]; acc[1] += w0.y * e[1]; acc[2] += w0.z * e[2]; acc[3] += w0.w * e[3]; acc[4] += w1.x * e[4]; acc[5] += w1.y * e[5]; acc[6] += w1.z * e[6]; acc[7] += w1.w * e[7];
            }
            if (t >= L - 3) { float* op = F.out + (samp ? O_CVS : O_CVP) + ((size_t)b * 3 + (t - (L - 3))) * XBC + c0;
                *(f32x4*)op = (f32x4){e[0], e[1], e[2], e[3]}; *(f32x4*)(op + 4) = (f32x4){e[4], e[5], e[6], e[7]}; }
            v4u o; o.x = pk2(silu_f(acc[0]), silu_f(acc[1])); o.y = pk2(silu_f(acc[2]), silu_f(acc[3])); o.z = pk2(silu_f(acc[4]), silu_f(acc[5])); o.w = pk2(silu_f(acc[6]), silu_f(acc[7]));
            *(v4u*)(F.xbcc + (size_t)r * XBC + c0) = o;
        }
    }
}
__device__ __forceinline__ void p4_scan(Frame& F) {
    const int p = F.tid >> 3, nq = F.tid & 7;
    const int nitems = NSEQ * NH;
    for (int it = blockIdx.x; it < nitems; it += F.G) {
        const int s = it / NH, h = it % NH, g = h >> 2;
        const bool samp = s >= BATCH_P; const int b = samp ? s - BATCH_P : s; const int L = samp ? SEQ_S : SEQ_P; const int row0 = samp ? MP + b * SEQ_S : b * SEQ_P;
        float S[16];
        if (samp) { const float* sp = F.st_ssm + (((size_t)b * NH + h) * HP + p) * NS + nq * 16;
#pragma unroll
            for (int i = 0; i < 4; ++i) { const f32x4 a = *(const f32x4*)(sp + 4 * i); S[4 * i] = a.x; S[4 * i + 1] = a.y; S[4 * i + 2] = a.z; S[4 * i + 3] = a.w; } }
        else {
#pragma unroll
            for (int i = 0; i < 16; ++i) S[i] = 0.f; }
        const float A = -__expf(F.a_log[h]), dtb = F.dt_bias[h], Dh = F.d_skip[h];
        for (int t0 = 0; t0 < L; t0 += 8) {
            v4u Bq[8][2], Cq[8][2]; float xv[8], dtv[8];
#pragma unroll
            for (int u = 0; u < 8; ++u) { const int r = row0 + t0 + u; const bf16* xr = F.xbcc + (size_t)r * XBC;
                Bq[u][0] = *(const v4u*)(xr + 1024 + g * NS + nq * 16); Bq[u][1] = *(const v4u*)(xr + 1024 + g * NS + nq * 16 + 8);
                Cq[u][0] = *(const v4u*)(xr + 1536 + g * NS + nq * 16); Cq[u][1] = *(const v4u*)(xr + 1536 + g * NS + nq * 16 + 8);
                xv[u] = bf1(xr[h * HP + p]); dtv[u] = F.dtraw[(size_t)r * 16 + h]; }
#pragma unroll
            for (int u = 0; u < 8; ++u) {
                const float dt = softplus_f(dtv[u] + dtb), dA = __expf(dt * A), xdt = dt * xv[u];
                float Bf[16], Cf[16]; { float t8[8]; unpack8(Bq[u][0], t8);
#pragma unroll
                    for (int i = 0; i < 8; ++i) Bf[i] = t8[i];
                    unpack8(Bq[u][1], t8);
#pragma unroll
                    for (int i = 0; i < 8; ++i) Bf[8 + i] = t8[i];
                    unpack8(Cq[u][0], t8);
#pragma unroll
                    for (int i = 0; i < 8; ++i) Cf[i] = t8[i];
                    unpack8(Cq[u][1], t8);
#pragma unroll
                    for (int i = 0; i < 8; ++i) Cf[8 + i] = t8[i]; }
                float y = 0.f;
#pragma unroll
                for (int i = 0; i < 16; ++i) { S[i] = S[i] * dA + xdt * Bf[i]; y += Cf[i] * S[i]; }
                y += __shfl_xor(y, 1); y += __shfl_xor(y, 2); y += __shfl_xor(y, 4);
                y += Dh * xv[u];
                if (nq == 0) F.proj[(size_t)(row0 + t0 + u) * PROJ_LD + C_SCX + h * HP + p] = (bf16)f2bf(y);
            }
        }
        float* op = F.out + (samp ? O_SSMS : O_SSMP) + (((size_t)b * NH + h) * HP + p) * NS + nq * 16;
#pragma unroll
        for (int i = 0; i < 4; ++i) *(f32x4*)(op + 4 * i) = (f32x4){S[4 * i], S[4 * i + 1], S[4 * i + 2], S[4 * i + 3]};
    }
}
__device__ __forceinline__ void p5_gatenorm(Frame& F) {
    const int gw = blockIdx.x * NWAVES + F.wave, NGW = F.G * NWAVES;
    for (int it = gw; it < M * NG; it += NGW) {
        const int r = it >> 2, g = it & 3; bf16* prow = F.proj + (size_t)r * PROJ_LD; const int c = g * 256 + 4 * F.lane;
        const v2u yq = *(const v2u*)(prow + C_SCX + c), zq = *(const v2u*)(prow + C_Z + c);
        float v[4]; v[0] = bflo(yq.x) * silu_f(bflo(zq.x)); v[1] = bfhi(yq.x) * silu_f(bfhi(zq.x)); v[2] = bflo(yq.y) * silu_f(bflo(zq.y)); v[3] = bfhi(yq.y) * silu_f(bfhi(zq.y));
        const float ss = wave_sum((v[0] * v[0] + v[1] * v[1]) + (v[2] * v[2] + v[3] * v[3]));
        const float rstd = 1.0f / sqrtf(ss * (1.f / 256.f) + EPS); const f32x4 gg = *(const f32x4*)(F.ssm_g + c);
        v2u o; o.x = pk2(v[0] * rstd * gg.x, v[1] * rstd * gg.y); o.y = pk2(v[2] * rstd * gg.z, v[3] * rstd * gg.w);
        *(v2u*)(prow + C_SCC + c) = o;
    }
}
__device__ __forceinline__ void p7_rows(Frame& F) {
    const int gw = blockIdx.x * NWAVES + F.wave, NGW = F.G * NWAVES;
    for (int m = gw; m < M; m += NGW) {
        const f32x4* xr = (const f32x4*)x_row(F, m) + F.lane; f32x4* mr = (f32x4*)(F.mix + (size_t)m * D) + F.lane; const float* md = F.mod + (size_t)seq_of(m) * 6144;
        f32x4 v[4], x1[4]; float ss = 0.f;
#pragma unroll
        for (int j = 0; j < 4; ++j) { v[j] = mr[64 * j]; ss += (v[j].x * v[j].x + v[j].y * v[j].y) + (v[j].z * v[j].z + v[j].w * v[j].w); }
        const float rstd = 1.0f / sqrtf(wave_sum(ss) * (1.f / D) + EPS); float s2 = 0.f;
#pragma unroll
        for (int j = 0; j < 4; ++j) { const int col = 256 * j + 4 * F.lane; const f32x4 g = *(const f32x4*)(F.g_mpost + col), gt = *(const f32x4*)(md + 2048 + col);
            x1[j] = xr[64 * j] + gt * ((v[j] * rstd) * g); mr[64 * j] = x1[j];
            s2 += (x1[j].x * x1[j].x + x1[j].y * x1[j].y) + (x1[j].z * x1[j].z + x1[j].w * x1[j].w); }
        const float rstd2 = 1.0f / sqrtf(wave_sum(s2) * (1.f / D) + EPS);
        unsigned long long* o8 = (unsigned long long*)(F.xn2 + (size_t)m * D) + F.lane;
#pragma unroll
        for (int j = 0; j < 4; ++j) { const int col = 256 * j + 4 * F.lane; const f32x4 g = *(const f32x4*)(F.g_fpre + col), sh = *(const f32x4*)(md + 3072 + col), sc = *(const f32x4*)(md + 4096 + col);
            const f32x4 h = (x1[j] * rstd2) * g * (sc + 1.0f) + sh;
            o8[64 * j] = (unsigned long long)pk2(h.x, h.y) | ((unsigned long long)pk2(h.z, h.w) << 32); }
    }
}
__device__ __forceinline__ void p10_rows(Frame& F) {
    const int gw = blockIdx.x * NWAVES + F.wave, NGW = F.G * NWAVES;
    for (int m = gw; m < M; m += NGW) {
        const f32x4* fr = (const f32x4*)(F.fbuf + (size_t)m * D) + F.lane; f32x4* yr = (f32x4*)(F.out + (size_t)m * D) + F.lane; const float* md = F.mod + (size_t)seq_of(m) * 6144;
        f32x4 v[4]; float ss = 0.f;
#pragma unroll
        for (int j = 0; j < 4; ++j) { v[j] = fr[64 * j]; ss += (v[j].x * v[j].x + v[j].y * v[j].y) + (v[j].z * v[j].z + v[j].w * v[j].w); }
        const float rstd = 1.0f / sqrtf(wave_sum(ss) * (1.f / D) + EPS);
#pragma unroll
        for (int j = 0; j < 4; ++j) { const int col = 256 * j + 4 * F.lane; const f32x4 g = *(const f32x4*)(F.g_fpost + col), gt = *(const f32x4*)(md + 5120 + col);
            yr[64 * j] = yr[64 * j] + gt * ((v[j] * rstd) * g); }
    }
}

constexpr int NPHASE = 11;
#ifndef MK_ONE_LAUNCH
#define MK_ONE_LAUNCH 1
#endif
__global__ void __launch_bounds__(NTHREADS, 2) hymba_fwd(Args args) {
    extern __shared__ __attribute__((aligned(16))) unsigned char lds[];
    Frame F;
    F.lds = (LAS unsigned char*)lds;
    F.MISC = (volatile LAS unsigned*)(F.lds + MISC_OFF);
    F.tid = threadIdx.x; F.lane = F.tid & 63; F.wave = __builtin_amdgcn_readfirstlane(F.tid >> 6);
    F.G = gridDim.x;
    unsigned char* ws = args.ws;
    F.ctl = (gu32*)(ws + WS_CTL);
    F.x_p = args.in[0]; F.x_s = args.in[1]; F.c_p = args.in[2]; F.c_s = args.in[3]; F.st_sc = args.in[4]; F.st_cv = args.in[5]; F.st_ssm = args.in[6];
    F.w_ada = args.in[7]; F.b_ada = args.in[8]; F.g_mpre = args.in[9]; F.g_mpost = args.in[10]; F.g_fpre = args.in[11]; F.g_fpost = args.in[12];
    F.w_in = args.in[13]; F.sc_w = args.in[14]; F.cv_w = args.in[15]; F.cv_b = args.in[16]; F.dt_bias = args.in[17]; F.a_log = args.in[18]; F.d_skip = args.in[19];
    F.ssm_g = args.in[20]; F.w_out = args.in[21]; F.w_gate = args.in[22]; F.w_up = args.in[23]; F.w_down = args.in[24];
    F.out = args.out;
    F.mod = (float*)(ws + WS_MOD); F.Win_t = (bf16*)(ws + WS_WIN); F.Wout_t = (bf16*)(ws + WS_WOUT); F.Wgu_t = (bf16*)(ws + WS_WGU); F.Wd_t = (bf16*)(ws + WS_WD);
    F.dtraw = (float*)(ws + WS_DT); F.proj = (bf16*)(ws + WS_PROJ); F.act = (bf16*)(ws + WS_ACT); F.xn2 = (bf16*)(ws + WS_XN2); F.fbuf = (float*)(ws + WS_F);
    F.xn1 = (bf16*)(args.out + O_Y); F.xbcc = (bf16*)(args.out + O_Y); F.mix = args.out + O_Y;
    for (int u = F.tid; u < (LDS_BYTES - LDSCTL_OFF) / 4; u += NTHREADS) ((LAS unsigned*)(F.lds + LDSCTL_OFF))[u] = 0u;
    __syncthreads();
    XcdBarrier bar; bar.bar = (unsigned*)(F.ctl + CW_BAR); bar.x = 0; bar.st = nullptr;
    const int lo = args.ph_lo, hi = args.ph_hi;
    if (hi - lo > 1) bar = xcd_barrier_post((unsigned*)(F.ctl + CW_BAR), F.MISC + 8);
#define IN(k) (lo <= (k) && (k) < hi)
#define SEAM(k) do { if (IN(k) && IN((k) + 1)) xcd_barrier(bar); } while (0)

    if (IN(0)) { p0_prologue(F); } SEAM(0);
    if (IN(1)) { p1_hrows(F); } SEAM(1);
    if (IN(2)) {
        pg8::Gemm g{F.xn1, F.Win_t, M, NPROJ_PAD, D, D}; pg8::StaticOrder S; S.init(M, NPROJ_PAD, F.G, (int)blockIdx.x);
        pg8::EpiProj E{F.proj, PROJ_LD, F.dtraw, PROJ_LD / 256};
        pg8::gemm_phase<pg8::EpiProj, pg8::StaticOrder, true, true>(F.lds + RING_OFF, g, S, E);
    } SEAM(2);
    if (IN(3)) { p3_conv(F); } SEAM(3);
    if (IN(4)) { p4_scan(F); } SEAM(4);
    if (IN(5)) { p5_gatenorm(F); } SEAM(5);
    if (IN(6)) {
        pg8::Gemm g{F.proj, F.Wout_t, M, D, 2048, PROJ_LD}; pg8::StaticOrder S; S.init(M, D, F.G, (int)blockIdx.x);
        pg8::EpiF32 E{F.mix, D};
        pg8::gemm_phase<pg8::EpiF32, pg8::StaticOrder, true, true>(F.lds + RING_OFF, g, S, E);
    } SEAM(6);
    if (IN(7)) { p7_rows(F); } SEAM(7);
    if (IN(8)) {
        pg8::Gemm g{F.xn2, F.Wgu_t, M, NGU, D, D}; pg8::StaticOrder S; S.init(M, NGU, F.G, (int)blockIdx.x);
        pg8::EpiSwiGLU E{F.act, FF};
        pg8::gemm_phase<pg8::EpiSwiGLU, pg8::StaticOrder, true, true>(F.lds + RING_OFF, g, S, E);
    } SEAM(8);
    if (IN(9)) {
        pg8::Gemm g{F.act, F.Wd_t, M, D, FF, FF}; pg8::StaticOrder S; S.init(M, D, F.G, (int)blockIdx.x);
        pg8::EpiF32 E{F.fbuf, D};
        pg8::gemm_phase<pg8::EpiF32, pg8::StaticOrder, true, true>(F.lds + RING_OFF, g, S, E);
    } SEAM(9);
    if (IN(10)) { p10_rows(F); }
#undef IN
#undef SEAM
}

extern "C" void kernel_launch(void* const* d_in, const int* in_sizes, int n_in, void* d_out, int out_size, void* d_ws, size_t ws_size, hipStream_t stream) {
    static int grid = 0;
    if (grid == 0) {
        if (n_in != 25 || out_size != (int)O_END || ws_size < WS_END) { fprintf(stderr, "kernel_launch: unexpected sizes n_in %d out %d ws %zu; nothing launched\n", n_in, out_size, ws_size); grid = -1; return; }
        int dev = 0, cus = 0, per_cu = 0;
        if (hipGetDevice(&dev) != hipSuccess || hipDeviceGetAttribute(&cus, hipDeviceAttributeMultiprocessorCount, dev) != hipSuccess) { grid = -1; return; }
        if (hipFuncSetAttribute((const void*)hymba_fwd, hipFuncAttributeMaxDynamicSharedMemorySize, LDS_BYTES) != hipSuccess) { fprintf(stderr, "kernel_launch: hipFuncSetAttribute failed\n"); grid = -1; return; }
        if (hipOccupancyMaxActiveBlocksPerMultiprocessor(&per_cu, (const void*)hymba_fwd, NTHREADS, LDS_BYTES) != hipSuccess || per_cu < 1) { fprintf(stderr, "kernel_launch: occupancy query says %d\n", per_cu); per_cu = 1; }
        (void)hipGetLastError();
        grid = cus;
    }
    if (grid < 0) return;
    (void)hipMemsetAsync((char*)d_ws + WS_CTL, 0, CTL_ZERO_BYTES, stream);
    Args a{};
    for (int i = 0; i < 25; ++i) a.in[i] = (const float*)d_in[i];
    a.out = (float*)d_out; a.ws = (unsigned char*)d_ws;
#if MK_ONE_LAUNCH
    a.ph_lo = 0; a.ph_hi = NPHASE;
    hipLaunchKernelGGL(hymba_fwd, dim3(grid), dim3(NTHREADS), LDS_BYTES, stream, a);
#else
    for (int ph = 0; ph < NPHASE; ++ph) { a.ph_lo = ph; a.ph_hi = ph + 1; hipLaunchKernelGGL(hymba_fwd, dim3(grid), dim3(NTHREADS), LDS_BYTES, stream, a); }
#endif
}
```

```cpp
#include <hip/hip_runtime.h>
#include <cstdio>
#include <cstdint>
namespace pg8 {
#define PG8_LAS __attribute__((address_space(3)))
typedef unsigned short bf16_t;
typedef short bf16x8 __attribute__((ext_vector_type(8)));
typedef float f32x4 __attribute__((ext_vector_type(4)));
typedef unsigned u32x4 __attribute__((ext_vector_type(4)));
constexpr int BM = 256, BK = 64, HALF = 128, HTB = HALF * BK * 2  , STAGE_BYTES = 8 * HTB, NXCD = 8, WGM = 8;

__host__ __device__ __forceinline__ int lds_byte(int r, int c) { const int st = (r >> 4) * 2 + (c >> 5), rr = r & 15, cc = c & 31, ob = rr * 64 + cc * 2; return st * 1024 + (ob ^ (((ob >> 9) & 1) << 5)); }
__host__ __device__ __forceinline__ void stage_rc(int b, int& R, int& C) { const int st = b / 1024, sb = b % 1024, swz = sb ^ (((sb >> 9) & 1) << 5); R = (st >> 1) * 16 + swz / 64; C = (st & 1) * 32 + (swz % 64) / 2; }
__host__ __device__ __forceinline__ int perm32(int rho) { const int n = rho >> 4, i = rho & 15; return 8 * (i >> 2) + 4 * n + (i & 3); }

struct Unit { int pm, pn; };
struct Gemm { const bf16_t* A; const bf16_t* Bt; int M, N, K, lda; };

struct StaticOrder {
    int nM, nN, nwg, G, c;
    __host__ __device__ void init(int M, int N, int G_, int c_) { nM = M / BM; nN = N / BM; nwg = nM * nN; G = G_; c = c_; }
    __host__ __device__ bool next(int i, Unit& u) const {
        const long L = (long)i * G + c; if (L >= nwg) return false;
        int wgid = (int)L; { const int q = nwg / NXCD, r = nwg % NXCD, xcd = wgid % NXCD, off = wgid / NXCD; wgid = (xcd < r ? xcd * (q + 1) : r * (q + 1) + (xcd - r) * q) + off; }
        const int nig = WGM * nN, gid = wgid / nig, fm = gid * WGM, gsz = (nM - fm) < WGM ? (nM - fm) : WGM;
        u.pm = fm + ((wgid % nig) % gsz); u.pn = (wgid % nig) / gsz; return true;
    }
    __device__ __forceinline__ void a_ready(const Unit&) const {}
    __device__ __forceinline__ void done(const Unit&) const {}
};

__device__ __forceinline__ unsigned cvt_pk_bf16(float lo, float hi) { unsigned r; asm volatile("v_cvt_pk_bf16_f32 %0, %1, %2" : "=v"(r) : "v"(lo), "v"(hi)); return r; }

struct EpiF32 {
    static constexpr bool PERM = false, AFTER_DRAIN = false;
    float* C; int ldc;
    __device__ __forceinline__ void operator()(const f32x4 (&acc)[2][2][4][2], const Unit& u, int wr, int wc, int fr, int fq) const {
        const int row0 = u.pm * BM + wr * 64 + fr, col0 = u.pn * BM + wc * 32 + 4 * fq;
#pragma unroll
        for (int ai = 0; ai < 2; ++ai)
#pragma unroll
            for (int m = 0; m < 4; ++m) { float* rowp = C + (size_t)(row0 + ai * HALF + m * 16) * ldc + col0;
#pragma unroll
                for (int bj = 0; bj < 2; ++bj)
#pragma unroll
                    for (int n = 0; n < 2; ++n) *(f32x4*)(rowp + bj * HALF + n * 16) = acc[ai][bj][m][n]; }
    }
};
struct EpiProj {
    static constexpr bool PERM = true, AFTER_DRAIN = false;
    bf16_t* O; int ldc; float* dt; int dt_tile;
    __device__ __forceinline__ void operator()(const f32x4 (&acc)[2][2][4][2], const Unit& u, int wr, int wc, int fr, int fq) const {
        const int row0 = u.pm * BM + wr * 64 + fr;
        if (u.pn == dt_tile) {
            if (wc == 0 && fq < 2) {
#pragma unroll
                for (int ai = 0; ai < 2; ++ai)
#pragma unroll
                    for (int m = 0; m < 4; ++m) { float* rowp = dt + (size_t)(row0 + ai * HALF + m * 16) * 16 + 8 * fq;
                        *(f32x4*)(rowp) = acc[ai][0][m][0]; *(f32x4*)(rowp + 4) = acc[ai][0][m][1]; }
            }
            return;
        }
        const int col0 = u.pn * BM + wc * 32 + 8 * fq;
#pragma unroll
        for (int ai = 0; ai < 2; ++ai)
#pragma unroll
            for (int m = 0; m < 4; ++m) { bf16_t* rowp = O + (size_t)(row0 + ai * HALF + m * 16) * ldc + col0;
#pragma unroll
                for (int bj = 0; bj < 2; ++bj) { const f32x4 v0 = acc[ai][bj][m][0], v1 = acc[ai][bj][m][1];
                    u32x4 w; w.x = cvt_pk_bf16(v0[0], v0[1]); w.y = cvt_pk_bf16(v0[2], v0[3]); w.z = cvt_pk_bf16(v1[0], v1[1]); w.w = cvt_pk_bf16(v1[2], v1[3]);
                    *(u32x4*)(rowp + bj * HALF) = w; } }
    }
};
struct EpiSwiGLU {
    static constexpr bool PERM = true, AFTER_DRAIN = false;
    bf16_t* O; int ldc;
    __device__ __forceinline__ void operator()(const f32x4 (&acc)[2][2][4][2], const Unit& u, int wr, int wc, int fr, int fq) const {
        const int row0 = u.pm * BM + wr * 64 + fr, col0 = u.pn * HALF + wc * 32 + 8 * fq;
#pragma unroll
        for (int ai = 0; ai < 2; ++ai)
#pragma unroll
            for (int m = 0; m < 4; ++m) { bf16_t* rowp = O + (size_t)(row0 + ai * HALF + m * 16) * ldc + col0;
                float r[8];
#pragma unroll
                for (int n = 0; n < 2; ++n)
#pragma unroll
                    for (int i = 0; i < 4; ++i) { const float g = acc[ai][0][m][n][i], up = acc[ai][1][m][n][i];
                        r[n * 4 + i] = g * up * __builtin_amdgcn_rcpf(1.0f + __builtin_amdgcn_exp2f(-1.4426950408889634f * g)); }
                u32x4 w; w.x = cvt_pk_bf16(r[0], r[1]); w.y = cvt_pk_bf16(r[2], r[3]); w.z = cvt_pk_bf16(r[4], r[5]); w.w = cvt_pk_bf16(r[6], r[7]);
                *(u32x4*)(rowp) = w; }
    }
};

template <class Epi, class Sched, bool ALIGN_EPI = false, bool SP2 = false>
__device__ __forceinline__ void gemm_phase(PG8_LAS unsigned char* lds, const Gemm g, const Sched& S, const Epi& E) {
    const int tid = threadIdx.x, wid = __builtin_amdgcn_readfirstlane(tid >> 6), lane = tid & 63, wr = wid >> 2, wc = wid & 3, fr = lane & 15, fq = lane >> 4;
    const int K = g.K, nt = K / BK;
    unsigned voffA[2], voffB[2];
#pragma unroll
    for (int i = 0; i < 2; ++i) { int R, C; stage_rc(tid * 16 + i * 8192, R, C); const int Rb = Epi::PERM ? ((R & ~31) + perm32(R & 31)) : R;
        voffA[i] = (unsigned)(R * g.lda + C) * 2u; voffB[i] = (unsigned)(Rb * K + C) * 2u; }
    const size_t kstep = (size_t)(BK * 2);
    const size_t hstep = (size_t)HALF * K * 2, hstepA = (size_t)HALF * g.lda * 2;
    const size_t tstep = 2 * hstep, tstepA = 2 * hstepA;
    const unsigned ldsw = (unsigned)wid * 1024u;
    const int aoff = lds_byte(wr * 64 + fr, fq * 8), boff = lds_byte(wc * 32 + fr, fq * 8);
#define PG8_SA(b, h) (((b) * 2 + (h)) * HTB)
#define PG8_SB(b, h) ((4 + (b) * 2 + (h)) * HTB)
#define PG8_STAGE(bufoff, gbase, voff) do { _Pragma("unroll") for (int _i = 0; _i < 2; ++_i) \
        __builtin_amdgcn_global_load_lds((const unsigned*)((const char*)(gbase) + (voff)[_i]), (PG8_LAS unsigned*)(lds + (bufoff) + ldsw + _i * 8192), 16, 0, 0); } while (0)
#define PG8_LDA(dst, b, h) do { _Pragma("unroll") for (int m = 0; m < 4; ++m) _Pragma("unroll") for (int k = 0; k < 2; ++k) dst[m][k] = *(const PG8_LAS bf16x8*)(lds + PG8_SA(b, h) + aoff + m * 2048 + k * 1024); } while (0)
#define PG8_LDB(dst, b, h) do { _Pragma("unroll") for (int n = 0; n < 2; ++n) _Pragma("unroll") for (int k = 0; k < 2; ++k) dst[n][k] = *(const PG8_LAS bf16x8*)(lds + PG8_SB(b, h) + boff + n * 2048 + k * 1024); } while (0)
#define PG8_MMA(ai, bj, At, Bt) do { __builtin_amdgcn_s_setprio(1); _Pragma("unroll") for (int m = 0; m < 4; ++m) _Pragma("unroll") for (int n = 0; n < 2; ++n) _Pragma("unroll") for (int k = 0; k < 2; ++k) \
        acc[ai][bj][m][n] = __builtin_amdgcn_mfma_f32_16x16x32_bf16(Bt[n][k], At[m][k], acc[ai][bj][m][n], 0, 0, 0); __builtin_amdgcn_s_setprio(0); } while (0)
#define PG8_WAIT_V(n) asm volatile("s_waitcnt vmcnt(" #n ")" ::: "memory")
#define PG8_WAIT_L(n) asm volatile("s_waitcnt lgkmcnt(" #n ")" ::: "memory")
#define PG8_BAR __builtin_amdgcn_s_barrier()
#define PG8_SCHED __builtin_amdgcn_sched_barrier(0)
    Unit cur, nxt; int ui = 0;
    if (!S.next(0, cur)) return;
    f32x4 acc[2][2][4][2];
#pragma unroll
    for (int a = 0; a < 2; ++a)
#pragma unroll
        for (int b = 0; b < 2; ++b)
#pragma unroll
            for (int m = 0; m < 4; ++m)
#pragma unroll
                for (int n = 0; n < 2; ++n) acc[a][b][m][n] = (f32x4){0.f, 0.f, 0.f, 0.f};
    bf16x8 At[4][2], B0[2][2], B1[2][2];
    const char* cA = (const char*)g.A + (size_t)cur.pm * tstepA; const char* cB = (const char*)g.Bt + (size_t)cur.pn * tstep;
    S.a_ready(cur);
    if constexpr (SP2) {
        PG8_STAGE(PG8_SB(0, 0), cB, voffB); PG8_STAGE(PG8_SB(0, 1), cB + hstep, voffB); PG8_STAGE(PG8_SA(0, 0), cA, voffA); PG8_STAGE(PG8_SA(0, 1), cA + hstepA, voffA);
        if (wr == 1) PG8_BAR;
        PG8_WAIT_V(2); PG8_BAR;
        PG8_STAGE(PG8_SB(1, 0), cB + kstep, voffB); PG8_STAGE(PG8_SA(1, 0), cA + kstep, voffA); PG8_STAGE(PG8_SB(1, 1), cB + hstep + kstep, voffB);
        PG8_WAIT_V(6); PG8_BAR;
    } else {
        PG8_STAGE(PG8_SB(0, 0), cB, voffB); PG8_STAGE(PG8_SA(0, 0), cA, voffA); PG8_STAGE(PG8_SB(0, 1), cB + hstep, voffB); PG8_STAGE(PG8_SA(0, 1), cA + hstepA, voffA);
        if (wr == 1) PG8_BAR;
        PG8_WAIT_V(4); PG8_BAR;
        PG8_STAGE(PG8_SB(1, 0), cB + kstep, voffB); PG8_STAGE(PG8_SA(1, 0), cA + kstep, voffA); PG8_STAGE(PG8_SB(1, 1), cB + hstep + kstep, voffB);
        PG8_WAIT_V(6); PG8_BAR;
    }
    for (;;) {
        const bool has_next = S.next(ui + 1, nxt);
        const char* nA = has_next ? (const char*)g.A + (size_t)nxt.pm * tstepA : cA; const char* nB = has_next ? (const char*)g.Bt + (size_t)nxt.pn * tstep : cB;
        for (int t = 0; t < nt; t += 2) {
            const bool last = (t == nt - 2);
            const char* a1 = cA + (size_t)(t + 1) * kstep;
            const char* a2 = last ? nA : cA + (size_t)(t + 2) * kstep; const char* b2 = last ? nB : cB + (size_t)(t + 2) * kstep;
            const char* a3 = a2 + kstep; const char* b3 = b2 + kstep;
            if (last && has_next) S.a_ready(nxt);
            if constexpr (SP2) {
            PG8_LDB(B0, 0, 0); PG8_LDB(B1, 0, 1); PG8_SCHED; PG8_LDA(At, 0, 0); PG8_STAGE(PG8_SA(1, 1), a1 + hstepA, voffA);
            PG8_WAIT_V(8); PG8_WAIT_L(0); PG8_BAR; PG8_MMA(0, 0, At, B0); PG8_MMA(0, 1, At, B1); PG8_BAR; PG8_SCHED;
            PG8_LDA(At, 0, 1); PG8_STAGE(PG8_SB(0, 0), b2, voffB); PG8_STAGE(PG8_SB(0, 1), b2 + hstep, voffB); PG8_STAGE(PG8_SA(0, 0), a2, voffA);
            PG8_WAIT_V(8); PG8_WAIT_L(0); PG8_BAR; PG8_MMA(1, 0, At, B0); PG8_MMA(1, 1, At, B1); PG8_BAR; PG8_SCHED;
            PG8_LDB(B0, 1, 0); PG8_LDB(B1, 1, 1); PG8_SCHED; PG8_LDA(At, 1, 0); PG8_STAGE(PG8_SA(0, 1), a2 + hstepA, voffA);
            PG8_WAIT_V(8); PG8_WAIT_L(0); PG8_BAR; PG8_MMA(0, 0, At, B0); PG8_MMA(0, 1, At, B1); PG8_BAR; PG8_SCHED;
            PG8_LDA(At, 1, 1); PG8_STAGE(PG8_SB(1, 0), b3, voffB); PG8_STAGE(PG8_SB(1, 1), b3 + hstep, voffB); PG8_STAGE(PG8_SA(1, 0), a3, voffA);
            PG8_WAIT_V(8); PG8_WAIT_L(0); PG8_BAR; PG8_MMA(1, 0, At, B0); PG8_MMA(1, 1, At, B1); PG8_BAR; PG8_SCHED;
            } else {
            PG8_LDB(B0, 0, 0); PG8_SCHED; PG8_LDA(At, 0, 0); PG8_STAGE(PG8_SA(1, 1), a1 + hstepA, voffA);
            PG8_WAIT_L(8); PG8_BAR; PG8_WAIT_L(0); PG8_MMA(0, 0, At, B0); PG8_BAR; PG8_SCHED;
            PG8_LDB(B1, 0, 1); PG8_STAGE(PG8_SB(0, 0), b2, voffB);
            PG8_BAR; PG8_WAIT_L(0); PG8_MMA(0, 1, At, B1); PG8_BAR;
            PG8_LDA(At, 0, 1); PG8_STAGE(PG8_SA(0, 0), a2, voffA);
            PG8_BAR; PG8_WAIT_L(0); PG8_MMA(1, 0, At, B0); PG8_BAR; PG8_SCHED;
            PG8_STAGE(PG8_SB(0, 1), b2 + hstep, voffB);
            PG8_WAIT_V(6); PG8_BAR; PG8_MMA(1, 1, At, B1); PG8_BAR;
            PG8_LDB(B0, 1, 0); PG8_SCHED; PG8_LDA(At, 1, 0); PG8_STAGE(PG8_SA(0, 1), a2 + hstepA, voffA);
            PG8_WAIT_L(8); PG8_BAR; PG8_WAIT_L(0); PG8_MMA(0, 0, At, B0); PG8_BAR; PG8_SCHED;
            PG8_LDB(B1, 1, 1); PG8_STAGE(PG8_SB(1, 0), b3, voffB);
            PG8_BAR; PG8_WAIT_L(0); PG8_MMA(0, 1, At, B1); PG8_BAR;
            PG8_LDA(At, 1, 1); PG8_STAGE(PG8_SA(1, 0), a3, voffA);
            PG8_BAR; PG8_WAIT_L(0); PG8_MMA(1, 0, At, B0); PG8_BAR; PG8_SCHED;
            PG8_STAGE(PG8_SB(1, 1), b3 + hstep, voffB);
            PG8_WAIT_V(6); PG8_BAR; PG8_MMA(1, 1, At, B1); PG8_BAR;
            }
        }
        if constexpr (ALIGN_EPI) { if (wr == 0) PG8_BAR; }
        if constexpr (!Epi::AFTER_DRAIN) { E(acc, cur, wr, wc, fr, fq); S.done(cur); }
        if (!has_next) break;
#pragma unroll
        for (int a = 0; a < 2; ++a)
#pragma unroll
            for (int b = 0; b < 2; ++b)
#pragma unroll
                for (int m = 0; m < 4; ++m)
#pragma unroll
                    for (int n = 0; n < 2; ++n) acc[a][b][m][n] = (f32x4){0.f, 0.f, 0.f, 0.f};
        cur = nxt; cA = nA; cB = nB; ++ui;
        if constexpr (ALIGN_EPI) { if (wr == 1) PG8_BAR; }
    }
    PG8_WAIT_V(0);
    if constexpr (!ALIGN_EPI) { if (wr == 0) PG8_BAR; }
    PG8_BAR;
    if constexpr (Epi::AFTER_DRAIN) { E.fused(acc, cur, wr, wc, fr, fq, lds, wid, lane); S.done(cur); }
#undef PG8_SA
#undef PG8_SB
#undef PG8_STAGE
#undef PG8_LDA
#undef PG8_LDB
#undef PG8_MMA
#undef PG8_WAIT_V
#undef PG8_WAIT_L
#undef PG8_BAR
#undef PG8_SCHED
}}

constexpr int NWAVES = 8, NTHREADS = NWAVES * 64;
constexpr int D = 1024, BATCH_P = 8, SEQ_P = 2048, BATCH_S = 128, SEQ_S = 8;
constexpr int MP = BATCH_P * SEQ_P, MS = BATCH_S * SEQ_S, M = MP + MS;
constexpr int NSEQ = BATCH_P + BATCH_S;
constexpr int SCW = 1024, SSMW = 1024, NH = 16, HP = 64, NG = 4, NS = 128, XBC = 2048;
constexpr int NPROJ = 6160, NPROJ_PAD = 6400, PROJ_LD = 6144;
constexpr int C_SCB = 0, C_SCC = 1024, C_SCX = 2048, C_Z = 3072, C_XBC = 4096;
constexpr int FF = 2816, NGU = 2 * FF;
constexpr float EPS = 1e-6f;
constexpr size_t O_Y = 0, O_SCP = (size_t)M * D, O_CVP = O_SCP + (size_t)BATCH_P * 2 * SCW, O_SSMP = O_CVP + (size_t)BATCH_P * 3 * XBC,
                 O_SCS = O_SSMP + (size_t)BATCH_P * NH * HP * NS, O_CVS = O_SCS + (size_t)BATCH_S * 2 * SCW, O_SSMS = O_CVS + (size_t)BATCH_S * 3 * XBC,
                 O_END = O_SSMS + (size_t)BATCH_S * NH * HP * NS;
static_assert(O_END == 36765696ull, "output size");
constexpr size_t MiB = 1u << 20;
constexpr size_t WS_CTL = 0, CTL_ZERO_BYTES = 1 * MiB;
constexpr size_t WS_MOD = 1 * MiB;
constexpr size_t WS_WIN = 5 * MiB;
constexpr size_t WS_WOUT = 18 * MiB;
constexpr size_t WS_WGU = 22 * MiB;
constexpr size_t WS_WD = 33 * MiB;
constexpr size_t WS_DT = 39 * MiB;
constexpr size_t WS_PROJ = 41 * MiB;
constexpr size_t WS_ACT = 41 * MiB;
constexpr size_t WS_XN2 = 136 * MiB;
constexpr size_t WS_F = 170 * MiB;
constexpr size_t WS_END = 256 * MiB;
static_assert(WS_PROJ + (size_t)M * PROJ_LD * 2 <= WS_END && WS_ACT + (size_t)M * FF * 2 <= WS_XN2 && WS_XN2 + (size_t)M * D * 2 <= WS_F && WS_F + (size_t)M * D * 4 <= WS_END, "d_ws map");
static_assert(WS_WIN + (size_t)NPROJ_PAD * D * 2 <= WS_WOUT && WS_WD + (size_t)D * FF * 2 <= WS_DT && WS_DT + (size_t)M * 16 * 4 <= WS_PROJ, "d_ws map 2");
constexpr int CW_BAR = 4096;
constexpr int RING_OFF = 0, RING_BYTES = 131072;
constexpr int LDSCTL_OFF = RING_BYTES, MISC_OFF = LDSCTL_OFF + 320;
constexpr int LDS_BYTES = 147456;
static_assert(MISC_OFF + 128 <= LDS_BYTES, "LDS map");

#define GAS __attribute__((address_space(1)))
#define LAS __attribute__((address_space(3)))
typedef unsigned short bf16;
typedef unsigned v4u __attribute__((ext_vector_type(4)));
typedef unsigned v2u __attribute__((ext_vector_type(2)));
typedef float f32x4 __attribute__((ext_vector_type(4)));
typedef GAS unsigned gu32;
#define RLX_AGENT __ATOMIC_RELAXED, __HIP_MEMORY_SCOPE_AGENT
#define LDS_WAIT() asm volatile("s_waitcnt lgkmcnt(0)" ::: "memory")
#define VM_WAIT() asm volatile("s_waitcnt vmcnt(0)" ::: "memory")
__device__ __forceinline__ unsigned f2bf(float f) { unsigned u = __builtin_bit_cast(unsigned, f); return (u + 0x7fffu + ((u >> 16) & 1u)) >> 16; }
typedef float f32x2_t __attribute__((ext_vector_type(2))); typedef __bf16 bf16x2_t __attribute__((ext_vector_type(2)));
__device__ __forceinline__ unsigned pk2(float lo, float hi) { f32x2_t v = {lo, hi}; bf16x2_t b = __builtin_convertvector(v, bf16x2_t); return __builtin_bit_cast(unsigned, b); }
__device__ __forceinline__ float bflo(unsigned u) { return __builtin_bit_cast(float, u << 16); }
__device__ __forceinline__ float bfhi(unsigned u) { return __builtin_bit_cast(float, u & 0xffff0000u); }
__device__ __forceinline__ float bf1(bf16 h) { return __builtin_bit_cast(float, (unsigned)h << 16); }
__device__ __forceinline__ float silu_f(float v) { return v * __builtin_amdgcn_rcpf(1.0f + __builtin_amdgcn_exp2f(-1.4426950408889634f * v)); }
__device__ __forceinline__ float softplus_f(float v) { return v > 20.f ? v : log1pf(__expf(v)); }

#define XB_TMO      128
#define XB_XCNT(j)  (256  + 64 * (j))
#define XB_XSUB(j)  (1280 + 64 * (j))
#define XB_XGEN(j)  (2304 + 64 * (j))
#define XB_TOP      3328
#define XB_TOPGEN   3392
#define XCD_BAR_WORDS 3456
#define XB_SPIN_CAP (1u << 18)
__device__ __forceinline__ unsigned xb_ld(unsigned* p)              { return __hip_atomic_load(p, __ATOMIC_RELAXED, __HIP_MEMORY_SCOPE_AGENT); }
__device__ __forceinline__ unsigned xb_add(unsigned* p, unsigned v) { return __hip_atomic_fetch_add(p, v, __ATOMIC_RELAXED, __HIP_MEMORY_SCOPE_AGENT); }
__device__ __forceinline__ unsigned xb_xcc_id() { return (unsigned)__builtin_amdgcn_s_getreg((3 << 11) | 20) & 0xFu; }
#define XB_SPIN(cond, bar) do { unsigned _sp = 0; while (cond) { __builtin_amdgcn_s_sleep(1); \
    if ((++_sp & 255u) == 0u) { if (xb_ld(&(bar)[XB_TMO])) break; if (_sp > XB_SPIN_CAP) { atomicAdd(&(bar)[XB_TMO], 1u); break; } } } } while (0)
struct XcdBarrier { unsigned* bar; unsigned x; volatile LAS unsigned* st; };
__device__ __forceinline__ XcdBarrier xcd_barrier_post(unsigned* bar, volatile LAS unsigned* st) {
    XcdBarrier b; b.bar = bar; b.x = xb_xcc_id(); b.st = st;
    if (threadIdx.x == 0) (void)xb_add(&bar[XB_XCNT(b.x)], 1u);
    return b;
}
__device__ __forceinline__ void xcd_barrier_complete(unsigned* bar, unsigned x, unsigned& nloc, unsigned& nx) {
    const unsigned G = gridDim.x * gridDim.y * gridDim.z;
    unsigned sum, cnt, mine, sp = 0u;
    for (;;) {
        sum = 0u; cnt = 0u; mine = 0u;
#pragma unroll
        for (unsigned j = 0; j < 16; ++j) { const unsigned c = xb_ld(&bar[XB_XCNT(j)]); sum += c; cnt += (c > 0u) ? 1u : 0u; mine = (j == x) ? c : mine; }
        if (sum == G) break;
        __builtin_amdgcn_s_sleep(1);
        if ((++sp & 255u) == 0u) { if (xb_ld(&bar[XB_TMO])) break; if (sp > XB_SPIN_CAP) { atomicAdd(&bar[XB_TMO], 1u); break; } }
    }
    nloc = mine > 0u ? mine : 1u; nx = cnt > 0u ? cnt : 1u;
}
__device__ __forceinline__ void xcd_barrier(const XcdBarrier& b) {
    asm volatile("s_waitcnt vmcnt(0)" ::: "memory");
    __syncthreads();
    if (threadIdx.x == 0) {
        unsigned* bar = b.bar;
        __builtin_amdgcn_s_waitcnt(0);
        unsigned nloc = b.st[0], nx = b.st[1];
        if (nloc == 0u) { xcd_barrier_complete(bar, b.x, nloc, nx); b.st[0] = nloc; b.st[1] = nx; }
        const unsigned old = xb_add(&bar[XB_XSUB(b.x)], 1u);
        const unsigned gen = old / nloc;
        if (old + 1u == (gen + 1u) * nloc) {
            __builtin_amdgcn_fence(__ATOMIC_RELEASE, "agent");
            asm volatile("s_waitcnt vmcnt(0)" ::: "memory");
            const unsigned og = xb_add(&bar[XB_TOP], 1u);
            const unsigned tg = og / nx;
            if (og + 1u == (tg + 1u) * nx) xb_add(&bar[XB_TOPGEN], 1u);
            else XB_SPIN(xb_ld(&bar[XB_TOPGEN]) == tg, bar);
            __builtin_amdgcn_fence(__ATOMIC_ACQUIRE, "agent");
            xb_add(&bar[XB_XGEN(b.x)], 1u);
            asm volatile("s_waitcnt vmcnt(0)" ::: "memory");
        } else {
            XB_SPIN(xb_ld(&bar[XB_XGEN(b.x)]) == gen, bar);
            __builtin_amdgcn_fence(__ATOMIC_ACQUIRE, "agent");
            asm volatile("s_waitcnt vmcnt(0)" ::: "memory");
        }
    }
    __syncthreads();
}

struct Args { const float* in[25]; float* out; unsigned char* ws; int ph_lo, ph_hi; };
struct Frame {
    LAS unsigned char* lds;
    volatile LAS unsigned* MISC;
    gu32* ctl;
    int tid, lane, wave, G;
    const float *x_p, *x_s, *c_p, *c_s, *st_sc, *st_cv, *st_ssm, *w_ada, *b_ada, *g_mpre, *g_mpost, *g_fpre, *g_fpost, *w_in, *sc_w, *cv_w, *cv_b, *dt_bias, *a_log, *d_skip, *ssm_g, *w_out, *w_gate, *w_up, *w_down;
    float* out;
    float* mod; bf16 *Win_t, *Wout_t, *Wgu_t, *Wd_t; float* dtraw; bf16 *proj, *act, *xn2; float* fbuf;
    bf16* xn1;
    bf16* xbcc;
    float* mix;
};
__device__ __forceinline__ float wave_sum(float v) {
#pragma unroll
    for (int o = 1; o < 64; o <<= 1) v += __shfl_xor(v, o);
    return v;
}
__device__ __forceinline__ const float* x_row(const Frame& F, int m) { return m < MP ? F.x_p + (size_t)m * D : F.x_s + (size_t)(m - MP) * D; }
__device__ __forceinline__ int seq_of(int m) { return m < MP ? (m >> 11) : BATCH_P + ((m - MP) >> 3); }

__device__ __forceinline__ void p0_transpose_item(const float* W, int K, int N, int nblk, bf16* WT, int mode, LAS float* scr, int item, int lane) {
    const int kb = item / nblk, nb = item % nblk, k0 = 64 * kb, n0 = 32 * nb;
    const bool ok = (n0 + (lane & 31)) < N;
#pragma unroll 8
    for (int i = 0; i < 32; ++i) { const int kk = 2 * i + (lane >> 5); scr[kk * 33 + (lane & 31)] = ok ? W[(size_t)(k0 + kk) * N + n0 + (lane & 31)] : 0.f; }
    LDS_WAIT(); asm volatile("" ::: "memory");
    const int c = lane & 7;
    const int r0 = mode == 0 ? n0 : ((n0 >> 7) * 256 + (n0 & 127) + (mode == 2 ? 128 : 0));
#pragma unroll
    for (int j = 0; j < 4; ++j) { const int n = (lane >> 3) + 8 * j; const LAS float* s = scr + (8 * c) * 33 + n;
        v4u o; o.x = pk2(s[0 * 33], s[1 * 33]); o.y = pk2(s[2 * 33], s[3 * 33]); o.z = pk2(s[4 * 33], s[5 * 33]); o.w = pk2(s[6 * 33], s[7 * 33]);
        *(v4u*)(WT + (size_t)(r0 + n) * K + k0 + 8 * c) = o; }
    LDS_WAIT(); asm volatile("" ::: "memory");
}

__device__ __forceinline__ void p0_prologue(Frame& F) {
    {
        LAS float* sc = (LAS float*)(F.lds + RING_OFF);
        for (int it = blockIdx.x; it < 17 * 12; it += F.G) {
            const int sg = it / 12, cb = it % 12, s0 = sg * 8;
            for (int idx = F.tid; idx < 8192; idx += NTHREADS) { const int sl = idx >> 10, k = idx & 1023, s = s0 + sl;
                const float* cp = s < BATCH_P ? F.c_p + (size_t)s * D : F.c_s + (size_t)(s - BATCH_P) * D; sc[k * 8 + sl] = silu_f(cp[k]); }
            __syncthreads();
            const int j = cb * 512 + F.tid; float acc[8];
#pragma unroll
            for (int i = 0; i < 8; ++i) acc[i] = 0.f;
#pragma unroll 8
            for (int k = 0; k < D; ++k) { const float w = F.w_ada[(size_t)k * 6144 + j]; const f32x4 a = *(const LAS f32x4*)(sc + k * 8), b = *(const LAS f32x4*)(sc + k * 8 + 4);
                acc[0] += a[0] * w; acc[1] += a[1] * w; acc[2] += a[2] * w; acc[3] += a[3] * w; acc[4] += b[0] * w; acc[5] += b[1] * w; acc[6] += b[2] * w; acc[7] += b[3] * w; }
            const float bj = F.b_ada[j];
#pragma unroll
            for (int i = 0; i < 8; ++i) F.mod[(size_t)(s0 + i) * 6144 + j] = acc[i] + bj;
            __syncthreads();
        }
    }
    LAS float* scr = (LAS float*)(F.lds + RING_OFF + F.wave * 16384);
    const int gw = blockIdx.x * NWAVES + F.wave, NGW = F.G * NWAVES;
    constexpr int I_IN = (D / 64) * (NPROJ_PAD / 32), I_OUT = (2048 / 64) * (D / 32), I_G = (D / 64) * (FF / 32), I_D = (FF / 64) * (D / 32);
    constexpr int NITEMS = I_IN + I_OUT + 2 * I_G + I_D;
    for (int it = gw; it < NITEMS; it += NGW) {
        int r = it;
        if (r < I_IN) { p0_transpose_item(F.w_in, D, NPROJ, NPROJ_PAD / 32, F.Win_t, 0, scr, r, F.lane); continue; } r -= I_IN;
        if (r < I_OUT) { p0_transpose_item(F.w_out, 2048, D, D / 32, F.Wout_t, 0, scr, r, F.lane); continue; } r -= I_OUT;
        if (r < I_G) { p0_transpose_item(F.w_gate, D, FF, FF / 32, F.Wgu_t, 1, scr, r, F.lane); continue; } r -= I_G;
        if (r < I_G) { p0_transpose_item(F.w_up, D, FF, FF / 32, F.Wgu_t, 2, scr, r, F.lane); continue; } r -= I_G;
        p0_transpose_item(F.w_down, FF, D, D / 32, F.Wd_t, 0, scr, r, F.lane);
    }
}
__device__ __forceinline__ void p1_hrows(Frame& F) {
    const int gw = blockIdx.x * NWAVES + F.wave, NGW = F.G * NWAVES;
    for (int m = gw; m < M; m += NGW) {
        const f32x4* xr = (const f32x4*)x_row(F, m) + F.lane; const float* md = F.mod + (size_t)seq_of(m) * 6144;
        f32x4 v[4]; float ss = 0.f;
#pragma unroll
        for (int j = 0; j < 4; ++j) { v[j] = xr[64 * j]; ss += (v[j].x * v[j].x + v[j].y * v[j].y) + (v[j].z * v[j].z + v[j].w * v[j].w); }
        const float rstd = 1.0f / sqrtf(wave_sum(ss) * (1.f / D) + EPS);
        unsigned long long* o8 = (unsigned long long*)(F.xn1 + (size_t)m * D) + F.lane;
#pragma unroll
        for (int j = 0; j < 4; ++j) { const int col = 256 * j + 4 * F.lane; const f32x4 g = *(const f32x4*)(F.g_mpre + col), sh = *(const f32x4*)(md + col), sc = *(const f32x4*)(md + 1024 + col);
            const f32x4 h = (v[j] * rstd) * g * (sc + 1.0f) + sh;
            o8[64 * j] = (unsigned long long)pk2(h.x, h.y) | ((unsigned long long)pk2(h.z, h.w) << 32); }
    }
}
__device__ __forceinline__ void unpack8(const v4u q, float (&f)[8]) { f[0] = bflo(q.x); f[1] = bfhi(q.x); f[2] = bflo(q.y); f[3] = bfhi(q.y); f[4] = bflo(q.z); f[5] = bfhi(q.z); f[6] = bflo(q.w); f[7] = bfhi(q.w); }
__device__ __forceinline__ void p3_conv(Frame& F) {
    const long total = (long)M * 384;
    for (long idx = (long)blockIdx.x * NTHREADS + F.tid; idx < total; idx += (long)F.G * NTHREADS) {
        const int r = (int)(idx / 384), ch = (int)(idx % 384);
        int b, t, L; bool samp;
        if (r < MP) { b = r >> 11; t = r & 2047; L = SEQ_P; samp = false; } else { const int rr = r - MP; b = rr >> 3; t = rr & 7; L = SEQ_S; samp = true; }
        const bf16* prow = F.proj + (size_t)r * PROJ_LD;
        if (ch < 128) {
            const int c0 = ch * 8;
            float acc[8], e[8];
#pragma unroll
            for (int i = 0; i < 8; ++i) acc[i] = 0.f;
#pragma unroll
            for (int j = 0; j < 3; ++j) {
                const int ee = t + j;
                if (ee < 2) {
                    if (samp) { const float* bp = F.st_sc + ((size_t)b * 2 + ee) * SCW + c0; const f32x4 a = *(const f32x4*)bp, bb = *(const f32x4*)(bp + 4);
                        e[0] = a.x; e[1] = a.y; e[2] = a.z; e[3] = a.w; e[4] = bb.x; e[5] = bb.y; e[6] = bb.z; e[7] = bb.w; }
                    else {
#pragma unroll
                        for (int i = 0; i < 8; ++i) e[i] = 0.f; }
                } else {
                    const bf16* pr = prow + (ptrdiff_t)(j - 2) * PROJ_LD; float cc[8], xx[8];
                    unpack8(*(const v4u*)(pr + C_SCC + c0), cc); unpack8(*(const v4u*)(pr + C_SCX + c0), xx);
#pragma unroll
                    for (int i = 0; i < 8; ++i) e[i] = cc[i] * xx[i];
                }
                const float* wp = F.sc_w + (size_t)j * SCW + c0; const f32x4 w0 = *(const f32x4*)wp, w1 = *(const f32x4*)(wp + 4);
                acc[0] += w0.x * e[0]; acc[1] += w0.y * e[1]; acc[2] += w0.z * e[2]; acc[3] += w0.w * e[3]; acc[4] += w1.x * e[4]; acc[5] += w1.y * e[5]; acc[6] += w1.z * e[6]; acc[7] += w1.w * e[7];
            }
            if (t >= L - 2) { float* op = F.out + (samp ? O_SCS : O_SCP) + ((size_t)b * 2 + (t - (L - 2))) * SCW + c0;
                *(f32x4*)op = (f32x4){e[0], e[1], e[2], e[3]}; *(f32x4*)(op + 4) = (f32x4){e[4], e[5], e[6], e[7]}; }
            float bb[8]; unpack8(*(const v4u*)(prow + C_SCB + c0), bb);
            v4u o; o.x = pk2(bb[0] * acc[0], bb[1] * acc[1]); o.y = pk2(bb[2] * acc[2], bb[3] * acc[3]); o.z = pk2(bb[4] * acc[4], bb[5] * acc[5]); o.w = pk2(bb[6] * acc[6], bb[7] * acc[7]);
            *(v4u*)(F.proj + (size_t)r * PROJ_LD + C_SCB + c0) = o;
        } else {
            const int c0 = (ch - 128) * 8;
            float acc[8], e[8];
            { const f32x4 a = *(const f32x4*)(F.cv_b + c0), bb = *(const f32x4*)(F.cv_b + c0 + 4); acc[0] = a.x; acc[1] = a.y; acc[2] = a.z; acc[3] = a.w; acc[4] = bb.x; acc[5] = bb.y; acc[6] = bb.z; acc[7] = bb.w; }
#pragma unroll
            for (int j = 0; j < 4; ++j) {
                const int ee = t + j;
                if (ee < 3) {
                    if (samp) { const float* bp = F.st_cv + ((size_t)b * 3 + ee) * XBC + c0; const f32x4 a = *(const f32x4*)bp, bb = *(const f32x4*)(bp + 4);
                        e[0] = a.x; e[1] = a.y; e[2] = a.z; e[3] = a.w; e[4] = bb.x; e[5] = bb.y; e[6] = bb.z; e[7] = bb.w; }
                    else {
#pragma unroll
                        for (int i = 0; i < 8; ++i) e[i] = 0.f; }
                } else unpack8(*(const v4u*)(prow + (ptrdiff_t)(j - 3) * PROJ_LD + C_XBC + c0), e);
                const float* wp = F.cv_w + (size_t)j * XBC + c0; const f32x4 w0 = *(const f32x4*)wp, w1 = *(const f32x4*)(wp + 4);
                acc[0] += w0.x * e[0]; acc[1] += w0.y * e[1]; acc[2] += w0.z * e[2]; acc[3] += w0.w * e[3]; acc[4] += w1.x * e[4]; acc[5] += w1.y * e[5]; acc[6] += w1.z * e[6]; acc[7] += w1.w * e[7];
            }
            if (t >= L - 3) { float* op = F.out + (samp ? O_CVS : O_CVP) + ((size_t)b * 3 + (t - (L - 3))) * XBC + c0;
                *(f32x4*)op = (f32x4){e[0], e[1], e[2], e[3]}; *(f32x4*)(op + 4) = (f32x4){e[4], e[5], e[6], e[7]}; }
            v4u o; o.x = pk2(silu_f(acc[0]), silu_f(acc[1])); o.y = pk2(silu_f(acc[2]), silu_f(acc[3])); o.z = pk2(silu_f(acc[4]), silu_f(acc[5])); o.w = pk2(silu_f(acc[6]), silu_f(acc[7]));
            *(v4u*)(F.xbcc + (size_t)r * XBC + c0) = o;
        }
    }
}
__device__ __forceinline__ void scan_item(Frame& F, int s, int h) {
    const int p = F.tid >> 3, nq = F.tid & 7, g = h >> 2;
    const bool samp = s >= BATCH_P; const int b = samp ? s - BATCH_P : s; const int L = samp ? SEQ_S : SEQ_P; const int row0 = samp ? MP + b * SEQ_S : b * SEQ_P;
    float S[16];
    if (samp) { const float* sp = F.st_ssm + (((size_t)b * NH + h) * HP + p) * NS + nq * 16;
#pragma unroll
        for (int i = 0; i < 4; ++i) { const f32x4 a = *(const f32x4*)(sp + 4 * i); S[4 * i] = a.x; S[4 * i + 1] = a.y; S[4 * i + 2] = a.z; S[4 * i + 3] = a.w; } }
    else {
#pragma unroll
        for (int i = 0; i < 16; ++i) S[i] = 0.f; }
    const float A = -__expf(F.a_log[h]), dtb = F.dt_bias[h], Dh = F.d_skip[h];
    for (int t0 = 0; t0 < L; t0 += 8) {
        v4u Bq[8][2], Cq[8][2]; float xv[8], dtv[8];
#pragma unroll
        for (int u = 0; u < 8; ++u) { const int r = row0 + t0 + u; const bf16* xr = F.xbcc + (size_t)r * XBC;
            Bq[u][0] = *(const v4u*)(xr + 1024 + g * NS + nq * 16); Bq[u][1] = *(const v4u*)(xr + 1024 + g * NS + nq * 16 + 8);
            Cq[u][0] = *(const v4u*)(xr + 1536 + g * NS + nq * 16); Cq[u][1] = *(const v4u*)(xr + 1536 + g * NS + nq * 16 + 8);
            xv[u] = bf1(xr[h * HP + p]); dtv[u] = F.dtraw[(size_t)r * 16 + h]; }
#pragma unroll
        for (int u = 0; u < 8; ++u) {
            const float dt = softplus_f(dtv[u] + dtb), dA = __expf(dt * A), xdt = dt * xv[u];
            float Bf[16], Cf[16]; { float t8[8]; unpack8(Bq[u][0], t8);
#pragma unroll
                for (int i = 0; i < 8; ++i) Bf[i] = t8[i];
                unpack8(Bq[u][1], t8);
#pragma unroll
                for (int i = 0; i < 8; ++i) Bf[8 + i] = t8[i];
                unpack8(Cq[u][0], t8);
#pragma unroll
                for (int i = 0; i < 8; ++i) Cf[i] = t8[i];
                unpack8(Cq[u][1], t8);
#pragma unroll
                for (int i = 0; i < 8; ++i) Cf[8 + i] = t8[i]; }
            float y = 0.f;
#pragma unroll
            for (int i = 0; i < 16; ++i) { S[i] = S[i] * dA + xdt * Bf[i]; y += Cf[i] * S[i]; }
            y += __shfl_xor(y, 1); y += __shfl_xor(y, 2); y += __shfl_xor(y, 4);
            y += Dh * xv[u];
            if (nq == 0) F.proj[(size_t)(row0 + t0 + u) * PROJ_LD + C_SCX + h * HP + p] = (bf16)f2bf(y);
        }
    }
    float* op = F.out + (samp ? O_SSMS : O_SSMP) + (((size_t)b * NH + h) * HP + p) * NS + nq * 16;
#pragma unroll
    for (int i = 0; i < 4; ++i) *(f32x4*)(op + 4 * i) = (f32x4){S[4 * i], S[4 * i + 1], S[4 * i + 2], S[4 * i + 3]};
}
typedef float f32x16 __attribute__((ext_vector_type(16)));
typedef short bf16x8 __attribute__((ext_vector_type(8)));
constexpr int SSD_Q = 128, SSD_NC = SEQ_P / SSD_Q;
constexpr int SB_STRIDE = 272, SX_STRIDE = 144;
constexpr int L_BS = 0, L_CS = L_BS + SSD_Q * SB_STRIDE, L_XS = L_CS + SSD_Q * SB_STRIDE, L_SB = L_XS + SSD_Q * SX_STRIDE, L_A2 = L_SB + 2 * 16384, L_LA2 = L_A2 + 512, L_SSD_END = L_LA2 + 512;
static_assert(L_SSD_END <= RING_BYTES, "SSD LDS map");
constexpr float LOG2E = 1.4426950408889634f;
__device__ __forceinline__ void pack_tile(const f32x16& x, bf16x8 (&f)[2]) {
#pragma unroll
    for (int s = 0; s < 2; ++s) { pg8::u32x4 w;
#pragma unroll
        for (int k = 0; k < 4; ++k) w[k] = pk2(x[8 * s + 2 * k], x[8 * s + 2 * k + 1]);
        f[s] = __builtin_bit_cast(bf16x8, w); }
}
__device__ __forceinline__ void ssd_prompt_item(Frame& F, int b, int h) {
    LAS unsigned char* L = F.lds + RING_OFF;
    const int tid = F.tid, lane = F.lane, wid = F.wave, r32 = lane & 31, hh = lane >> 5;
    const int pt = wid >> 2, jj = wid & 3, j = pt ? 3 - jj : jj, q = jj, g = h >> 2;
    const float A2 = -__expf(F.a_log[h]) * LOG2E, dtb = F.dt_bias[h], Dh = F.d_skip[h];
    bf16x8 Id[2];
#pragma unroll
    for (int ks = 0; ks < 2; ++ks)
#pragma unroll
        for (int e = 0; e < 8; ++e) Id[ks][e] = (16 * ks + 8 * hh + e == r32) ? (short)0x3F80 : (short)0;
    for (int i = tid; i < 16384 / 16; i += NTHREADS) *(LAS v4u*)(L + L_SB + i * 16) = (v4u){0u, 0u, 0u, 0u};
    f32x16 S;
#pragma unroll
    for (int i = 0; i < 16; ++i) S[i] = 0.f;
    const bf16* xb = F.xbcc + (size_t)(b * SEQ_P) * XBC;
    const float* dtr = F.dtraw + (size_t)(b * SEQ_P) * 16 + h;
    v4u pB[4], pC[4], pX[2]; float pd0 = 0.f, pd1 = 0.f;
#define SSD_LOAD(c) do { const bf16* xc = xb + (size_t)(c) * SSD_Q * XBC; \
        _Pragma("unroll") for (int k = 0; k < 4; ++k) { const int qq = tid + NTHREADS * k, row = qq >> 4, ch = qq & 15; \
            pB[k] = *(const v4u*)(xc + (size_t)row * XBC + 1024 + g * NS + ch * 8); pC[k] = *(const v4u*)(xc + (size_t)row * XBC + 1536 + g * NS + ch * 8); } \
        _Pragma("unroll") for (int k = 0; k < 2; ++k) { const int qq = tid + NTHREADS * k, row = qq >> 3, ch = qq & 7; pX[k] = *(const v4u*)(xc + (size_t)row * XBC + h * HP + ch * 8); } \
        if (wid == 0) { pd0 = dtr[(size_t)((c) * SSD_Q + 2 * lane) * 16]; pd1 = dtr[(size_t)((c) * SSD_Q + 2 * lane + 1) * 16]; } } while (0)
    SSD_LOAD(0);
    for (int c = 0; c < SSD_NC; ++c) {
#pragma unroll
        for (int k = 0; k < 4; ++k) { const int qq = tid + NTHREADS * k, row = qq >> 4, ch = qq & 15;
            *(LAS v4u*)(L + L_BS + row * SB_STRIDE + ch * 16) = pB[k]; *(LAS v4u*)(L + L_CS + row * SB_STRIDE + ch * 16) = pC[k]; }
#pragma unroll
        for (int k = 0; k < 2; ++k) { const int qq = tid + NTHREADS * k, row = qq >> 3, ch = qq & 7; *(LAS v4u*)(L + L_XS + row * SX_STRIDE + ch * 16) = pX[k]; }
        if (wid == 0) {
            const float d0 = softplus_f(pd0 + dtb), d1 = softplus_f(pd1 + dtb), a0 = d0 * A2, a1 = d1 * A2;
            float pfx = a0 + a1;
#pragma unroll
            for (int o = 1; o < 64; o <<= 1) { const float t = __shfl_up(pfx, o); if (lane >= o) pfx += t; }
            const float c1 = pfx, c0 = pfx - a1;
            *(LAS float*)(L + L_A2 + (2 * lane) * 4) = c0; *(LAS float*)(L + L_A2 + (2 * lane + 1) * 4) = c1;
            *(LAS float*)(L + L_LA2 + (2 * lane) * 4) = c0 - __log2f(d0); *(LAS float*)(L + L_LA2 + (2 * lane + 1) * 4) = c1 - __log2f(d1);
        }
        LDS_WAIT(); __syncthreads();
        if (c + 1 < SSD_NC) SSD_LOAD(c + 1);
        LAS unsigned char* SBc = L + L_SB + (c & 1) * 16384; LAS unsigned char* SBn = L + L_SB + ((c + 1) & 1) * 16384;
        const float a2end = *(LAS float*)(L + L_A2 + 127 * 4);
#define SSD_T1(i, dst) do { f32x16 acc_; _Pragma("unroll") for (int e = 0; e < 16; ++e) acc_[e] = 0.f; \
            _Pragma("unroll") for (int ks = 0; ks < 2; ++ks) { const bf16x8 a_ = *(const LAS bf16x8*)(L + L_XS + (32 * (i) + r32) * SX_STRIDE + (32 * pt + 16 * ks + 8 * hh) * 2); \
                acc_ = __builtin_amdgcn_mfma_f32_32x32x16_bf16(a_, Id[ks], acc_, 0, 0, 0); } \
            pack_tile(acc_, dst); } while (0)
        const int lrow = 32 * j + r32; const float a2l = *(LAS float*)(L + L_A2 + lrow * 4);
        f32x16 Y;
#pragma unroll
        for (int e = 0; e < 16; ++e) Y[e] = 0.f;
#pragma unroll
        for (int qq = 0; qq < 4; ++qq)
#pragma unroll
            for (int s = 0; s < 2; ++s) { const bf16x8 a = *(const LAS bf16x8*)(SBc + ((qq * 2 + pt) * 2 + s) * 1024 + lane * 16);
                const LAS unsigned char* cp = L + L_CS + lrow * SB_STRIDE + (32 * qq + 16 * s + 4 * hh) * 2;
                const v2u c0 = *(const LAS v2u*)cp, c1 = *(const LAS v2u*)(cp + 16);
                const bf16x8 bb = __builtin_bit_cast(bf16x8, ((v4u){c0.x, c0.y, c1.x, c1.y}));
                Y = __builtin_amdgcn_mfma_f32_32x32x16_bf16(a, bb, Y, 0, 0, 0); }
        { const float el = __builtin_amdgcn_exp2f(a2l);
#pragma unroll
            for (int e = 0; e < 16; ++e) Y[e] *= el; }
        for (int i = 0; i <= j; ++i) {
            bf16x8 t1[2]; SSD_T1(i, t1);
            f32x16 X;
#pragma unroll
            for (int e = 0; e < 16; ++e) X[e] = 0.f;
#pragma unroll
            for (int ks = 0; ks < 8; ++ks) { const bf16x8 a = *(const LAS bf16x8*)(L + L_BS + (32 * i + r32) * SB_STRIDE + (16 * ks + 8 * hh) * 2);
                const bf16x8 bb = *(const LAS bf16x8*)(L + L_CS + lrow * SB_STRIDE + (16 * ks + 8 * hh) * 2);
                X = __builtin_amdgcn_mfma_f32_32x32x16_bf16(a, bb, X, 0, 0, 0); }
#pragma unroll
            for (int rg = 0; rg < 4; ++rg) { const int sb = 32 * i + 8 * rg + 4 * hh; const f32x4 la = *(const LAS f32x4*)(L + L_LA2 + sb * 4);
#pragma unroll
                for (int e = 0; e < 4; ++e) { float v = X[4 * rg + e] * __builtin_amdgcn_exp2f(a2l - la[e]);
                    if (i == j) { const int s = sb + e; v = (s <= lrow) ? v : 0.f; v += (s == lrow) ? Dh : 0.f; }
                    X[4 * rg + e] = v; } }
            bf16x8 xf[2]; pack_tile(X, xf);
#pragma unroll
            for (int s = 0; s < 2; ++s) Y = __builtin_amdgcn_mfma_f32_32x32x16_bf16(t1[s], xf[s], Y, 0, 0, 0);
        }
        { bf16* yrow = F.proj + (size_t)(b * SEQ_P + c * SSD_Q + lrow) * PROJ_LD + C_SCX + h * HP + 32 * pt + 4 * hh;
#pragma unroll
            for (int rg = 0; rg < 4; ++rg) { v2u o; o.x = pk2(Y[4 * rg], Y[4 * rg + 1]); o.y = pk2(Y[4 * rg + 2], Y[4 * rg + 3]); *(v2u*)(yrow + 8 * rg) = o; } }
        { const float dec = __builtin_amdgcn_exp2f(a2end);
#pragma unroll
            for (int e = 0; e < 16; ++e) S[e] *= dec; }
        for (int i = 0; i < 4; ++i) {
            bf16x8 t1[2]; SSD_T1(i, t1);
            f32x16 acc;
#pragma unroll
            for (int e = 0; e < 16; ++e) acc[e] = 0.f;
#pragma unroll
            for (int ks = 0; ks < 2; ++ks) { const bf16x8 a = *(const LAS bf16x8*)(L + L_BS + (32 * i + r32) * SB_STRIDE + (32 * q + 16 * ks + 8 * hh) * 2);
                acc = __builtin_amdgcn_mfma_f32_32x32x16_bf16(a, Id[ks], acc, 0, 0, 0); }
#pragma unroll
            for (int rg = 0; rg < 4; ++rg) { const int sb = 32 * i + 8 * rg + 4 * hh; const f32x4 la = *(const LAS f32x4*)(L + L_LA2 + sb * 4);
#pragma unroll
                for (int e = 0; e < 4; ++e) acc[4 * rg + e] *= __builtin_amdgcn_exp2f(a2end - la[e]); }
            bf16x8 t2[2]; pack_tile(acc, t2);
#pragma unroll
            for (int s = 0; s < 2; ++s) S = __builtin_amdgcn_mfma_f32_32x32x16_bf16(t2[s], t1[s], S, 0, 0, 0);
        }
        if (c + 1 < SSD_NC) { bf16x8 sf[2]; pack_tile(S, sf);
#pragma unroll
            for (int s = 0; s < 2; ++s) *(LAS bf16x8*)(SBn + ((q * 2 + pt) * 2 + s) * 1024 + lane * 16) = sf[s]; }
        else { float* op = F.out + O_SSMP + (((size_t)b * NH + h) * HP + 32 * pt + r32) * NS + 32 * q + 4 * hh;
#pragma unroll
            for (int rg = 0; rg < 4; ++rg) *(f32x4*)(op + 8 * rg) = (f32x4){S[4 * rg], S[4 * rg + 1], S[4 * rg + 2], S[4 * rg + 3]}; }
        LDS_WAIT(); __syncthreads();
    }
#undef SSD_LOAD
#undef SSD_T1
}
__device__ __forceinline__ void p4_scan(Frame& F) {
    const int np = (F.G >= 256) ? 128 : F.G;
    if ((int)blockIdx.x < np) for (int it = blockIdx.x; it < BATCH_P * NH; it += np) ssd_prompt_item(F, it / NH, it % NH);
    const int ns = (F.G >= 256) ? F.G - np : F.G, sb = (F.G >= 256) ? (int)blockIdx.x - np : (int)blockIdx.x;
    if (sb >= 0) for (int it = sb; it < BATCH_S * NH; it += ns) scan_item(F, BATCH_P + it / NH, it % NH);
}
__device__ __forceinline__ void p5_gatenorm(Frame& F) {
    const int gw = blockIdx.x * NWAVES + F.wave, NGW = F.G * NWAVES;
    for (int it = gw; it < M * NG; it += NGW) {
        const int r = it >> 2, g = it & 3; bf16* prow = F.proj + (size_t)r * PROJ_LD; const int c = g * 256 + 4 * F.lane;
        const v2u yq = *(const v2u*)(prow + C_SCX + c), zq = *(const v2u*)(prow + C_Z + c);
        float v[4]; v[0] = bflo(yq.x) * silu_f(bflo(zq.x)); v[1] = bfhi(yq.x) * silu_f(bfhi(zq.x)); v[2] = bflo(yq.y) * silu_f(bflo(zq.y)); v[3] = bfhi(yq.y) * silu_f(bfhi(zq.y));
        const float ss = wave_sum((v[0] * v[0] + v[1] * v[1]) + (v[2] * v[2] + v[3] * v[3]));
        const float rstd = 1.0f / sqrtf(ss * (1.f / 256.f) + EPS); const f32x4 gg = *(const f32x4*)(F.ssm_g + c);
        v2u o; o.x = pk2(v[0] * rstd * gg.x, v[1] * rstd * gg.y); o.y = pk2(v[2] * rstd * gg.z, v[3] * rstd * gg.w);
        *(v2u*)(prow + C_SCC + c) = o;
    }
}
__device__ __forceinline__ void p7_rows(Frame& F) {
    const int gw = blockIdx.x * NWAVES + F.wave, NGW = F.G * NWAVES;
    for (int m = gw; m < M; m += NGW) {
        const f32x4* xr = (const f32x4*)x_row(F, m) + F.lane; f32x4* mr = (f32x4*)(F.mix + (size_t)m * D) + F.lane; const float* md = F.mod + (size_t)seq_of(m) * 6144;
        f32x4 v[4], x1[4]; float ss = 0.f;
#pragma unroll
        for (int j = 0; j < 4; ++j) { v[j] = mr[64 * j]; ss += (v[j].x * v[j].x + v[j].y * v[j].y) + (v[j].z * v[j].z + v[j].w * v[j].w); }
        const float rstd = 1.0f / sqrtf(wave_sum(ss) * (1.f / D) + EPS); float s2 = 0.f;
#pragma unroll
        for (int j = 0; j < 4; ++j) { const int col = 256 * j + 4 * F.lane; const f32x4 g = *(const f32x4*)(F.g_mpost + col), gt = *(const f32x4*)(md + 2048 + col);
            x1[j] = xr[64 * j] + gt * ((v[j] * rstd) * g); mr[64 * j] = x1[j];
            s2 += (x1[j].x * x1[j].x + x1[j].y * x1[j].y) + (x1[j].z * x1[j].z + x1[j].w * x1[j].w); }
        const float rstd2 = 1.0f / sqrtf(wave_sum(s2) * (1.f / D) + EPS);
        unsigned long long* o8 = (unsigned long long*)(F.xn2 + (size_t)m * D) + F.lane;
#pragma unroll
        for (int j = 0; j < 4; ++j) { const int col = 256 * j + 4 * F.lane; const f32x4 g = *(const f32x4*)(F.g_fpre + col), sh = *(const f32x4*)(md + 3072 + col), sc = *(const f32x4*)(md + 4096 + col);
            const f32x4 h = (x1[j] * rstd2) * g * (sc + 1.0f) + sh;
            o8[64 * j] = (unsigned long long)pk2(h.x, h.y) | ((unsigned long long)pk2(h.z, h.w) << 32); }
    }
}
__device__ __forceinline__ void p10_rows(Frame& F) {
    const int gw = blockIdx.x * NWAVES + F.wave, NGW = F.G * NWAVES;
    for (int m = gw; m < M; m += NGW) {
        const f32x4* fr = (const f32x4*)(F.fbuf + (size_t)m * D) + F.lane; f32x4* yr = (f32x4*)(F.out + (size_t)m * D) + F.lane; const float* md = F.mod + (size_t)seq_of(m) * 6144;
        f32x4 v[4]; float ss = 0.f;
#pragma unroll
        for (int j = 0; j < 4; ++j) { v[j] = fr[64 * j]; ss += (v[j].x * v[j].x + v[j].y * v[j].y) + (v[j].z * v[j].z + v[j].w * v[j].w); }
        const float rstd = 1.0f / sqrtf(wave_sum(ss) * (1.f / D) + EPS);
#pragma unroll
        for (int j = 0; j < 4; ++j) { const int col = 256 * j + 4 * F.lane; const f32x4 g = *(const f32x4*)(F.g_fpost + col), gt = *(const f32x4*)(md + 5120 + col);
            yr[64 * j] = yr[64 * j] + gt * ((v[j] * rstd) * g); }
    }
}

constexpr int NPHASE = 11;
#ifndef MK_ONE_LAUNCH
#define MK_ONE_LAUNCH 1
#endif
__global__ void __launch_bounds__(NTHREADS, 2) hymba_fwd(Args args) {
    extern __shared__ __attribute__((aligned(16))) unsigned char lds[];
    Frame F;
    F.lds = (LAS unsigned char*)lds;
    F.MISC = (volatile LAS unsigned*)(F.lds + MISC_OFF);
    F.tid = threadIdx.x; F.lane = F.tid & 63; F.wave = __builtin_amdgcn_readfirstlane(F.tid >> 6);
    F.G = gridDim.x;
    unsigned char* ws = args.ws;
    F.ctl = (gu32*)(ws + WS_CTL);
    F.x_p = args.in[0]; F.x_s = args.in[1]; F.c_p = args.in[2]; F.c_s = args.in[3]; F.st_sc = args.in[4]; F.st_cv = args.in[5]; F.st_ssm = args.in[6];
    F.w_ada = args.in[7]; F.b_ada = args.in[8]; F.g_mpre = args.in[9]; F.g_mpost = args.in[10]; F.g_fpre = args.in[11]; F.g_fpost = args.in[12];
    F.w_in = args.in[13]; F.sc_w = args.in[14]; F.cv_w = args.in[15]; F.cv_b = args.in[16]; F.dt_bias = args.in[17]; F.a_log = args.in[18]; F.d_skip = args.in[19];
    F.ssm_g = args.in[20]; F.w_out = args.in[21]; F.w_gate = args.in[22]; F.w_up = args.in[23]; F.w_down = args.in[24];
    F.out = args.out;
    F.mod = (float*)(ws + WS_MOD); F.Win_t = (bf16*)(ws + WS_WIN); F.Wout_t = (bf16*)(ws + WS_WOUT); F.Wgu_t = (bf16*)(ws + WS_WGU); F.Wd_t = (bf16*)(ws + WS_WD);
    F.dtraw = (float*)(ws + WS_DT); F.proj = (bf16*)(ws + WS_PROJ); F.act = (bf16*)(ws + WS_ACT); F.xn2 = (bf16*)(ws + WS_XN2); F.fbuf = (float*)(ws + WS_F);
    F.xn1 = (bf16*)(args.out + O_Y); F.xbcc = (bf16*)(args.out + O_Y); F.mix = args.out + O_Y;
    for (int u = F.tid; u < (LDS_BYTES - LDSCTL_OFF) / 4; u += NTHREADS) ((LAS unsigned*)(F.lds + LDSCTL_OFF))[u] = 0u;
    __syncthreads();
    XcdBarrier bar; bar.bar = (unsigned*)(F.ctl + CW_BAR); bar.x = 0; bar.st = nullptr;
    const int lo = args.ph_lo, hi = args.ph_hi;
    if (hi - lo > 1) bar = xcd_barrier_post((unsigned*)(F.ctl + CW_BAR), F.MISC + 8);
#define IN(k) (lo <= (k) && (k) < hi)
#define SEAM(k) do { if (IN(k) && IN((k) + 1)) xcd_barrier(bar); } while (0)

    if (IN(0)) { p0_prologue(F); } SEAM(0);
    if (IN(1)) { p1_hrows(F); } SEAM(1);
    if (IN(2)) {
        pg8::Gemm g{F.xn1, F.Win_t, M, NPROJ_PAD, D, D}; pg8::StaticOrder S; S.init(M, NPROJ_PAD, F.G, (int)blockIdx.x);
        pg8::EpiProj E{F.proj, PROJ_LD, F.dtraw, PROJ_LD / 256};
        pg8::gemm_phase<pg8::EpiProj, pg8::StaticOrder, true, true>(F.lds + RING_OFF, g, S, E);
    } SEAM(2);
    if (IN(3)) { p3_conv(F); } SEAM(3);
    if (IN(4)) { p4_scan(F); } SEAM(4);
    if (IN(5)) { p5_gatenorm(F); } SEAM(5);
    if (IN(6)) {
        pg8::Gemm g{F.proj, F.Wout_t, M, D, 2048, PROJ_LD}; pg8::StaticOrder S; S.init(M, D, F.G, (int)blockIdx.x);
        pg8::EpiF32 E{F.mix, D};
        pg8::gemm_phase<pg8::EpiF32, pg8::StaticOrder, true, true>(F.lds + RING_OFF, g, S, E);
    } SEAM(6);
    if (IN(7)) { p7_rows(F); } SEAM(7);
    if (IN(8)) {
        pg8::Gemm g{F.xn2, F.Wgu_t, M, NGU, D, D}; pg8::StaticOrder S; S.init(M, NGU, F.G, (int)blockIdx.x);
        pg8::EpiSwiGLU E{F.act, FF};
        pg8::gemm_phase<pg8::EpiSwiGLU, pg8::StaticOrder, true, true>(F.lds + RING_OFF, g, S, E);
    } SEAM(8);
    if (IN(9)) {
        pg8::Gemm g{F.act, F.Wd_t, M, D, FF, FF}; pg8::StaticOrder S; S.init(M, D, F.G, (int)blockIdx.x);
        pg8::EpiF32 E{F.fbuf, D};
        pg8::gemm_phase<pg8::EpiF32, pg8::StaticOrder, true, true>(F.lds + RING_OFF, g, S, E);
    } SEAM(9);
    if (IN(10)) { p10_rows(F); }
#undef IN
#undef SEAM
}

extern "C" void kernel_launch(void* const* d_in, const int* in_sizes, int n_in, void* d_out, int out_size, void* d_ws, size_t ws_size, hipStream_t stream) {
    static int grid = 0;
    if (grid == 0) {
        if (n_in != 25 || out_size != (int)O_END || ws_size < WS_END) { fprintf(stderr, "kernel_launch: unexpected sizes n_in %d out %d ws %zu; nothing launched\n", n_in, out_size, ws_size); grid = -1; return; }
        int dev = 0, cus = 0, per_cu = 0;
        if (hipGetDevice(&dev) != hipSuccess || hipDeviceGetAttribute(&cus, hipDeviceAttributeMultiprocessorCount, dev) != hipSuccess) { grid = -1; return; }
        if (hipFuncSetAttribute((const void*)hymba_fwd, hipFuncAttributeMaxDynamicSharedMemorySize, LDS_BYTES) != hipSuccess) { fprintf(stderr, "kernel_launch: hipFuncSetAttribute failed\n"); grid = -1; return; }
        if (hipOccupancyMaxActiveBlocksPerMultiprocessor(&per_cu, (const void*)hymba_fwd, NTHREADS, LDS_BYTES) != hipSuccess || per_cu < 1) { fprintf(stderr, "kernel_launch: occupancy query says %d\n", per_cu); per_cu = 1; }
        (void)hipGetLastError();
        grid = cus;
    }
    if (grid < 0) return;
    (void)hipMemsetAsync((char*)d_ws + WS_CTL, 0, CTL_ZERO_BYTES, stream);
    Args a{};
    for (int i = 0; i < 25; ++i) a.in[i] = (const float*)d_in[i];
    a.out = (float*)d_out; a.ws = (unsigned char*)d_ws;
#if MK_ONE_LAUNCH
    a.ph_lo = 0; a.ph_hi = NPHASE;
    hipLaunchKernelGGL(hymba_fwd, dim3(grid), dim3(NTHREADS), LDS_BYTES, stream, a);
#else
    for (int ph = 0; ph < NPHASE; ++ph) { a.ph_lo = ph; a.ph_hi = ph + 1; hipLaunchKernelGGL(hymba_fwd, dim3(grid), dim3(NTHREADS), LDS_BYTES, stream, a); }
#endif
}
```

```cpp
#include <hip/hip_runtime.h>
#include <cstdio>
#include <cstdint>
namespace pg8 {
#define PG8_LAS __attribute__((address_space(3)))
typedef unsigned short bf16_t;
typedef short bf16x8 __attribute__((ext_vector_type(8)));
typedef float f32x4 __attribute__((ext_vector_type(4)));
typedef unsigned u32x4 __attribute__((ext_vector_type(4)));
constexpr int BM = 256, BK = 64, HALF = 128, HTB = HALF * BK * 2  , STAGE_BYTES = 8 * HTB, NXCD = 8, WGM = 8;

__host__ __device__ __forceinline__ int lds_byte(int r, int c) { const int st = (r >> 4) * 2 + (c >> 5), rr = r & 15, cc = c & 31, ob = rr * 64 + cc * 2; return st * 1024 + (ob ^ (((ob >> 9) & 1) << 5)); }
__host__ __device__ __forceinline__ void stage_rc(int b, int& R, int& C) { const int st = b / 1024, sb = b % 1024, swz = sb ^ (((sb >> 9) & 1) << 5); R = (st >> 1) * 16 + swz / 64; C = (st & 1) * 32 + (swz % 64) / 2; }
__host__ __device__ __forceinline__ int perm32(int rho) { const int n = rho >> 4, i = rho & 15; return 8 * (i >> 2) + 4 * n + (i & 3); }

struct Unit { int pm, pn, kb; };
struct Gemm { const bf16_t* A; const bf16_t* Bt; int M, N, K, lda, Kloop; };

struct StaticOrder {
    int nM, nN, nwg, G, c;
    __host__ __device__ void init(int M, int N, int G_, int c_) { nM = M / BM; nN = N / BM; nwg = nM * nN; G = G_; c = c_; }
    __host__ __device__ bool next(int i, Unit& u) const {
        const long L = (long)i * G + c; if (L >= nwg) return false;
        int wgid = (int)L; { const int q = nwg / NXCD, r = nwg % NXCD, xcd = wgid % NXCD, off = wgid / NXCD; wgid = (xcd < r ? xcd * (q + 1) : r * (q + 1) + (xcd - r) * q) + off; }
        const int nig = WGM * nN, gid = wgid / nig, fm = gid * WGM, gsz = (nM - fm) < WGM ? (nM - fm) : WGM;
        u.pm = fm + ((wgid % nig) % gsz); u.pn = (wgid % nig) / gsz; u.kb = 0; return true;
    }
    __device__ __forceinline__ void a_ready(const Unit&) const {}
    __device__ __forceinline__ void done(const Unit&) const {}
};

template <int NKS, int KSLICE, int PM0, int NN, int NUNITS> struct SplitKOrder {
    int G, c;
    __host__ __device__ bool next(int i, Unit& u) const {
        const int L = i * G + c; if (L >= NUNITS * NKS) return false;
        const int unit = L / NKS, ks = L % NKS; u.pm = PM0 + unit / NN; u.pn = unit % NN; u.kb = ks * KSLICE; return true;
    }
    __device__ __forceinline__ void a_ready(const Unit&) const {}
    __device__ __forceinline__ void done(const Unit&) const {}
};

__device__ __forceinline__ unsigned cvt_pk_bf16(float lo, float hi) { unsigned r; asm volatile("v_cvt_pk_bf16_f32 %0, %1, %2" : "=v"(r) : "v"(lo), "v"(hi)); return r; }

struct EpiF32 {
    static constexpr bool PERM = false, AFTER_DRAIN = false;
    float* C; int ldc;
    __device__ __forceinline__ void operator()(const f32x4 (&acc)[2][2][4][2], const Unit& u, int wr, int wc, int fr, int fq) const {
        const int row0 = u.pm * BM + wr * 64 + fr, col0 = u.pn * BM + wc * 32 + 4 * fq;
#pragma unroll
        for (int ai = 0; ai < 2; ++ai)
#pragma unroll
            for (int m = 0; m < 4; ++m) { float* rowp = C + (size_t)(row0 + ai * HALF + m * 16) * ldc + col0;
#pragma unroll
                for (int bj = 0; bj < 2; ++bj)
#pragma unroll
                    for (int n = 0; n < 2; ++n) *(f32x4*)(rowp + bj * HALF + n * 16) = acc[ai][bj][m][n]; }
    }
};
struct EpiBf16Plain {
    static constexpr bool PERM = true, AFTER_DRAIN = false;
    bf16_t* O; int ldc;
    __device__ __forceinline__ void operator()(const f32x4 (&acc)[2][2][4][2], const Unit& u, int wr, int wc, int fr, int fq) const {
        const int row0 = u.pm * BM + wr * 64 + fr, col0 = u.pn * BM + wc * 32 + 8 * fq;
#pragma unroll
        for (int ai = 0; ai < 2; ++ai)
#pragma unroll
            for (int m = 0; m < 4; ++m) { bf16_t* rowp = O + (size_t)(row0 + ai * HALF + m * 16) * ldc + col0;
#pragma unroll
                for (int bj = 0; bj < 2; ++bj) { const f32x4 v0 = acc[ai][bj][m][0], v1 = acc[ai][bj][m][1];
                    u32x4 w; w.x = cvt_pk_bf16(v0[0], v0[1]); w.y = cvt_pk_bf16(v0[2], v0[3]); w.z = cvt_pk_bf16(v1[0], v1[1]); w.w = cvt_pk_bf16(v1[2], v1[3]);
                    *(u32x4*)(rowp + bj * HALF) = w; } }
    }
};
struct EpiSlabF32 {
    static constexpr bool PERM = false, AFTER_DRAIN = false;
    float* C; int ldc, pm0, kslice, rows_per_slab;
    __device__ __forceinline__ void operator()(const f32x4 (&acc)[2][2][4][2], const Unit& u, int wr, int wc, int fr, int fq) const {
        const int row0 = (u.kb / kslice) * rows_per_slab + (u.pm - pm0) * BM + wr * 64 + fr, col0 = u.pn * BM + wc * 32 + 4 * fq;
#pragma unroll
        for (int ai = 0; ai < 2; ++ai)
#pragma unroll
            for (int m = 0; m < 4; ++m) { float* rowp = C + (size_t)(row0 + ai * HALF + m * 16) * ldc + col0;
#pragma unroll
                for (int bj = 0; bj < 2; ++bj)
#pragma unroll
                    for (int n = 0; n < 2; ++n) *(f32x4*)(rowp + bj * HALF + n * 16) = acc[ai][bj][m][n]; }
    }
};
struct EpiProj {
    static constexpr bool PERM = true, AFTER_DRAIN = false;
    bf16_t* O; int ldc; float* dt; int dt_tile;
    __device__ __forceinline__ void operator()(const f32x4 (&acc)[2][2][4][2], const Unit& u, int wr, int wc, int fr, int fq) const {
        const int row0 = u.pm * BM + wr * 64 + fr;
        if (u.pn == dt_tile) {
            if (wc == 0 && fq < 2) {
#pragma unroll
                for (int ai = 0; ai < 2; ++ai)
#pragma unroll
                    for (int m = 0; m < 4; ++m) { float* rowp = dt + (size_t)(row0 + ai * HALF + m * 16) * 16 + 8 * fq;
                        *(f32x4*)(rowp) = acc[ai][0][m][0]; *(f32x4*)(rowp + 4) = acc[ai][0][m][1]; }
            }
            return;
        }
        const int col0 = u.pn * BM + wc * 32 + 8 * fq;
#pragma unroll
        for (int ai = 0; ai < 2; ++ai)
#pragma unroll
            for (int m = 0; m < 4; ++m) { bf16_t* rowp = O + (size_t)(row0 + ai * HALF + m * 16) * ldc + col0;
#pragma unroll
                for (int bj = 0; bj < 2; ++bj) { const f32x4 v0 = acc[ai][bj][m][0], v1 = acc[ai][bj][m][1];
                    u32x4 w; w.x = cvt_pk_bf16(v0[0], v0[1]); w.y = cvt_pk_bf16(v0[2], v0[3]); w.z = cvt_pk_bf16(v1[0], v1[1]); w.w = cvt_pk_bf16(v1[2], v1[3]);
                    *(u32x4*)(rowp + bj * HALF) = w; } }
    }
};
struct EpiSwiGLU {
    static constexpr bool PERM = true, AFTER_DRAIN = false;
    bf16_t* O; int ldc;
    __device__ __forceinline__ void operator()(const f32x4 (&acc)[2][2][4][2], const Unit& u, int wr, int wc, int fr, int fq) const {
        const int row0 = u.pm * BM + wr * 64 + fr, col0 = u.pn * HALF + wc * 32 + 8 * fq;
#pragma unroll
        for (int ai = 0; ai < 2; ++ai)
#pragma unroll
            for (int m = 0; m < 4; ++m) { bf16_t* rowp = O + (size_t)(row0 + ai * HALF + m * 16) * ldc + col0;
                float r[8];
#pragma unroll
                for (int n = 0; n < 2; ++n)
#pragma unroll
                    for (int i = 0; i < 4; ++i) { const float g = acc[ai][0][m][n][i], up = acc[ai][1][m][n][i];
                        r[n * 4 + i] = g * up * __builtin_amdgcn_rcpf(1.0f + __builtin_amdgcn_exp2f(-1.4426950408889634f * g)); }
                u32x4 w; w.x = cvt_pk_bf16(r[0], r[1]); w.y = cvt_pk_bf16(r[2], r[3]); w.z = cvt_pk_bf16(r[4], r[5]); w.w = cvt_pk_bf16(r[6], r[7]);
                *(u32x4*)(rowp) = w; }
    }
};

template <class Epi, class Sched, bool ALIGN_EPI = false, bool SP2 = false>
__device__ __forceinline__ void gemm_phase(PG8_LAS unsigned char* lds, const Gemm g, const Sched& S, const Epi& E) {
    const int tid = threadIdx.x, wid = __builtin_amdgcn_readfirstlane(tid >> 6), lane = tid & 63, wr = wid >> 2, wc = wid & 3, fr = lane & 15, fq = lane >> 4;
    const int K = g.K, nt = g.Kloop / BK;
    unsigned voffA[2], voffB[2];
#pragma unroll
    for (int i = 0; i < 2; ++i) { int R, C; stage_rc(tid * 16 + i * 8192, R, C); const int Rb = Epi::PERM ? ((R & ~31) + perm32(R & 31)) : R;
        voffA[i] = (unsigned)(R * g.lda + C) * 2u; voffB[i] = (unsigned)(Rb * K + C) * 2u; }
    const size_t kstep = (size_t)(BK * 2);
    const size_t hstep = (size_t)HALF * K * 2, hstepA = (size_t)HALF * g.lda * 2;
    const size_t tstep = 2 * hstep, tstepA = 2 * hstepA;
    const unsigned ldsw = (unsigned)wid * 1024u;
    const int aoff = lds_byte(wr * 64 + fr, fq * 8), boff = lds_byte(wc * 32 + fr, fq * 8);
#define PG8_SA(b, h) (((b) * 2 + (h)) * HTB)
#define PG8_SB(b, h) ((4 + (b) * 2 + (h)) * HTB)
#define PG8_STAGE(bufoff, gbase, voff) do { _Pragma("unroll") for (int _i = 0; _i < 2; ++_i) \
        __builtin_amdgcn_global_load_lds((const unsigned*)((const char*)(gbase) + (voff)[_i]), (PG8_LAS unsigned*)(lds + (bufoff) + ldsw + _i * 8192), 16, 0, 0); } while (0)
#define PG8_LDA(dst, b, h) do { _Pragma("unroll") for (int m = 0; m < 4; ++m) _Pragma("unroll") for (int k = 0; k < 2; ++k) dst[m][k] = *(const PG8_LAS bf16x8*)(lds + PG8_SA(b, h) + aoff + m * 2048 + k * 1024); } while (0)
#define PG8_LDB(dst, b, h) do { _Pragma("unroll") for (int n = 0; n < 2; ++n) _Pragma("unroll") for (int k = 0; k < 2; ++k) dst[n][k] = *(const PG8_LAS bf16x8*)(lds + PG8_SB(b, h) + boff + n * 2048 + k * 1024); } while (0)
#define PG8_MMA(ai, bj, At, Bt) do { __builtin_amdgcn_s_setprio(1); _Pragma("unroll") for (int m = 0; m < 4; ++m) _Pragma("unroll") for (int n = 0; n < 2; ++n) _Pragma("unroll") for (int k = 0; k < 2; ++k) \
        acc[ai][bj][m][n] = __builtin_amdgcn_mfma_f32_16x16x32_bf16(Bt[n][k], At[m][k], acc[ai][bj][m][n], 0, 0, 0); __builtin_amdgcn_s_setprio(0); } while (0)
#define PG8_WAIT_V(n) asm volatile("s_waitcnt vmcnt(" #n ")" ::: "memory")
#define PG8_WAIT_L(n) asm volatile("s_waitcnt lgkmcnt(" #n ")" ::: "memory")
#define PG8_BAR __builtin_amdgcn_s_barrier()
#define PG8_SCHED __builtin_amdgcn_sched_barrier(0)
    Unit cur, nxt; int ui = 0;
    if (!S.next(0, cur)) return;
    f32x4 acc[2][2][4][2];
#pragma unroll
    for (int a = 0; a < 2; ++a)
#pragma unroll
        for (int b = 0; b < 2; ++b)
#pragma unroll
            for (int m = 0; m < 4; ++m)
#pragma unroll
                for (int n = 0; n < 2; ++n) acc[a][b][m][n] = (f32x4){0.f, 0.f, 0.f, 0.f};
    bf16x8 At[4][2], B0[2][2], B1[2][2];
    const char* cA = (const char*)g.A + (size_t)cur.pm * tstepA + (size_t)cur.kb * 2; const char* cB = (const char*)g.Bt + (size_t)cur.pn * tstep + (size_t)cur.kb * 2;
    S.a_ready(cur);
    if constexpr (SP2) {
        PG8_STAGE(PG8_SB(0, 0), cB, voffB); PG8_STAGE(PG8_SB(0, 1), cB + hstep, voffB); PG8_STAGE(PG8_SA(0, 0), cA, voffA); PG8_STAGE(PG8_SA(0, 1), cA + hstepA, voffA);
        if (wr == 1) PG8_BAR;
        PG8_WAIT_V(2); PG8_BAR;
        PG8_STAGE(PG8_SB(1, 0), cB + kstep, voffB); PG8_STAGE(PG8_SA(1, 0), cA + kstep, voffA); PG8_STAGE(PG8_SB(1, 1), cB + hstep + kstep, voffB);
        PG8_WAIT_V(6); PG8_BAR;
    } else {
        PG8_STAGE(PG8_SB(0, 0), cB, voffB); PG8_STAGE(PG8_SA(0, 0), cA, voffA); PG8_STAGE(PG8_SB(0, 1), cB + hstep, voffB); PG8_STAGE(PG8_SA(0, 1), cA + hstepA, voffA);
        if (wr == 1) PG8_BAR;
        PG8_WAIT_V(4); PG8_BAR;
        PG8_STAGE(PG8_SB(1, 0), cB + kstep, voffB); PG8_STAGE(PG8_SA(1, 0), cA + kstep, voffA); PG8_STAGE(PG8_SB(1, 1), cB + hstep + kstep, voffB);
        PG8_WAIT_V(6); PG8_BAR;
    }
    for (;;) {
        const bool has_next = S.next(ui + 1, nxt);
        const char* nA = has_next ? (const char*)g.A + (size_t)nxt.pm * tstepA + (size_t)nxt.kb * 2 : cA; const char* nB = has_next ? (const char*)g.Bt + (size_t)nxt.pn * tstep + (size_t)nxt.kb * 2 : cB;
        for (int t = 0; t < nt; t += 2) {
            const bool last = (t == nt - 2);
            const char* a1 = cA + (size_t)(t + 1) * kstep;
            const char* a2 = last ? nA : cA + (size_t)(t + 2) * kstep; const char* b2 = last ? nB : cB + (size_t)(t + 2) * kstep;
            const char* a3 = a2 + kstep; const char* b3 = b2 + kstep;
            if (last && has_next) S.a_ready(nxt);
            if constexpr (SP2) {
            PG8_LDB(B0, 0, 0); PG8_LDB(B1, 0, 1); PG8_SCHED; PG8_LDA(At, 0, 0); PG8_STAGE(PG8_SA(1, 1), a1 + hstepA, voffA);
            PG8_WAIT_V(8); PG8_WAIT_L(0); PG8_BAR; PG8_MMA(0, 0, At, B0); PG8_MMA(0, 1, At, B1); PG8_BAR; PG8_SCHED;
            PG8_LDA(At, 0, 1); PG8_STAGE(PG8_SB(0, 0), b2, voffB); PG8_STAGE(PG8_SB(0, 1), b2 + hstep, voffB); PG8_STAGE(PG8_SA(0, 0), a2, voffA);
            PG8_WAIT_V(8); PG8_WAIT_L(0); PG8_BAR; PG8_MMA(1, 0, At, B0); PG8_MMA(1, 1, At, B1); PG8_BAR; PG8_SCHED;
            PG8_LDB(B0, 1, 0); PG8_LDB(B1, 1, 1); PG8_SCHED; PG8_LDA(At, 1, 0); PG8_STAGE(PG8_SA(0, 1), a2 + hstepA, voffA);
            PG8_WAIT_V(8); PG8_WAIT_L(0); PG8_BAR; PG8_MMA(0, 0, At, B0); PG8_MMA(0, 1, At, B1); PG8_BAR; PG8_SCHED;
            PG8_LDA(At, 1, 1); PG8_STAGE(PG8_SB(1, 0), b3, voffB); PG8_STAGE(PG8_SB(1, 1), b3 + hstep, voffB); PG8_STAGE(PG8_SA(1, 0), a3, voffA);
            PG8_WAIT_V(8); PG8_WAIT_L(0); PG8_BAR; PG8_MMA(1, 0, At, B0); PG8_MMA(1, 1, At, B1); PG8_BAR; PG8_SCHED;
            } else {
            PG8_LDB(B0, 0, 0); PG8_SCHED; PG8_LDA(At, 0, 0); PG8_STAGE(PG8_SA(1, 1), a1 + hstepA, voffA);
            PG8_WAIT_L(8); PG8_BAR; PG8_WAIT_L(0); PG8_MMA(0, 0, At, B0); PG8_BAR; PG8_SCHED;
            PG8_LDB(B1, 0, 1); PG8_STAGE(PG8_SB(0, 0), b2, voffB);
            PG8_BAR; PG8_WAIT_L(0); PG8_MMA(0, 1, At, B1); PG8_BAR;
            PG8_LDA(At, 0, 1); PG8_STAGE(PG8_SA(0, 0), a2, voffA);
            PG8_BAR; PG8_WAIT_L(0); PG8_MMA(1, 0, At, B0); PG8_BAR; PG8_SCHED;
            PG8_STAGE(PG8_SB(0, 1), b2 + hstep, voffB);
            PG8_WAIT_V(6); PG8_BAR; PG8_MMA(1, 1, At, B1); PG8_BAR;
            PG8_LDB(B0, 1, 0); PG8_SCHED; PG8_LDA(At, 1, 0); PG8_STAGE(PG8_SA(0, 1), a2 + hstepA, voffA);
            PG8_WAIT_L(8); PG8_BAR; PG8_WAIT_L(0); PG8_MMA(0, 0, At, B0); PG8_BAR; PG8_SCHED;
            PG8_LDB(B1, 1, 1); PG8_STAGE(PG8_SB(1, 0), b3, voffB);
            PG8_BAR; PG8_WAIT_L(0); PG8_MMA(0, 1, At, B1); PG8_BAR;
            PG8_LDA(At, 1, 1); PG8_STAGE(PG8_SA(1, 0), a3, voffA);
            PG8_BAR; PG8_WAIT_L(0); PG8_MMA(1, 0, At, B0); PG8_BAR; PG8_SCHED;
            PG8_STAGE(PG8_SB(1, 1), b3 + hstep, voffB);
            PG8_WAIT_V(6); PG8_BAR; PG8_MMA(1, 1, At, B1); PG8_BAR;
            }
        }
        if constexpr (ALIGN_EPI) { if (wr == 0) PG8_BAR; }
        if constexpr (!Epi::AFTER_DRAIN) { E(acc, cur, wr, wc, fr, fq); S.done(cur); }
        if (!has_next) break;
#pragma unroll
        for (int a = 0; a < 2; ++a)
#pragma unroll
            for (int b = 0; b < 2; ++b)
#pragma unroll
                for (int m = 0; m < 4; ++m)
#pragma unroll
                    for (int n = 0; n < 2; ++n) acc[a][b][m][n] = (f32x4){0.f, 0.f, 0.f, 0.f};
        cur = nxt; cA = nA; cB = nB; ++ui;
        if constexpr (ALIGN_EPI) { if (wr == 1) PG8_BAR; }
    }
    PG8_WAIT_V(0);
    if constexpr (!ALIGN_EPI) { if (wr == 0) PG8_BAR; }
    PG8_BAR;
    if constexpr (Epi::AFTER_DRAIN) { E.fused(acc, cur, wr, wc, fr, fq, lds, wid, lane); S.done(cur); }
#undef PG8_SA
#undef PG8_SB
#undef PG8_STAGE
#undef PG8_LDA
#undef PG8_LDB
#undef PG8_MMA
#undef PG8_WAIT_V
#undef PG8_WAIT_L
#undef PG8_BAR
#undef PG8_SCHED
}}

constexpr int NWAVES = 8, NTHREADS = NWAVES * 64;
constexpr int D = 1024, BATCH_P = 8, SEQ_P = 2048, BATCH_S = 128, SEQ_S = 8;
constexpr int MP = BATCH_P * SEQ_P, MS = BATCH_S * SEQ_S, M = MP + MS;
constexpr int NSEQ = BATCH_P + BATCH_S;
constexpr int SCW = 1024, SSMW = 1024, NH = 16, HP = 64, NG = 4, NS = 128, XBC = 2048;
constexpr int NPROJ = 6160, NPROJ_PAD = 6400, PROJ_LD = 6144;
constexpr int C_SCB = 0, C_SCC = 1024, C_SCX = 2048, C_Z = 3072, C_XBC = 4096;
constexpr int FF = 2816, NGU = 2 * FF;
constexpr float EPS = 1e-6f;
constexpr size_t O_Y = 0, O_SCP = (size_t)M * D, O_CVP = O_SCP + (size_t)BATCH_P * 2 * SCW, O_SSMP = O_CVP + (size_t)BATCH_P * 3 * XBC,
                 O_SCS = O_SSMP + (size_t)BATCH_P * NH * HP * NS, O_CVS = O_SCS + (size_t)BATCH_S * 2 * SCW, O_SSMS = O_CVS + (size_t)BATCH_S * 3 * XBC,
                 O_END = O_SSMS + (size_t)BATCH_S * NH * HP * NS;
static_assert(O_END == 36765696ull, "output size");
constexpr size_t MiB = 1u << 20;
constexpr size_t WS_CTL = 0, CTL_ZERO_BYTES = 1 * MiB;
constexpr size_t WS_MOD = 1 * MiB;
constexpr size_t WS_WIN = 5 * MiB;
constexpr size_t WS_WOUT = 18 * MiB;
constexpr size_t WS_WGU = 22 * MiB;
constexpr size_t WS_WD = 33 * MiB;
constexpr size_t WS_DT = 39 * MiB;
constexpr size_t WS_PROJ = 41 * MiB;
constexpr size_t WS_ACT = 41 * MiB;
constexpr size_t WS_XN2 = 138 * MiB;
constexpr size_t WS_F = 172 * MiB;
constexpr size_t WS_SLAB9 = 204 * MiB;
constexpr size_t WS_END = 256 * MiB;
static_assert(WS_XN2 >= WS_PROJ + (size_t)8192 * PROJ_LD * 2 && WS_PROJ + (size_t)M * PROJ_LD * 2 <= WS_END && WS_ACT + (size_t)M * FF * 2 <= WS_XN2 && WS_XN2 + (size_t)M * D * 2 <= WS_F && WS_F + (size_t)MP * D * 2 <= WS_SLAB9 && WS_SLAB9 + (size_t)11 * MS * D * 4 <= WS_END, "d_ws map");
static_assert(WS_WIN + (size_t)NPROJ_PAD * D * 2 <= WS_WOUT && WS_WD + (size_t)D * FF * 2 <= WS_DT && WS_DT + (size_t)M * 16 * 4 <= WS_PROJ, "d_ws map 2");
constexpr int CW_BAR = 4096;
constexpr int RING_OFF = 0, RING_BYTES = 131072;
constexpr int LDSCTL_OFF = RING_BYTES, MISC_OFF = LDSCTL_OFF + 320;
constexpr int LDS_BYTES = 147456;
static_assert(MISC_OFF + 128 <= LDS_BYTES, "LDS map");

#define GAS __attribute__((address_space(1)))
#define LAS __attribute__((address_space(3)))
typedef unsigned short bf16;
typedef unsigned v4u __attribute__((ext_vector_type(4)));
typedef unsigned v2u __attribute__((ext_vector_type(2)));
typedef float f32x4 __attribute__((ext_vector_type(4)));
typedef GAS unsigned gu32;
#define RLX_AGENT __ATOMIC_RELAXED, __HIP_MEMORY_SCOPE_AGENT
#define LDS_WAIT() asm volatile("s_waitcnt lgkmcnt(0)" ::: "memory")
#define VM_WAIT() asm volatile("s_waitcnt vmcnt(0)" ::: "memory")
__device__ __forceinline__ unsigned f2bf(float f) { unsigned u = __builtin_bit_cast(unsigned, f); return (u + 0x7fffu + ((u >> 16) & 1u)) >> 16; }
typedef float f32x2_t __attribute__((ext_vector_type(2))); typedef __bf16 bf16x2_t __attribute__((ext_vector_type(2)));
__device__ __forceinline__ unsigned pk2(float lo, float hi) { f32x2_t v = {lo, hi}; bf16x2_t b = __builtin_convertvector(v, bf16x2_t); return __builtin_bit_cast(unsigned, b); }
__device__ __forceinline__ float bflo(unsigned u) { return __builtin_bit_cast(float, u << 16); }
__device__ __forceinline__ float bfhi(unsigned u) { return __builtin_bit_cast(float, u & 0xffff0000u); }
__device__ __forceinline__ float bf1(bf16 h) { return __builtin_bit_cast(float, (unsigned)h << 16); }
__device__ __forceinline__ float silu_f(float v) { return v * __builtin_amdgcn_rcpf(1.0f + __builtin_amdgcn_exp2f(-1.4426950408889634f * v)); }
__device__ __forceinline__ float softplus_f(float v) { return v > 20.f ? v : log1pf(__expf(v)); }

#define XB_TMO      128
#define XB_XCNT(j)  (256  + 64 * (j))
#define XB_XSUB(j)  (1280 + 64 * (j))
#define XB_XGEN(j)  (2304 + 64 * (j))
#define XB_TOP      3328
#define XB_TOPGEN   3392
#define XCD_BAR_WORDS 3456
#define XB_SPIN_CAP (1u << 18)
__device__ __forceinline__ unsigned xb_ld(unsigned* p)              { return __hip_atomic_load(p, __ATOMIC_RELAXED, __HIP_MEMORY_SCOPE_AGENT); }
__device__ __forceinline__ unsigned xb_add(unsigned* p, unsigned v) { return __hip_atomic_fetch_add(p, v, __ATOMIC_RELAXED, __HIP_MEMORY_SCOPE_AGENT); }
__device__ __forceinline__ unsigned xb_xcc_id() { return (unsigned)__builtin_amdgcn_s_getreg((3 << 11) | 20) & 0xFu; }
#define XB_SPIN(cond, bar) do { unsigned _sp = 0; while (cond) { __builtin_amdgcn_s_sleep(1); \
    if ((++_sp & 255u) == 0u) { if (xb_ld(&(bar)[XB_TMO])) break; if (_sp > XB_SPIN_CAP) { atomicAdd(&(bar)[XB_TMO], 1u); break; } } } } while (0)
struct XcdBarrier { unsigned* bar; unsigned x; volatile LAS unsigned* st; };
__device__ __forceinline__ XcdBarrier xcd_barrier_post(unsigned* bar, volatile LAS unsigned* st) {
    XcdBarrier b; b.bar = bar; b.x = xb_xcc_id(); b.st = st;
    if (threadIdx.x == 0) (void)xb_add(&bar[XB_XCNT(b.x)], 1u);
    return b;
}
__device__ __forceinline__ void xcd_barrier_complete(unsigned* bar, unsigned x, unsigned& nloc, unsigned& nx) {
    const unsigned G = gridDim.x * gridDim.y * gridDim.z;
    unsigned sum, cnt, mine, sp = 0u;
    for (;;) {
        sum = 0u; cnt = 0u; mine = 0u;
#pragma unroll
        for (unsigned j = 0; j < 16; ++j) { const unsigned c = xb_ld(&bar[XB_XCNT(j)]); sum += c; cnt += (c > 0u) ? 1u : 0u; mine = (j == x) ? c : mine; }
        if (sum == G) break;
        __builtin_amdgcn_s_sleep(1);
        if ((++sp & 255u) == 0u) { if (xb_ld(&bar[XB_TMO])) break; if (sp > XB_SPIN_CAP) { atomicAdd(&bar[XB_TMO], 1u); break; } }
    }
    nloc = mine > 0u ? mine : 1u; nx = cnt > 0u ? cnt : 1u;
}
__device__ __forceinline__ void xcd_barrier(const XcdBarrier& b) {
    asm volatile("s_waitcnt vmcnt(0)" ::: "memory");
    __syncthreads();
    if (threadIdx.x == 0) {
        unsigned* bar = b.bar;
        __builtin_amdgcn_s_waitcnt(0);
        unsigned nloc = b.st[0], nx = b.st[1];
        if (nloc == 0u) { xcd_barrier_complete(bar, b.x, nloc, nx); b.st[0] = nloc; b.st[1] = nx; }
        const unsigned old = xb_add(&bar[XB_XSUB(b.x)], 1u);
        const unsigned gen = old / nloc;
        if (old + 1u == (gen + 1u) * nloc) {
            __builtin_amdgcn_fence(__ATOMIC_RELEASE, "agent");
            asm volatile("s_waitcnt vmcnt(0)" ::: "memory");
            const unsigned og = xb_add(&bar[XB_TOP], 1u);
            const unsigned tg = og / nx;
            if (og + 1u == (tg + 1u) * nx) xb_add(&bar[XB_TOPGEN], 1u);
            else XB_SPIN(xb_ld(&bar[XB_TOPGEN]) == tg, bar);
            __builtin_amdgcn_fence(__ATOMIC_ACQUIRE, "agent");
            xb_add(&bar[XB_XGEN(b.x)], 1u);
            asm volatile("s_waitcnt vmcnt(0)" ::: "memory");
        } else {
            XB_SPIN(xb_ld(&bar[XB_XGEN(b.x)]) == gen, bar);
            __builtin_amdgcn_fence(__ATOMIC_ACQUIRE, "agent");
            asm volatile("s_waitcnt vmcnt(0)" ::: "memory");
        }
    }
    __syncthreads();
}

struct Args { const float* in[25]; float* out; unsigned char* ws; int ph_lo, ph_hi; };
struct Frame {
    LAS unsigned char* lds;
    volatile LAS unsigned* MISC;
    gu32* ctl;
    int tid, lane, wave, G;
    const float *x_p, *x_s, *c_p, *c_s, *st_sc, *st_cv, *st_ssm, *w_ada, *b_ada, *g_mpre, *g_mpost, *g_fpre, *g_fpost, *w_in, *sc_w, *cv_w, *cv_b, *dt_bias, *a_log, *d_skip, *ssm_g, *w_out, *w_gate, *w_up, *w_down;
    float* out;
    float* mod; bf16 *Win_t, *Wout_t, *Wgu_t, *Wd_t; float* dtraw; bf16 *proj, *act, *xn2; bf16* fbuf; float *slab6, *slab9;
    bf16* xn1;
    bf16* xbcc;
    float* x1;
};
__device__ __forceinline__ float wave_sum(float v) {
#pragma unroll
    for (int o = 1; o < 64; o <<= 1) v += __shfl_xor(v, o);
    return v;
}
__device__ __forceinline__ const float* x_row(const Frame& F, int m) { return m < MP ? F.x_p + (size_t)m * D : F.x_s + (size_t)(m - MP) * D; }
__device__ __forceinline__ int seq_of(int m) { return m < MP ? (m >> 11) : BATCH_P + ((m - MP) >> 3); }

__device__ __forceinline__ void p0_transpose_item(const float* W, int K, int N, int nblk, bf16* WT, int mode, LAS float* scr, int item, int lane) {
    const int kb = item / nblk, nb = item % nblk, k0 = 64 * kb, n0 = 32 * nb;
    const bool ok = (n0 + (lane & 31)) < N;
#pragma unroll 8
    for (int i = 0; i < 32; ++i) { const int kk = 2 * i + (lane >> 5); scr[kk * 33 + (lane & 31)] = ok ? W[(size_t)(k0 + kk) * N + n0 + (lane & 31)] : 0.f; }
    LDS_WAIT(); asm volatile("" ::: "memory");
    const int c = lane & 7;
    const int r0 = mode == 0 ? n0 : ((n0 >> 7) * 256 + (n0 & 127) + (mode == 2 ? 128 : 0));
#pragma unroll
    for (int j = 0; j < 4; ++j) { const int n = (lane >> 3) + 8 * j; const LAS float* s = scr + (8 * c) * 33 + n;
        v4u o; o.x = pk2(s[0 * 33], s[1 * 33]); o.y = pk2(s[2 * 33], s[3 * 33]); o.z = pk2(s[4 * 33], s[5 * 33]); o.w = pk2(s[6 * 33], s[7 * 33]);
        *(v4u*)(WT + (size_t)(r0 + n) * K + k0 + 8 * c) = o; }
    LDS_WAIT(); asm volatile("" ::: "memory");
}

__device__ __forceinline__ void p0_prologue(Frame& F) {
    {
        LAS float* sc = (LAS float*)(F.lds + RING_OFF);
        for (int it = blockIdx.x; it < 17 * 12; it += F.G) {
            const int sg = it / 12, cb = it % 12, s0 = sg * 8;
            for (int idx = F.tid; idx < 8192; idx += NTHREADS) { const int sl = idx >> 10, k = idx & 1023, s = s0 + sl;
                const float* cp = s < BATCH_P ? F.c_p + (size_t)s * D : F.c_s + (size_t)(s - BATCH_P) * D; sc[k * 8 + sl] = silu_f(cp[k]); }
            __syncthreads();
            const int j = cb * 512 + F.tid; float acc[8];
#pragma unroll
            for (int i = 0; i < 8; ++i) acc[i] = 0.f;
#pragma unroll 8
            for (int k = 0; k < D; ++k) { const float w = F.w_ada[(size_t)k * 6144 + j]; const f32x4 a = *(const LAS f32x4*)(sc + k * 8), b = *(const LAS f32x4*)(sc + k * 8 + 4);
                acc[0] += a[0] * w; acc[1] += a[1] * w; acc[2] += a[2] * w; acc[3] += a[3] * w; acc[4] += b[0] * w; acc[5] += b[1] * w; acc[6] += b[2] * w; acc[7] += b[3] * w; }
            const float bj = F.b_ada[j];
#pragma unroll
            for (int i = 0; i < 8; ++i) F.mod[(size_t)(s0 + i) * 6144 + j] = acc[i] + bj;
            __syncthreads();
        }
    }
    LAS float* scr = (LAS float*)(F.lds + RING_OFF + F.wave * 16384);
    const int gw = blockIdx.x * NWAVES + F.wave, NGW = F.G * NWAVES;
    constexpr int I_IN = (D / 64) * (NPROJ_PAD / 32), I_OUT = (2048 / 64) * (D / 32), I_G = (D / 64) * (FF / 32), I_D = (FF / 64) * (D / 32);
    constexpr int NITEMS = I_IN + I_OUT + 2 * I_G + I_D;
    for (int it = gw; it < NITEMS; it += NGW) {
        int r = it;
        if (r < I_IN) { p0_transpose_item(F.w_in, D, NPROJ, NPROJ_PAD / 32, F.Win_t, 0, scr, r, F.lane); continue; } r -= I_IN;
        if (r < I_OUT) { p0_transpose_item(F.w_out, 2048, D, D / 32, F.Wout_t, 0, scr, r, F.lane); continue; } r -= I_OUT;
        if (r < I_G) { p0_transpose_item(F.w_gate, D, FF, FF / 32, F.Wgu_t, 1, scr, r, F.lane); continue; } r -= I_G;
        if (r < I_G) { p0_transpose_item(F.w_up, D, FF, FF / 32, F.Wgu_t, 2, scr, r, F.lane); continue; } r -= I_G;
        p0_transpose_item(F.w_down, FF, D, D / 32, F.Wd_t, 0, scr, r, F.lane);
    }
}
__device__ __forceinline__ void p1_hrows(Frame& F) {
    const int gw = blockIdx.x * NWAVES + F.wave, NGW = F.G * NWAVES;
    for (int m = gw; m < M; m += NGW) {
        const f32x4* xr = (const f32x4*)x_row(F, m) + F.lane; const float* md = F.mod + (size_t)seq_of(m) * 6144;
        f32x4 v[4]; float ss = 0.f;
#pragma unroll
        for (int j = 0; j < 4; ++j) { v[j] = xr[64 * j]; ss += (v[j].x * v[j].x + v[j].y * v[j].y) + (v[j].z * v[j].z + v[j].w * v[j].w); }
        const float rstd = 1.0f / sqrtf(wave_sum(ss) * (1.f / D) + EPS);
        unsigned long long* o8 = (unsigned long long*)(F.xn1 + (size_t)m * D) + F.lane;
#pragma unroll
        for (int j = 0; j < 4; ++j) { const int col = 256 * j + 4 * F.lane; const f32x4 g = *(const f32x4*)(F.g_mpre + col), sh = *(const f32x4*)(md + col), sc = *(const f32x4*)(md + 1024 + col);
            const f32x4 h = (v[j] * rstd) * g * (sc + 1.0f) + sh;
            o8[64 * j] = (unsigned long long)pk2(h.x, h.y) | ((unsigned long long)pk2(h.z, h.w) << 32); }
    }
}
__device__ __forceinline__ void unpack8(const v4u q, float (&f)[8]) { f[0] = bflo(q.x); f[1] = bfhi(q.x); f[2] = bflo(q.y); f[3] = bfhi(q.y); f[4] = bflo(q.z); f[5] = bfhi(q.z); f[6] = bflo(q.w); f[7] = bfhi(q.w); }
__device__ __forceinline__ void p3_conv(Frame& F) {
    const long total = (long)M * 384;
    for (long idx = (long)blockIdx.x * NTHREADS + F.tid; idx < total; idx += (long)F.G * NTHREADS) {
        const int r = (int)(idx / 384), ch = (int)(idx % 384);
        int b, t, L; bool samp;
        if (r < MP) { b = r >> 11; t = r & 2047; L = SEQ_P; samp = false; } else { const int rr = r - MP; b = rr >> 3; t = rr & 7; L = SEQ_S; samp = true; }
        const bf16* prow = F.proj + (size_t)r * PROJ_LD;
        if (ch < 128) {
            const int c0 = ch * 8;
            float acc[8], e[8];
#pragma unroll
            for (int i = 0; i < 8; ++i) acc[i] = 0.f;
#pragma unroll
            for (int j = 0; j < 3; ++j) {
                const int ee = t + j;
                if (ee < 2) {
                    if (samp) { const float* bp = F.st_sc + ((size_t)b * 2 + ee) * SCW + c0; const f32x4 a = *(const f32x4*)bp, bb = *(const f32x4*)(bp + 4);
                        e[0] = a.x; e[1] = a.y; e[2] = a.z; e[3] = a.w; e[4] = bb.x; e[5] = bb.y; e[6] = bb.z; e[7] = bb.w; }
                    else {
#pragma unroll
                        for (int i = 0; i < 8; ++i) e[i] = 0.f; }
                } else {
                    const bf16* pr = prow + (ptrdiff_t)(j - 2) * PROJ_LD; float cc[8], xx[8];
                    unpack8(*(const v4u*)(pr + C_SCC + c0), cc); unpack8(*(const v4u*)(pr + C_SCX + c0), xx);
#pragma unroll
                    for (int i = 0; i < 8; ++i) e[i] = cc[i] * xx[i];
                }
                const float* wp = F.sc_w + (size_t)j * SCW + c0; const f32x4 w0 = *(const f32x4*)wp, w1 = *(const f32x4*)(wp + 4);
                acc[0] += w0.x * e[0]; acc[1] += w0.y * e[1]; acc[2] += w0.z * e[2]; acc[3] += w0.w * e[3]; acc[4] += w1.x * e[4]; acc[5] += w1.y * e[5]; acc[6] += w1.z * e[6]; acc[7] += w1.w * e[7];
            }
            if (t >= L - 2) { float* op = F.out + (samp ? O_SCS : O_SCP) + ((size_t)b * 2 + (t - (L - 2))) * SCW + c0;
                *(f32x4*)op = (f32x4){e[0], e[1], e[2], e[3]}; *(f32x4*)(op + 4) = (f32x4){e[4], e[5], e[6], e[7]}; }
            float bb[8]; unpack8(*(const v4u*)(prow + C_SCB + c0), bb);
            v4u o; o.x = pk2(bb[0] * acc[0], bb[1] * acc[1]); o.y = pk2(bb[2] * acc[2], bb[3] * acc[3]); o.z = pk2(bb[4] * acc[4], bb[5] * acc[5]); o.w = pk2(bb[6] * acc[6], bb[7] * acc[7]);
            *(v4u*)(F.proj + (size_t)r * PROJ_LD + C_SCB + c0) = o;
        } else {
            const int c0 = (ch - 128) * 8;
            float acc[8], e[8];
            { const f32x4 a = *(const f32x4*)(F.cv_b + c0), bb = *(const f32x4*)(F.cv_b + c0 + 4); acc[0] = a.x; acc[1] = a.y; acc[2] = a.z; acc[3] = a.w; acc[4] = bb.x; acc[5] = bb.y; acc[6] = bb.z; acc[7] = bb.w; }
#pragma unroll
            for (int j = 0; j < 4; ++j) {
                const int ee = t + j;
                if (ee < 3) {
                    if (samp) { const float* bp = F.st_cv + ((size_t)b * 3 + ee) * XBC + c0; const f32x4 a = *(const f32x4*)bp, bb = *(const f32x4*)(bp + 4);
                        e[0] = a.x; e[1] = a.y; e[2] = a.z; e[3] = a.w; e[4] = bb.x; e[5] = bb.y; e[6] = bb.z; e[7] = bb.w; }
                    else {
#pragma unroll
                        for (int i = 0; i < 8; ++i) e[i] = 0.f; }
                } else unpack8(*(const v4u*)(prow + (ptrdiff_t)(j - 3) * PROJ_LD + C_XBC + c0), e);
                const float* wp = F.cv_w + (size_t)j * XBC + c0; const f32x4 w0 = *(const f32x4*)wp, w1 = *(const f32x4*)(wp + 4);
                acc[0] += w0.x * e[0]; acc[1] += w0.y * e[1]; acc[2] += w0.z * e[2]; acc[3] += w0.w * e[3]; acc[4] += w1.x * e[4]; acc[5] += w1.y * e[5]; acc[6] += w1.z * e[6]; acc[7] += w1.w * e[7];
            }
            if (t >= L - 3) { float* op = F.out + (samp ? O_CVS : O_CVP) + ((size_t)b * 3 + (t - (L - 3))) * XBC + c0;
                *(f32x4*)op = (f32x4){e[0], e[1], e[2], e[3]}; *(f32x4*)(op + 4) = (f32x4){e[4], e[5], e[6], e[7]}; }
            v4u o; o.x = pk2(silu_f(acc[0]), silu_f(acc[1])); o.y = pk2(silu_f(acc[2]), silu_f(acc[3])); o.z = pk2(silu_f(acc[4]), silu_f(acc[5])); o.w = pk2(silu_f(acc[6]), silu_f(acc[7]));
            *(v4u*)(F.xbcc + (size_t)r * XBC + c0) = o;
        }
    }
}
__device__ __forceinline__ void scan_item(Frame& F, int s, int h) {
    const int p = F.tid >> 3, nq = F.tid & 7, g = h >> 2;
    const bool samp = s >= BATCH_P; const int b = samp ? s - BATCH_P : s; const int L = samp ? SEQ_S : SEQ_P; const int row0 = samp ? MP + b * SEQ_S : b * SEQ_P;
    float S[16];
    if (samp) { const float* sp = F.st_ssm + (((size_t)b * NH + h) * HP + p) * NS + nq * 16;
#pragma unroll
        for (int i = 0; i < 4; ++i) { const f32x4 a = *(const f32x4*)(sp + 4 * i); S[4 * i] = a.x; S[4 * i + 1] = a.y; S[4 * i + 2] = a.z; S[4 * i + 3] = a.w; } }
    else {
#pragma unroll
        for (int i = 0; i < 16; ++i) S[i] = 0.f; }
    const float A = -__expf(F.a_log[h]), dtb = F.dt_bias[h], Dh = F.d_skip[h];
    for (int t0 = 0; t0 < L; t0 += 8) {
        v4u Bq[8][2], Cq[8][2]; float xv[8], dtv[8];
#pragma unroll
        for (int u = 0; u < 8; ++u) { const int r = row0 + t0 + u; const bf16* xr = F.xbcc + (size_t)r * XBC;
            Bq[u][0] = *(const v4u*)(xr + 1024 + g * NS + nq * 16); Bq[u][1] = *(const v4u*)(xr + 1024 + g * NS + nq * 16 + 8);
            Cq[u][0] = *(const v4u*)(xr + 1536 + g * NS + nq * 16); Cq[u][1] = *(const v4u*)(xr + 1536 + g * NS + nq * 16 + 8);
            xv[u] = bf1(xr[h * HP + p]); dtv[u] = F.dtraw[(size_t)r * 16 + h]; }
#pragma unroll
        for (int u = 0; u < 8; ++u) {
            const float dt = softplus_f(dtv[u] + dtb), dA = __expf(dt * A), xdt = dt * xv[u];
            float Bf[16], Cf[16]; { float t8[8]; unpack8(Bq[u][0], t8);
#pragma unroll
                for (int i = 0; i < 8; ++i) Bf[i] = t8[i];
                unpack8(Bq[u][1], t8);
#pragma unroll
                for (int i = 0; i < 8; ++i) Bf[8 + i] = t8[i];
                unpack8(Cq[u][0], t8);
#pragma unroll
                for (int i = 0; i < 8; ++i) Cf[i] = t8[i];
                unpack8(Cq[u][1], t8);
#pragma unroll
                for (int i = 0; i < 8; ++i) Cf[8 + i] = t8[i]; }
            float y = 0.f;
#pragma unroll
            for (int i = 0; i < 16; ++i) { S[i] = S[i] * dA + xdt * Bf[i]; y += Cf[i] * S[i]; }
            y += __shfl_xor(y, 1); y += __shfl_xor(y, 2); y += __shfl_xor(y, 4);
            y += Dh * xv[u];
            if (nq == 0) F.proj[(size_t)(row0 + t0 + u) * PROJ_LD + C_SCX + h * HP + p] = (bf16)f2bf(y);
        }
    }
    float* op = F.out + (samp ? O_SSMS : O_SSMP) + (((size_t)b * NH + h) * HP + p) * NS + nq * 16;
#pragma unroll
    for (int i = 0; i < 4; ++i) *(f32x4*)(op + 4 * i) = (f32x4){S[4 * i], S[4 * i + 1], S[4 * i + 2], S[4 * i + 3]};
}
typedef float f32x16 __attribute__((ext_vector_type(16)));
typedef short bf16x8 __attribute__((ext_vector_type(8)));
constexpr int SSD_Q = 128, SSD_NC = SEQ_P / SSD_Q;
constexpr int SB_STRIDE = 272, SX_STRIDE = 144;
constexpr int L_BS = 0, L_CS = L_BS + SSD_Q * SB_STRIDE, L_XS = L_CS + SSD_Q * SB_STRIDE, L_SB = L_XS + SSD_Q * SX_STRIDE, L_A2 = L_SB + 2 * 16384, L_LA2 = L_A2 + 512, L_SSD_END = L_LA2 + 512;
static_assert(L_SSD_END <= RING_BYTES, "SSD LDS map");
constexpr float LOG2E = 1.4426950408889634f;
__device__ __forceinline__ void pack_tile(const f32x16& x, bf16x8 (&f)[2]) {
#pragma unroll
    for (int s = 0; s < 2; ++s) { pg8::u32x4 w;
#pragma unroll
        for (int k = 0; k < 4; ++k) w[k] = pk2(x[8 * s + 2 * k], x[8 * s + 2 * k + 1]);
        f[s] = __builtin_bit_cast(bf16x8, w); }
}
__device__ __forceinline__ void ssd_prompt_item(Frame& F, int b, int h) {
    LAS unsigned char* L = F.lds + RING_OFF;
    const int tid = F.tid, lane = F.lane, wid = F.wave, r32 = lane & 31, hh = lane >> 5;
    const int pt = wid >> 2, jj = wid & 3, j = pt ? 3 - jj : jj, q = jj, g = h >> 2;
    const float A2 = -__expf(F.a_log[h]) * LOG2E, dtb = F.dt_bias[h], Dh = F.d_skip[h];
    bf16x8 Id[2];
#pragma unroll
    for (int ks = 0; ks < 2; ++ks)
#pragma unroll
        for (int e = 0; e < 8; ++e) Id[ks][e] = (16 * ks + 8 * hh + e == r32) ? (short)0x3F80 : (short)0;
    for (int i = tid; i < 16384 / 16; i += NTHREADS) *(LAS v4u*)(L + L_SB + i * 16) = (v4u){0u, 0u, 0u, 0u};
    f32x16 S;
#pragma unroll
    for (int i = 0; i < 16; ++i) S[i] = 0.f;
    const bf16* xb = F.xbcc + (size_t)(b * SEQ_P) * XBC;
    const float* dtr = F.dtraw + (size_t)(b * SEQ_P) * 16 + h;
    v4u pB[4], pC[4], pX[2]; float pd0 = 0.f, pd1 = 0.f;
#define SSD_LOAD(c) do { const bf16* xc = xb + (size_t)(c) * SSD_Q * XBC; \
        _Pragma("unroll") for (int k = 0; k < 4; ++k) { const int qq = tid + NTHREADS * k, row = qq >> 4, ch = qq & 15; \
            pB[k] = *(const v4u*)(xc + (size_t)row * XBC + 1024 + g * NS + ch * 8); pC[k] = *(const v4u*)(xc + (size_t)row * XBC + 1536 + g * NS + ch * 8); } \
        _Pragma("unroll") for (int k = 0; k < 2; ++k) { const int qq = tid + NTHREADS * k, row = qq >> 3, ch = qq & 7; pX[k] = *(const v4u*)(xc + (size_t)row * XBC + h * HP + ch * 8); } \
        if (wid == 0) { pd0 = dtr[(size_t)((c) * SSD_Q + 2 * lane) * 16]; pd1 = dtr[(size_t)((c) * SSD_Q + 2 * lane + 1) * 16]; } } while (0)
    SSD_LOAD(0);
    for (int c = 0; c < SSD_NC; ++c) {
#pragma unroll
        for (int k = 0; k < 4; ++k) { const int qq = tid + NTHREADS * k, row = qq >> 4, ch = qq & 15;
            *(LAS v4u*)(L + L_BS + row * SB_STRIDE + ch * 16) = pB[k]; *(LAS v4u*)(L + L_CS + row * SB_STRIDE + ch * 16) = pC[k]; }
#pragma unroll
        for (int k = 0; k < 2; ++k) { const int qq = tid + NTHREADS * k, row = qq >> 3, ch = qq & 7; *(LAS v4u*)(L + L_XS + row * SX_STRIDE + ch * 16) = pX[k]; }
        if (wid == 0) {
            const float d0 = softplus_f(pd0 + dtb), d1 = softplus_f(pd1 + dtb), a0 = d0 * A2, a1 = d1 * A2;
            float pfx = a0 + a1;
#pragma unroll
            for (int o = 1; o < 64; o <<= 1) { const float t = __shfl_up(pfx, o); if (lane >= o) pfx += t; }
            const float c1 = pfx, c0 = pfx - a1;
            *(LAS float*)(L + L_A2 + (2 * lane) * 4) = c0; *(LAS float*)(L + L_A2 + (2 * lane + 1) * 4) = c1;
            *(LAS float*)(L + L_LA2 + (2 * lane) * 4) = c0 - __log2f(d0); *(LAS float*)(L + L_LA2 + (2 * lane + 1) * 4) = c1 - __log2f(d1);
        }
        LDS_WAIT(); __syncthreads();
        if (c + 1 < SSD_NC) SSD_LOAD(c + 1);
        LAS unsigned char* SBc = L + L_SB + (c & 1) * 16384; LAS unsigned char* SBn = L + L_SB + ((c + 1) & 1) * 16384;
        const float a2end = *(LAS float*)(L + L_A2 + 127 * 4);
#define SSD_T1(i, dst) do { f32x16 acc_; _Pragma("unroll") for (int e = 0; e < 16; ++e) acc_[e] = 0.f; \
            _Pragma("unroll") for (int ks = 0; ks < 2; ++ks) { const bf16x8 a_ = *(const LAS bf16x8*)(L + L_XS + (32 * (i) + r32) * SX_STRIDE + (32 * pt + 16 * ks + 8 * hh) * 2); \
                acc_ = __builtin_amdgcn_mfma_f32_32x32x16_bf16(a_, Id[ks], acc_, 0, 0, 0); } \
            pack_tile(acc_, dst); } while (0)
        const int lrow = 32 * j + r32; const float a2l = *(LAS float*)(L + L_A2 + lrow * 4);
        f32x16 Y;
#pragma unroll
        for (int e = 0; e < 16; ++e) Y[e] = 0.f;
#pragma unroll
        for (int qq = 0; qq < 4; ++qq)
#pragma unroll
            for (int s = 0; s < 2; ++s) { const bf16x8 a = *(const LAS bf16x8*)(SBc + ((qq * 2 + pt) * 2 + s) * 1024 + lane * 16);
                const LAS unsigned char* cp = L + L_CS + lrow * SB_STRIDE + (32 * qq + 16 * s + 4 * hh) * 2;
                const v2u c0 = *(const LAS v2u*)cp, c1 = *(const LAS v2u*)(cp + 16);
                const bf16x8 bb = __builtin_bit_cast(bf16x8, ((v4u){c0.x, c0.y, c1.x, c1.y}));
                Y = __builtin_amdgcn_mfma_f32_32x32x16_bf16(a, bb, Y, 0, 0, 0); }
        { const float el = __builtin_amdgcn_exp2f(a2l);
#pragma unroll
            for (int e = 0; e < 16; ++e) Y[e] *= el; }
        for (int i = 0; i <= j; ++i) {
            bf16x8 t1[2]; SSD_T1(i, t1);
            f32x16 X;
#pragma unroll
            for (int e = 0; e < 16; ++e) X[e] = 0.f;
#pragma unroll
            for (int ks = 0; ks < 8; ++ks) { const bf16x8 a = *(const LAS bf16x8*)(L + L_BS + (32 * i + r32) * SB_STRIDE + (16 * ks + 8 * hh) * 2);
                const bf16x8 bb = *(const LAS bf16x8*)(L + L_CS + lrow * SB_STRIDE + (16 * ks + 8 * hh) * 2);
                X = __builtin_amdgcn_mfma_f32_32x32x16_bf16(a, bb, X, 0, 0, 0); }
#pragma unroll
            for (int rg = 0; rg < 4; ++rg) { const int sb = 32 * i + 8 * rg + 4 * hh; const f32x4 la = *(const LAS f32x4*)(L + L_LA2 + sb * 4);
#pragma unroll
                for (int e = 0; e < 4; ++e) { float v = X[4 * rg + e] * __builtin_amdgcn_exp2f(a2l - la[e]);
                    if (i == j) { const int s = sb + e; v = (s <= lrow) ? v : 0.f; v += (s == lrow) ? Dh : 0.f; }
                    X[4 * rg + e] = v; } }
            bf16x8 xf[2]; pack_tile(X, xf);
#pragma unroll
            for (int s = 0; s < 2; ++s) Y = __builtin_amdgcn_mfma_f32_32x32x16_bf16(t1[s], xf[s], Y, 0, 0, 0);
        }
        { bf16* yrow = F.proj + (size_t)(b * SEQ_P + c * SSD_Q + lrow) * PROJ_LD + C_SCX + h * HP + 32 * pt + 4 * hh;
#pragma unroll
            for (int rg = 0; rg < 4; ++rg) { v2u o; o.x = pk2(Y[4 * rg], Y[4 * rg + 1]); o.y = pk2(Y[4 * rg + 2], Y[4 * rg + 3]); *(v2u*)(yrow + 8 * rg) = o; } }
        { const float dec = __builtin_amdgcn_exp2f(a2end);
#pragma unroll
            for (int e = 0; e < 16; ++e) S[e] *= dec; }
        for (int i = 0; i < 4; ++i) {
            bf16x8 t1[2]; SSD_T1(i, t1);
            f32x16 acc;
#pragma unroll
            for (int e = 0; e < 16; ++e) acc[e] = 0.f;
#pragma unroll
            for (int ks = 0; ks < 2; ++ks) { const bf16x8 a = *(const LAS bf16x8*)(L + L_BS + (32 * i + r32) * SB_STRIDE + (32 * q + 16 * ks + 8 * hh) * 2);
                acc = __builtin_amdgcn_mfma_f32_32x32x16_bf16(a, Id[ks], acc, 0, 0, 0); }
#pragma unroll
            for (int rg = 0; rg < 4; ++rg) { const int sb = 32 * i + 8 * rg + 4 * hh; const f32x4 la = *(const LAS f32x4*)(L + L_LA2 + sb * 4);
#pragma unroll
                for (int e = 0; e < 4; ++e) acc[4 * rg + e] *= __builtin_amdgcn_exp2f(a2end - la[e]); }
            bf16x8 t2[2]; pack_tile(acc, t2);
#pragma unroll
            for (int s = 0; s < 2; ++s) S = __builtin_amdgcn_mfma_f32_32x32x16_bf16(t2[s], t1[s], S, 0, 0, 0);
        }
        if (c + 1 < SSD_NC) { bf16x8 sf[2]; pack_tile(S, sf);
#pragma unroll
            for (int s = 0; s < 2; ++s) *(LAS bf16x8*)(SBn + ((q * 2 + pt) * 2 + s) * 1024 + lane * 16) = sf[s]; }
        else { float* op = F.out + O_SSMP + (((size_t)b * NH + h) * HP + 32 * pt + r32) * NS + 32 * q + 4 * hh;
#pragma unroll
            for (int rg = 0; rg < 4; ++rg) *(f32x4*)(op + 8 * rg) = (f32x4){S[4 * rg], S[4 * rg + 1], S[4 * rg + 2], S[4 * rg + 3]}; }
        LDS_WAIT(); __syncthreads();
    }
#undef SSD_LOAD
#undef SSD_T1
}
__device__ __forceinline__ void p4_scan(Frame& F) {
    const int np = (F.G >= 256) ? 128 : F.G;
    if ((int)blockIdx.x < np) for (int it = blockIdx.x; it < BATCH_P * NH; it += np) ssd_prompt_item(F, it / NH, it % NH);
    const int ns = (F.G >= 256) ? F.G - np : F.G, sb = (F.G >= 256) ? (int)blockIdx.x - np : (int)blockIdx.x;
    if (sb >= 0) for (int it = sb; it < BATCH_S * NH; it += ns) scan_item(F, BATCH_P + it / NH, it % NH);
}
__device__ __forceinline__ void p5_gatenorm(Frame& F) {
    const int gw = blockIdx.x * NWAVES + F.wave, NGW = F.G * NWAVES;
    for (int it = gw; it < M * NG; it += NGW) {
        const int r = it >> 2, g = it & 3; bf16* prow = F.proj + (size_t)r * PROJ_LD; const int c = g * 256 + 4 * F.lane;
        const v2u yq = *(const v2u*)(prow + C_SCX + c), zq = *(const v2u*)(prow + C_Z + c);
        float v[4]; v[0] = bflo(yq.x) * silu_f(bflo(zq.x)); v[1] = bfhi(yq.x) * silu_f(bfhi(zq.x)); v[2] = bflo(yq.y) * silu_f(bflo(zq.y)); v[3] = bfhi(yq.y) * silu_f(bfhi(zq.y));
        const float ss = wave_sum((v[0] * v[0] + v[1] * v[1]) + (v[2] * v[2] + v[3] * v[3]));
        const float rstd = 1.0f / sqrtf(ss * (1.f / 256.f) + EPS); const f32x4 gg = *(const f32x4*)(F.ssm_g + c);
        v2u o; o.x = pk2(v[0] * rstd * gg.x, v[1] * rstd * gg.y); o.y = pk2(v[2] * rstd * gg.z, v[3] * rstd * gg.w);
        *(v2u*)(prow + C_SCC + c) = o;
    }
}
template <int NSL> __device__ __forceinline__ void load_row4(const Frame& F, int m, const bf16* pb, int ldb, const float* ps, int lds_, f32x4 (&v)[4]) {
    if (m < MP) { const v2u* r = (const v2u*)(pb + (size_t)m * ldb) + F.lane;
#pragma unroll
        for (int j = 0; j < 4; ++j) { const v2u q = r[64 * j]; v[j] = (f32x4){bflo(q.x), bfhi(q.x), bflo(q.y), bfhi(q.y)}; } }
    else {
#pragma unroll
        for (int j = 0; j < 4; ++j) v[j] = (f32x4){0.f, 0.f, 0.f, 0.f};
#pragma unroll
        for (int s = 0; s < NSL; ++s) { const f32x4* r = (const f32x4*)(ps + (size_t)(s * MS + (m - MP)) * lds_) + F.lane;
#pragma unroll
            for (int j = 0; j < 4; ++j) v[j] += r[64 * j]; } }
}
__device__ __forceinline__ void p7_rows(Frame& F) {
    const int gw = blockIdx.x * NWAVES + F.wave, NGW = F.G * NWAVES;
    for (int m = gw; m < M; m += NGW) {
        const f32x4* xr = (const f32x4*)x_row(F, m) + F.lane; f32x4* mr = (f32x4*)(F.x1 + (size_t)m * D) + F.lane; const float* md = F.mod + (size_t)seq_of(m) * 6144;
        f32x4 v[4], x1[4]; float ss = 0.f;
        load_row4<8>(F, m, (const bf16*)F.x1, 2 * D, F.slab6, PROJ_LD / 2, v);
#pragma unroll
        for (int j = 0; j < 4; ++j) ss += (v[j].x * v[j].x + v[j].y * v[j].y) + (v[j].z * v[j].z + v[j].w * v[j].w);
        const float rstd = 1.0f / sqrtf(wave_sum(ss) * (1.f / D) + EPS); float s2 = 0.f;
#pragma unroll
        for (int j = 0; j < 4; ++j) { const int col = 256 * j + 4 * F.lane; const f32x4 g = *(const f32x4*)(F.g_mpost + col), gt = *(const f32x4*)(md + 2048 + col);
            x1[j] = xr[64 * j] + gt * ((v[j] * rstd) * g); mr[64 * j] = x1[j];
            s2 += (x1[j].x * x1[j].x + x1[j].y * x1[j].y) + (x1[j].z * x1[j].z + x1[j].w * x1[j].w); }
        const float rstd2 = 1.0f / sqrtf(wave_sum(s2) * (1.f / D) + EPS);
        unsigned long long* o8 = (unsigned long long*)(F.xn2 + (size_t)m * D) + F.lane;
#pragma unroll
        for (int j = 0; j < 4; ++j) { const int col = 256 * j + 4 * F.lane; const f32x4 g = *(const f32x4*)(F.g_fpre + col), sh = *(const f32x4*)(md + 3072 + col), sc = *(const f32x4*)(md + 4096 + col);
            const f32x4 h = (x1[j] * rstd2) * g * (sc + 1.0f) + sh;
            o8[64 * j] = (unsigned long long)pk2(h.x, h.y) | ((unsigned long long)pk2(h.z, h.w) << 32); }
    }
}
__device__ __forceinline__ void p10_rows(Frame& F) {
    const int gw = blockIdx.x * NWAVES + F.wave, NGW = F.G * NWAVES;
    for (int m = gw; m < M; m += NGW) {
        f32x4* yr = (f32x4*)(F.out + (size_t)m * D) + F.lane; const float* md = F.mod + (size_t)seq_of(m) * 6144;
        f32x4 v[4]; float ss = 0.f;
        load_row4<11>(F, m, F.fbuf, D, F.slab9, D, v);
#pragma unroll
        for (int j = 0; j < 4; ++j) ss += (v[j].x * v[j].x + v[j].y * v[j].y) + (v[j].z * v[j].z + v[j].w * v[j].w);
        const float rstd = 1.0f / sqrtf(wave_sum(ss) * (1.f / D) + EPS);
#pragma unroll
        for (int j = 0; j < 4; ++j) { const int col = 256 * j + 4 * F.lane; const f32x4 g = *(const f32x4*)(F.g_fpost + col), gt = *(const f32x4*)(md + 5120 + col);
            yr[64 * j] = yr[64 * j] + gt * ((v[j] * rstd) * g); }
    }
}

constexpr int NPHASE = 11;
#ifndef MK_ONE_LAUNCH
#define MK_ONE_LAUNCH 1
#endif
__global__ void __launch_bounds__(NTHREADS, 2) hymba_fwd(Args args) {
    extern __shared__ __attribute__((aligned(16))) unsigned char lds[];
    Frame F;
    F.lds = (LAS unsigned char*)lds;
    F.MISC = (volatile LAS unsigned*)(F.lds + MISC_OFF);
    F.tid = threadIdx.x; F.lane = F.tid & 63; F.wave = __builtin_amdgcn_readfirstlane(F.tid >> 6);
    F.G = gridDim.x;
    unsigned char* ws = args.ws;
    F.ctl = (gu32*)(ws + WS_CTL);
    F.x_p = args.in[0]; F.x_s = args.in[1]; F.c_p = args.in[2]; F.c_s = args.in[3]; F.st_sc = args.in[4]; F.st_cv = args.in[5]; F.st_ssm = args.in[6];
    F.w_ada = args.in[7]; F.b_ada = args.in[8]; F.g_mpre = args.in[9]; F.g_mpost = args.in[10]; F.g_fpre = args.in[11]; F.g_fpost = args.in[12];
    F.w_in = args.in[13]; F.sc_w = args.in[14]; F.cv_w = args.in[15]; F.cv_b = args.in[16]; F.dt_bias = args.in[17]; F.a_log = args.in[18]; F.d_skip = args.in[19];
    F.ssm_g = args.in[20]; F.w_out = args.in[21]; F.w_gate = args.in[22]; F.w_up = args.in[23]; F.w_down = args.in[24];
    F.out = args.out;
    F.mod = (float*)(ws + WS_MOD); F.Win_t = (bf16*)(ws + WS_WIN); F.Wout_t = (bf16*)(ws + WS_WOUT); F.Wgu_t = (bf16*)(ws + WS_WGU); F.Wd_t = (bf16*)(ws + WS_WD);
    F.dtraw = (float*)(ws + WS_DT); F.proj = (bf16*)(ws + WS_PROJ); F.act = (bf16*)(ws + WS_ACT); F.xn2 = (bf16*)(ws + WS_XN2); F.fbuf = (bf16*)(ws + WS_F); F.slab6 = (float*)(F.proj + C_XBC); F.slab9 = (float*)(ws + WS_SLAB9);
    F.xn1 = (bf16*)(args.out + O_Y); F.xbcc = (bf16*)(args.out + O_Y); F.x1 = args.out + O_Y;
    for (int u = F.tid; u < (LDS_BYTES - LDSCTL_OFF) / 4; u += NTHREADS) ((LAS unsigned*)(F.lds + LDSCTL_OFF))[u] = 0u;
    __syncthreads();
    XcdBarrier bar; bar.bar = (unsigned*)(F.ctl + CW_BAR); bar.x = 0; bar.st = nullptr;
    const int lo = args.ph_lo, hi = args.ph_hi;
    if (hi - lo > 1) bar = xcd_barrier_post((unsigned*)(F.ctl + CW_BAR), F.MISC + 8);
#define IN(k) (lo <= (k) && (k) < hi)
#define SEAM(k) do { if (IN(k) && IN((k) + 1)) xcd_barrier(bar); } while (0)

    if (IN(0)) { p0_prologue(F); } SEAM(0);
    if (IN(1)) { p1_hrows(F); } SEAM(1);
    if (IN(2)) {
        pg8::Gemm g{F.xn1, F.Win_t, M, NPROJ_PAD, D, D, D}; pg8::StaticOrder S; S.init(M, NPROJ_PAD, F.G, (int)blockIdx.x);
        pg8::EpiProj E{F.proj, PROJ_LD, F.dtraw, PROJ_LD / 256};
        pg8::gemm_phase<pg8::EpiProj, pg8::StaticOrder, true, true>(F.lds + RING_OFF, g, S, E);
    } SEAM(2);
    if (IN(3)) { p3_conv(F); } SEAM(3);
    if (IN(4)) { p4_scan(F); } SEAM(4);
    if (IN(5)) { p5_gatenorm(F); } SEAM(5);
    if (IN(6)) {
        { pg8::Gemm g{F.proj, F.Wout_t, MP, D, 2048, PROJ_LD, 2048}; pg8::StaticOrder S; S.init(MP, D, F.G, (int)blockIdx.x);
          pg8::EpiBf16Plain E{(bf16*)F.x1, 2 * D};
          pg8::gemm_phase<pg8::EpiBf16Plain, pg8::StaticOrder, true, true>(F.lds + RING_OFF, g, S, E); }
        { int kl = 256; asm volatile("" : "+s"(kl));
          pg8::Gemm g{F.proj, F.Wout_t, M, D, 2048, PROJ_LD, kl}; typedef pg8::SplitKOrder<8, 256, MP / 256, D / 256, 16> SK; SK S{F.G, (int)blockIdx.x};
          pg8::EpiSlabF32 E{F.slab6, PROJ_LD / 2, MP / 256, 256, MS};
          pg8::gemm_phase<pg8::EpiSlabF32, SK, true, true>(F.lds + RING_OFF, g, S, E); }
    } SEAM(6);
    if (IN(7)) { p7_rows(F); } SEAM(7);
    if (IN(8)) {
        pg8::Gemm g{F.xn2, F.Wgu_t, M, NGU, D, D, D}; pg8::StaticOrder S; S.init(M, NGU, F.G, (int)blockIdx.x);
        pg8::EpiSwiGLU E{F.act, FF};
        pg8::gemm_phase<pg8::EpiSwiGLU, pg8::StaticOrder, true, true>(F.lds + RING_OFF, g, S, E);
    } SEAM(8);
    if (IN(9)) {
        { pg8::Gemm g{F.act, F.Wd_t, MP, D, FF, FF, FF}; pg8::StaticOrder S; S.init(MP, D, F.G, (int)blockIdx.x);
          pg8::EpiBf16Plain E{F.fbuf, D};
          pg8::gemm_phase<pg8::EpiBf16Plain, pg8::StaticOrder, true, true>(F.lds + RING_OFF, g, S, E); }
        { int kl = 256; asm volatile("" : "+s"(kl));
          pg8::Gemm g{F.act, F.Wd_t, M, D, FF, FF, kl}; typedef pg8::SplitKOrder<11, 256, MP / 256, D / 256, 16> SK; SK S{F.G, (int)blockIdx.x};
          pg8::EpiSlabF32 E{F.slab9, D, MP / 256, 256, MS};
          pg8::gemm_phase<pg8::EpiSlabF32, SK, true, true>(F.lds + RING_OFF, g, S, E); }
    } SEAM(9);
    if (IN(10)) { p10_rows(F); }
#undef IN
#undef SEAM
}

extern "C" void kernel_launch(void* const* d_in, const int* in_sizes, int n_in, void* d_out, int out_size, void* d_ws, size_t ws_size, hipStream_t stream) {
    static int grid = 0;
    if (grid == 0) {
        if (n_in != 25 || out_size != (int)O_END || ws_size < WS_END) { fprintf(stderr, "kernel_launch: unexpected sizes n_in %d out %d ws %zu; nothing launched\n", n_in, out_size, ws_size); grid = -1; return; }
        int dev = 0, cus = 0, per_cu = 0;
        if (hipGetDevice(&dev) != hipSuccess || hipDeviceGetAttribute(&cus, hipDeviceAttributeMultiprocessorCount, dev) != hipSuccess) { grid = -1; return; }
        if (hipFuncSetAttribute((const void*)hymba_fwd, hipFuncAttributeMaxDynamicSharedMemorySize, LDS_BYTES) != hipSuccess) { fprintf(stderr, "kernel_launch: hipFuncSetAttribute failed\n"); grid = -1; return; }
        if (hipOccupancyMaxActiveBlocksPerMultiprocessor(&per_cu, (const void*)hymba_fwd, NTHREADS, LDS_BYTES) != hipSuccess || per_cu < 1) { fprintf(stderr, "kernel_launch: occupancy query says %d\n", per_cu); per_cu = 1; }
        (void)hipGetLastError();
        grid = cus;
    }
    if (grid < 0) return;
    (void)hipMemsetAsync((char*)d_ws + WS_CTL, 0, CTL_ZERO_BYTES, stream);
    Args a{};
    for (int i = 0; i < 25; ++i) a.in[i] = (const float*)d_in[i];
    a.out = (float*)d_out; a.ws = (unsigned char*)d_ws;
#if MK_ONE_LAUNCH
    a.ph_lo = 0; a.ph_hi = NPHASE;
    hipLaunchKernelGGL(hymba_fwd, dim3(grid), dim3(NTHREADS), LDS_BYTES, stream, a);
#else
    for (int ph = 0; ph < NPHASE; ++ph) { a.ph_lo = ph; a.ph_hi = ph + 1; hipLaunchKernelGGL(hymba_fwd, dim3(grid), dim3(NTHREADS), LDS_BYTES, stream, a); }
#endif
}
```

```cpp
#include <hip/hip_runtime.h>
#include <cstdio>
#include <cstdint>
namespace pg8 {
#define PG8_LAS __attribute__((address_space(3)))
typedef unsigned short bf16_t;
typedef short bf16x8 __attribute__((ext_vector_type(8)));
typedef float f32x4 __attribute__((ext_vector_type(4)));
typedef unsigned u32x4 __attribute__((ext_vector_type(4)));
constexpr int BM = 256, BK = 64, HALF = 128, HTB = HALF * BK * 2  , STAGE_BYTES = 8 * HTB, NXCD = 8, WGM = 8;

__host__ __device__ __forceinline__ int lds_byte(int r, int c) { const int st = (r >> 4) * 2 + (c >> 5), rr = r & 15, cc = c & 31, ob = rr * 64 + cc * 2; return st * 1024 + (ob ^ (((ob >> 9) & 1) << 5)); }
__host__ __device__ __forceinline__ void stage_rc(int b, int& R, int& C) { const int st = b / 1024, sb = b % 1024, swz = sb ^ (((sb >> 9) & 1) << 5); R = (st >> 1) * 16 + swz / 64; C = (st & 1) * 32 + (swz % 64) / 2; }
__host__ __device__ __forceinline__ int perm32(int rho) { const int n = rho >> 4, i = rho & 15; return 8 * (i >> 2) + 4 * n + (i & 3); }

struct Unit { int pm, pn, kb; };
struct Gemm { const bf16_t* A; const bf16_t* Bt; int M, N, K, lda, Kloop; };

struct StaticOrder {
    int nM, nN, nwg, G, c;
    __host__ __device__ void init(int M, int N, int G_, int c_) { nM = M / BM; nN = N / BM; nwg = nM * nN; G = G_; c = c_; }
    __host__ __device__ bool next(int i, Unit& u) const {
        const long L = (long)i * G + c; if (L >= nwg) return false;
        int wgid = (int)L; { const int q = nwg / NXCD, r = nwg % NXCD, xcd = wgid % NXCD, off = wgid / NXCD; wgid = (xcd < r ? xcd * (q + 1) : r * (q + 1) + (xcd - r) * q) + off; }
        const int nig = WGM * nN, gid = wgid / nig, fm = gid * WGM, gsz = (nM - fm) < WGM ? (nM - fm) : WGM;
        u.pm = fm + ((wgid % nig) % gsz); u.pn = (wgid % nig) / gsz; u.kb = 0; return true;
    }
    __device__ __forceinline__ void a_ready(const Unit&) const {}
    __device__ __forceinline__ void done(const Unit&) const {}
};

template <int NKS, int KSLICE, int PM0, int NN, int NUNITS> struct SplitKOrder {
    int G, c;
    __host__ __device__ bool next(int i, Unit& u) const {
        const int L = i * G + c; if (L >= NUNITS * NKS) return false;
        const int unit = L / NKS, ks = L % NKS; u.pm = PM0 + unit / NN; u.pn = unit % NN; u.kb = ks * KSLICE; return true;
    }
    __device__ __forceinline__ void a_ready(const Unit&) const {}
    __device__ __forceinline__ void done(const Unit&) const {}
};

__device__ __forceinline__ unsigned cvt_pk_bf16(float lo, float hi) { unsigned r; asm volatile("v_cvt_pk_bf16_f32 %0, %1, %2" : "=v"(r) : "v"(lo), "v"(hi)); return r; }

struct EpiF32 {
    static constexpr bool PERM = false, AFTER_DRAIN = false;
    float* C; int ldc;
    __device__ __forceinline__ void operator()(const f32x4 (&acc)[2][2][4][2], const Unit& u, int wr, int wc, int fr, int fq) const {
        const int row0 = u.pm * BM + wr * 64 + fr, col0 = u.pn * BM + wc * 32 + 4 * fq;
#pragma unroll
        for (int ai = 0; ai < 2; ++ai)
#pragma unroll
            for (int m = 0; m < 4; ++m) { float* rowp = C + (size_t)(row0 + ai * HALF + m * 16) * ldc + col0;
#pragma unroll
                for (int bj = 0; bj < 2; ++bj)
#pragma unroll
                    for (int n = 0; n < 2; ++n) *(f32x4*)(rowp + bj * HALF + n * 16) = acc[ai][bj][m][n]; }
    }
};
struct EpiBf16Plain {
    static constexpr bool PERM = true, AFTER_DRAIN = false;
    bf16_t* O; int ldc;
    __device__ __forceinline__ void operator()(const f32x4 (&acc)[2][2][4][2], const Unit& u, int wr, int wc, int fr, int fq) const {
        const int row0 = u.pm * BM + wr * 64 + fr, col0 = u.pn * BM + wc * 32 + 8 * fq;
#pragma unroll
        for (int ai = 0; ai < 2; ++ai)
#pragma unroll
            for (int m = 0; m < 4; ++m) { bf16_t* rowp = O + (size_t)(row0 + ai * HALF + m * 16) * ldc + col0;
#pragma unroll
                for (int bj = 0; bj < 2; ++bj) { const f32x4 v0 = acc[ai][bj][m][0], v1 = acc[ai][bj][m][1];
                    u32x4 w; w.x = cvt_pk_bf16(v0[0], v0[1]); w.y = cvt_pk_bf16(v0[2], v0[3]); w.z = cvt_pk_bf16(v1[0], v1[1]); w.w = cvt_pk_bf16(v1[2], v1[3]);
                    *(u32x4*)(rowp + bj * HALF) = w; } }
    }
};
struct EpiSlabF32 {
    static constexpr bool PERM = false, AFTER_DRAIN = false;
    float* C; int ldc, pm0, kslice, rows_per_slab;
    __device__ __forceinline__ void operator()(const f32x4 (&acc)[2][2][4][2], const Unit& u, int wr, int wc, int fr, int fq) const {
        const int row0 = (u.kb / kslice) * rows_per_slab + (u.pm - pm0) * BM + wr * 64 + fr, col0 = u.pn * BM + wc * 32 + 4 * fq;
#pragma unroll
        for (int ai = 0; ai < 2; ++ai)
#pragma unroll
            for (int m = 0; m < 4; ++m) { float* rowp = C + (size_t)(row0 + ai * HALF + m * 16) * ldc + col0;
#pragma unroll
                for (int bj = 0; bj < 2; ++bj)
#pragma unroll
                    for (int n = 0; n < 2; ++n) *(f32x4*)(rowp + bj * HALF + n * 16) = acc[ai][bj][m][n]; }
    }
};
struct EpiProj {
    static constexpr bool PERM = true, AFTER_DRAIN = false;
    bf16_t* O; int ldc; float* dt; int dt_tile; const float* dt_bias; const float* a_log;
    __device__ __forceinline__ void operator()(const f32x4 (&acc)[2][2][4][2], const Unit& u, int wr, int wc, int fr, int fq) const {
        const int row0 = u.pm * BM + wr * 64 + fr;
        if (u.pn == dt_tile) {
            if (wc == 0 && fq < 2) {
                float bias[8], a2f[8];
#pragma unroll
                for (int e = 0; e < 8; ++e) { bias[e] = dt_bias[8 * fq + e]; a2f[e] = -__expf(a_log[8 * fq + e]) * 1.4426950408889634f; }
#pragma unroll
                for (int ai = 0; ai < 2; ++ai)
#pragma unroll
                    for (int m = 0; m < 4; ++m) { float* rowp = dt + (size_t)(row0 + ai * HALF + m * 16) * 32 + 8 * fq; float d[8];
#pragma unroll
                        for (int e = 0; e < 8; ++e) { const float v = acc[ai][0][m][e >> 2][e & 3] + bias[e]; d[e] = v > 20.f ? v : log1pf(__expf(v)); }
                        *(f32x4*)(rowp) = (f32x4){d[0], d[1], d[2], d[3]}; *(f32x4*)(rowp + 4) = (f32x4){d[4], d[5], d[6], d[7]};
                        *(f32x4*)(rowp + 16) = (f32x4){d[0] * a2f[0], d[1] * a2f[1], d[2] * a2f[2], d[3] * a2f[3]}; *(f32x4*)(rowp + 20) = (f32x4){d[4] * a2f[4], d[5] * a2f[5], d[6] * a2f[6], d[7] * a2f[7]}; }
            }
            return;
        }
        const int col0 = u.pn * BM + wc * 32 + 8 * fq;
#pragma unroll
        for (int ai = 0; ai < 2; ++ai)
#pragma unroll
            for (int m = 0; m < 4; ++m) { bf16_t* rowp = O + (size_t)(row0 + ai * HALF + m * 16) * ldc + col0;
#pragma unroll
                for (int bj = 0; bj < 2; ++bj) { const f32x4 v0 = acc[ai][bj][m][0], v1 = acc[ai][bj][m][1];
                    u32x4 w; w.x = cvt_pk_bf16(v0[0], v0[1]); w.y = cvt_pk_bf16(v0[2], v0[3]); w.z = cvt_pk_bf16(v1[0], v1[1]); w.w = cvt_pk_bf16(v1[2], v1[3]);
                    *(u32x4*)(rowp + bj * HALF) = w; } }
    }
};
struct EpiSwiGLU {
    static constexpr bool PERM = true, AFTER_DRAIN = false;
    bf16_t* O; int ldc;
    __device__ __forceinline__ void operator()(const f32x4 (&acc)[2][2][4][2], const Unit& u, int wr, int wc, int fr, int fq) const {
        const int row0 = u.pm * BM + wr * 64 + fr, col0 = u.pn * HALF + wc * 32 + 8 * fq;
#pragma unroll
        for (int ai = 0; ai < 2; ++ai)
#pragma unroll
            for (int m = 0; m < 4; ++m) { bf16_t* rowp = O + (size_t)(row0 + ai * HALF + m * 16) * ldc + col0;
                float r[8];
#pragma unroll
                for (int n = 0; n < 2; ++n)
#pragma unroll
                    for (int i = 0; i < 4; ++i) { const float g = acc[ai][0][m][n][i], up = acc[ai][1][m][n][i];
                        r[n * 4 + i] = g * up * __builtin_amdgcn_rcpf(1.0f + __builtin_amdgcn_exp2f(-1.4426950408889634f * g)); }
                u32x4 w; w.x = cvt_pk_bf16(r[0], r[1]); w.y = cvt_pk_bf16(r[2], r[3]); w.z = cvt_pk_bf16(r[4], r[5]); w.w = cvt_pk_bf16(r[6], r[7]);
                *(u32x4*)(rowp) = w; }
    }
};

template <class Epi, class Sched, bool ALIGN_EPI = false, bool SP2 = false>
__device__ __forceinline__ void gemm_phase(PG8_LAS unsigned char* lds, const Gemm g, const Sched& S, const Epi& E) {
    const int tid = threadIdx.x, wid = __builtin_amdgcn_readfirstlane(tid >> 6), lane = tid & 63, wr = wid >> 2, wc = wid & 3, fr = lane & 15, fq = lane >> 4;
    const int K = g.K, nt = g.Kloop / BK;
    unsigned voffA[2], voffB[2];
#pragma unroll
    for (int i = 0; i < 2; ++i) { int R, C; stage_rc(tid * 16 + i * 8192, R, C); const int Rb = Epi::PERM ? ((R & ~31) + perm32(R & 31)) : R;
        voffA[i] = (unsigned)(R * g.lda + C) * 2u; voffB[i] = (unsigned)(Rb * K + C) * 2u; }
    const size_t kstep = (size_t)(BK * 2);
    const size_t hstep = (size_t)HALF * K * 2, hstepA = (size_t)HALF * g.lda * 2;
    const size_t tstep = 2 * hstep, tstepA = 2 * hstepA;
    const unsigned ldsw = (unsigned)wid * 1024u;
    const int aoff = lds_byte(wr * 64 + fr, fq * 8), boff = lds_byte(wc * 32 + fr, fq * 8);
#define PG8_SA(b, h) (((b) * 2 + (h)) * HTB)
#define PG8_SB(b, h) ((4 + (b) * 2 + (h)) * HTB)
#define PG8_STAGE(bufoff, gbase, voff) do { _Pragma("unroll") for (int _i = 0; _i < 2; ++_i) \
        __builtin_amdgcn_global_load_lds((const unsigned*)((const char*)(gbase) + (voff)[_i]), (PG8_LAS unsigned*)(lds + (bufoff) + ldsw + _i * 8192), 16, 0, 0); } while (0)
#define PG8_LDA(dst, b, h) do { _Pragma("unroll") for (int m = 0; m < 4; ++m) _Pragma("unroll") for (int k = 0; k < 2; ++k) dst[m][k] = *(const PG8_LAS bf16x8*)(lds + PG8_SA(b, h) + aoff + m * 2048 + k * 1024); } while (0)
#define PG8_LDB(dst, b, h) do { _Pragma("unroll") for (int n = 0; n < 2; ++n) _Pragma("unroll") for (int k = 0; k < 2; ++k) dst[n][k] = *(const PG8_LAS bf16x8*)(lds + PG8_SB(b, h) + boff + n * 2048 + k * 1024); } while (0)
#define PG8_MMA(ai, bj, At, Bt) do { __builtin_amdgcn_s_setprio(1); _Pragma("unroll") for (int m = 0; m < 4; ++m) _Pragma("unroll") for (int n = 0; n < 2; ++n) _Pragma("unroll") for (int k = 0; k < 2; ++k) \
        acc[ai][bj][m][n] = __builtin_amdgcn_mfma_f32_16x16x32_bf16(Bt[n][k], At[m][k], acc[ai][bj][m][n], 0, 0, 0); __builtin_amdgcn_s_setprio(0); } while (0)
#define PG8_WAIT_V(n) asm volatile("s_waitcnt vmcnt(" #n ")" ::: "memory")
#define PG8_WAIT_L(n) asm volatile("s_waitcnt lgkmcnt(" #n ")" ::: "memory")
#define PG8_BAR __builtin_amdgcn_s_barrier()
#define PG8_SCHED __builtin_amdgcn_sched_barrier(0)
    Unit cur, nxt; int ui = 0;
    if (!S.next(0, cur)) return;
    f32x4 acc[2][2][4][2];
#pragma unroll
    for (int a = 0; a < 2; ++a)
#pragma unroll
        for (int b = 0; b < 2; ++b)
#pragma unroll
            for (int m = 0; m < 4; ++m)
#pragma unroll
                for (int n = 0; n < 2; ++n) acc[a][b][m][n] = (f32x4){0.f, 0.f, 0.f, 0.f};
    bf16x8 At[4][2], B0[2][2], B1[2][2];
    const char* cA = (const char*)g.A + (size_t)cur.pm * tstepA + (size_t)cur.kb * 2; const char* cB = (const char*)g.Bt + (size_t)cur.pn * tstep + (size_t)cur.kb * 2;
    S.a_ready(cur);
    if constexpr (SP2) {
        PG8_STAGE(PG8_SB(0, 0), cB, voffB); PG8_STAGE(PG8_SB(0, 1), cB + hstep, voffB); PG8_STAGE(PG8_SA(0, 0), cA, voffA); PG8_STAGE(PG8_SA(0, 1), cA + hstepA, voffA);
        if (wr == 1) PG8_BAR;
        PG8_WAIT_V(2); PG8_BAR;
        PG8_STAGE(PG8_SB(1, 0), cB + kstep, voffB); PG8_STAGE(PG8_SA(1, 0), cA + kstep, voffA); PG8_STAGE(PG8_SB(1, 1), cB + hstep + kstep, voffB);
        PG8_WAIT_V(6); PG8_BAR;
    } else {
        PG8_STAGE(PG8_SB(0, 0), cB, voffB); PG8_STAGE(PG8_SA(0, 0), cA, voffA); PG8_STAGE(PG8_SB(0, 1), cB + hstep, voffB); PG8_STAGE(PG8_SA(0, 1), cA + hstepA, voffA);
        if (wr == 1) PG8_BAR;
        PG8_WAIT_V(4); PG8_BAR;
        PG8_STAGE(PG8_SB(1, 0), cB + kstep, voffB); PG8_STAGE(PG8_SA(1, 0), cA + kstep, voffA); PG8_STAGE(PG8_SB(1, 1), cB + hstep + kstep, voffB);
        PG8_WAIT_V(6); PG8_BAR;
    }
    for (;;) {
        const bool has_next = S.next(ui + 1, nxt);
        const char* nA = has_next ? (const char*)g.A + (size_t)nxt.pm * tstepA + (size_t)nxt.kb * 2 : cA; const char* nB = has_next ? (const char*)g.Bt + (size_t)nxt.pn * tstep + (size_t)nxt.kb * 2 : cB;
        for (int t = 0; t < nt; t += 2) {
            const bool last = (t == nt - 2);
            const char* a1 = cA + (size_t)(t + 1) * kstep;
            const char* a2 = last ? nA : cA + (size_t)(t + 2) * kstep; const char* b2 = last ? nB : cB + (size_t)(t + 2) * kstep;
            const char* a3 = a2 + kstep; const char* b3 = b2 + kstep;
            if (last && has_next) S.a_ready(nxt);
            if constexpr (SP2) {
            PG8_LDB(B0, 0, 0); PG8_LDB(B1, 0, 1); PG8_SCHED; PG8_LDA(At, 0, 0); PG8_STAGE(PG8_SA(1, 1), a1 + hstepA, voffA);
            PG8_WAIT_V(8); PG8_WAIT_L(0); PG8_BAR; PG8_MMA(0, 0, At, B0); PG8_MMA(0, 1, At, B1); PG8_BAR; PG8_SCHED;
            PG8_LDA(At, 0, 1); PG8_STAGE(PG8_SB(0, 0), b2, voffB); PG8_STAGE(PG8_SB(0, 1), b2 + hstep, voffB); PG8_STAGE(PG8_SA(0, 0), a2, voffA);
            PG8_WAIT_V(8); PG8_WAIT_L(0); PG8_BAR; PG8_MMA(1, 0, At, B0); PG8_MMA(1, 1, At, B1); PG8_BAR; PG8_SCHED;
            PG8_LDB(B0, 1, 0); PG8_LDB(B1, 1, 1); PG8_SCHED; PG8_LDA(At, 1, 0); PG8_STAGE(PG8_SA(0, 1), a2 + hstepA, voffA);
            PG8_WAIT_V(8); PG8_WAIT_L(0); PG8_BAR; PG8_MMA(0, 0, At, B0); PG8_MMA(0, 1, At, B1); PG8_BAR; PG8_SCHED;
            PG8_LDA(At, 1, 1); PG8_STAGE(PG8_SB(1, 0), b3, voffB); PG8_STAGE(PG8_SB(1, 1), b3 + hstep, voffB); PG8_STAGE(PG8_SA(1, 0), a3, voffA);
            PG8_WAIT_V(8); PG8_WAIT_L(0); PG8_BAR; PG8_MMA(1, 0, At, B0); PG8_MMA(1, 1, At, B1); PG8_BAR; PG8_SCHED;
            } else {
            PG8_LDB(B0, 0, 0); PG8_SCHED; PG8_LDA(At, 0, 0); PG8_STAGE(PG8_SA(1, 1), a1 + hstepA, voffA);
            PG8_WAIT_L(8); PG8_BAR; PG8_WAIT_L(0); PG8_MMA(0, 0, At, B0); PG8_BAR; PG8_SCHED;
            PG8_LDB(B1, 0, 1); PG8_STAGE(PG8_SB(0, 0), b2, voffB);
            PG8_BAR; PG8_WAIT_L(0); PG8_MMA(0, 1, At, B1); PG8_BAR;
            PG8_LDA(At, 0, 1); PG8_STAGE(PG8_SA(0, 0), a2, voffA);
            PG8_BAR; PG8_WAIT_L(0); PG8_MMA(1, 0, At, B0); PG8_BAR; PG8_SCHED;
            PG8_STAGE(PG8_SB(0, 1), b2 + hstep, voffB);
            PG8_WAIT_V(6); PG8_BAR; PG8_MMA(1, 1, At, B1); PG8_BAR;
            PG8_LDB(B0, 1, 0); PG8_SCHED; PG8_LDA(At, 1, 0); PG8_STAGE(PG8_SA(0, 1), a2 + hstepA, voffA);
            PG8_WAIT_L(8); PG8_BAR; PG8_WAIT_L(0); PG8_MMA(0, 0, At, B0); PG8_BAR; PG8_SCHED;
            PG8_LDB(B1, 1, 1); PG8_STAGE(PG8_SB(1, 0), b3, voffB);
            PG8_BAR; PG8_WAIT_L(0); PG8_MMA(0, 1, At, B1); PG8_BAR;
            PG8_LDA(At, 1, 1); PG8_STAGE(PG8_SA(1, 0), a3, voffA);
            PG8_BAR; PG8_WAIT_L(0); PG8_MMA(1, 0, At, B0); PG8_BAR; PG8_SCHED;
            PG8_STAGE(PG8_SB(1, 1), b3 + hstep, voffB);
            PG8_WAIT_V(6); PG8_BAR; PG8_MMA(1, 1, At, B1); PG8_BAR;
            }
        }
        if constexpr (ALIGN_EPI) { if (wr == 0) PG8_BAR; }
        if constexpr (!Epi::AFTER_DRAIN) { E(acc, cur, wr, wc, fr, fq); S.done(cur); }
        if (!has_next) break;
#pragma unroll
        for (int a = 0; a < 2; ++a)
#pragma unroll
            for (int b = 0; b < 2; ++b)
#pragma unroll
                for (int m = 0; m < 4; ++m)
#pragma unroll
                    for (int n = 0; n < 2; ++n) acc[a][b][m][n] = (f32x4){0.f, 0.f, 0.f, 0.f};
        cur = nxt; cA = nA; cB = nB; ++ui;
        if constexpr (ALIGN_EPI) { if (wr == 1) PG8_BAR; }
    }
    PG8_WAIT_V(0);
    if constexpr (!ALIGN_EPI) { if (wr == 0) PG8_BAR; }
    PG8_BAR;
    if constexpr (Epi::AFTER_DRAIN) { E.fused(acc, cur, wr, wc, fr, fq, lds, wid, lane); S.done(cur); }
#undef PG8_SA
#undef PG8_SB
#undef PG8_STAGE
#undef PG8_LDA
#undef PG8_LDB
#undef PG8_MMA
#undef PG8_WAIT_V
#undef PG8_WAIT_L
#undef PG8_BAR
#undef PG8_SCHED
}}

constexpr int NWAVES = 8, NTHREADS = NWAVES * 64;
constexpr int D = 1024, BATCH_P = 8, SEQ_P = 2048, BATCH_S = 128, SEQ_S = 8;
constexpr int MP = BATCH_P * SEQ_P, MS = BATCH_S * SEQ_S, M = MP + MS;
constexpr int NSEQ = BATCH_P + BATCH_S;
constexpr int SCW = 1024, SSMW = 1024, NH = 16, HP = 64, NG = 4, NS = 128, XBC = 2048;
constexpr int NPROJ = 6160, NPROJ_PAD = 6400, PROJ_LD = 6144;
constexpr int C_SCB = 0, C_SCC = 1024, C_SCX = 2048, C_Z = 3072, C_XBC = 4096;
constexpr int FF = 2816, NGU = 2 * FF;
constexpr float EPS = 1e-6f;
constexpr size_t O_Y = 0, O_SCP = (size_t)M * D, O_CVP = O_SCP + (size_t)BATCH_P * 2 * SCW, O_SSMP = O_CVP + (size_t)BATCH_P * 3 * XBC,
                 O_SCS = O_SSMP + (size_t)BATCH_P * NH * HP * NS, O_CVS = O_SCS + (size_t)BATCH_S * 2 * SCW, O_SSMS = O_CVS + (size_t)BATCH_S * 3 * XBC,
                 O_END = O_SSMS + (size_t)BATCH_S * NH * HP * NS;
static_assert(O_END == 36765696ull, "output size");
constexpr size_t MiB = 1u << 20;
constexpr size_t WS_CTL = 0, CTL_ZERO_BYTES = 1 * MiB;
constexpr size_t WS_MOD = 1 * MiB;
constexpr size_t WS_WIN = 5 * MiB;
constexpr size_t WS_WOUT = 18 * MiB;
constexpr size_t WS_WGU = 22 * MiB;
constexpr size_t WS_WD = 33 * MiB;
constexpr size_t WS_DT = 38 * MiB + 512 * 1024;
constexpr size_t WS_PROJ = 41 * MiB;
constexpr size_t WS_ACT = 41 * MiB;
constexpr size_t WS_XN2 = 138 * MiB;
constexpr size_t WS_F = 172 * MiB;
constexpr size_t WS_SLAB9 = 204 * MiB;
constexpr size_t WS_END = 256 * MiB;
static_assert(WS_XN2 >= WS_PROJ + (size_t)8192 * PROJ_LD * 2 && WS_PROJ + (size_t)M * PROJ_LD * 2 <= WS_END && WS_ACT + (size_t)M * FF * 2 <= WS_XN2 && WS_XN2 + (size_t)M * D * 2 <= WS_F && WS_F + (size_t)MP * D * 2 <= WS_SLAB9 && WS_SLAB9 + (size_t)11 * MS * D * 4 <= WS_END, "d_ws map");
static_assert(WS_WIN + (size_t)NPROJ_PAD * D * 2 <= WS_WOUT && WS_WD + (size_t)D * FF * 2 <= WS_DT && WS_DT + (size_t)M * 32 * 4 <= WS_PROJ, "d_ws map 2");
constexpr int CW_BAR = 4096;
constexpr int CW_SCAN = 64;
constexpr int RING_OFF = 0, RING_BYTES = 131072;
constexpr int LDSCTL_OFF = RING_BYTES, MISC_OFF = LDSCTL_OFF + 320;
constexpr int LDS_BYTES = 147456;
static_assert(MISC_OFF + 128 <= LDS_BYTES, "LDS map");

#define GAS __attribute__((address_space(1)))
#define LAS __attribute__((address_space(3)))
typedef unsigned short bf16;
typedef unsigned v4u __attribute__((ext_vector_type(4)));
typedef unsigned v2u __attribute__((ext_vector_type(2)));
typedef float f32x4 __attribute__((ext_vector_type(4)));
typedef GAS unsigned gu32;
#define RLX_AGENT __ATOMIC_RELAXED, __HIP_MEMORY_SCOPE_AGENT
#define LDS_WAIT() asm volatile("s_waitcnt lgkmcnt(0)" ::: "memory")
#define VM_WAIT() asm volatile("s_waitcnt vmcnt(0)" ::: "memory")
__device__ __forceinline__ unsigned f2bf(float f) { unsigned u = __builtin_bit_cast(unsigned, f); return (u + 0x7fffu + ((u >> 16) & 1u)) >> 16; }
typedef float f32x2_t __attribute__((ext_vector_type(2))); typedef __bf16 bf16x2_t __attribute__((ext_vector_type(2)));
__device__ __forceinline__ unsigned pk2(float lo, float hi) { f32x2_t v = {lo, hi}; bf16x2_t b = __builtin_convertvector(v, bf16x2_t); return __builtin_bit_cast(unsigned, b); }
__device__ __forceinline__ float bflo(unsigned u) { return __builtin_bit_cast(float, u << 16); }
__device__ __forceinline__ float bfhi(unsigned u) { return __builtin_bit_cast(float, u & 0xffff0000u); }
__device__ __forceinline__ float bf1(bf16 h) { return __builtin_bit_cast(float, (unsigned)h << 16); }
__device__ __forceinline__ float silu_f(float v) { return v * __builtin_amdgcn_rcpf(1.0f + __builtin_amdgcn_exp2f(-1.4426950408889634f * v)); }
__device__ __forceinline__ float softplus_f(float v) { return v > 20.f ? v : log1pf(__expf(v)); }

#define XB_TMO      128
#define XB_XCNT(j)  (256  + 64 * (j))
#define XB_XSUB(j)  (1280 + 64 * (j))
#define XB_XGEN(j)  (2304 + 64 * (j))
#define XB_TOP      3328
#define XB_TOPGEN   3392
#define XCD_BAR_WORDS 3456
#define XB_SPIN_CAP (1u << 18)
__device__ __forceinline__ unsigned xb_ld(unsigned* p)              { return __hip_atomic_load(p, __ATOMIC_RELAXED, __HIP_MEMORY_SCOPE_AGENT); }
__device__ __forceinline__ unsigned xb_add(unsigned* p, unsigned v) { return __hip_atomic_fetch_add(p, v, __ATOMIC_RELAXED, __HIP_MEMORY_SCOPE_AGENT); }
__device__ __forceinline__ unsigned xb_xcc_id() { return (unsigned)__builtin_amdgcn_s_getreg((3 << 11) | 20) & 0xFu; }
#define XB_SPIN(cond, bar) do { unsigned _sp = 0; while (cond) { __builtin_amdgcn_s_sleep(1); \
    if ((++_sp & 255u) == 0u) { if (xb_ld(&(bar)[XB_TMO])) break; if (_sp > XB_SPIN_CAP) { atomicAdd(&(bar)[XB_TMO], 1u); break; } } } } while (0)
struct XcdBarrier { unsigned* bar; unsigned x; volatile LAS unsigned* st; };
__device__ __forceinline__ XcdBarrier xcd_barrier_post(unsigned* bar, volatile LAS unsigned* st) {
    XcdBarrier b; b.bar = bar; b.x = xb_xcc_id(); b.st = st;
    if (threadIdx.x == 0) (void)xb_add(&bar[XB_XCNT(b.x)], 1u);
    return b;
}
__device__ __forceinline__ void xcd_barrier_complete(unsigned* bar, unsigned x, unsigned& nloc, unsigned& nx) {
    const unsigned G = gridDim.x * gridDim.y * gridDim.z;
    unsigned sum, cnt, mine, sp = 0u;
    for (;;) {
        sum = 0u; cnt = 0u; mine = 0u;
#pragma unroll
        for (unsigned j = 0; j < 16; ++j) { const unsigned c = xb_ld(&bar[XB_XCNT(j)]); sum += c; cnt += (c > 0u) ? 1u : 0u; mine = (j == x) ? c : mine; }
        if (sum == G) break;
        __builtin_amdgcn_s_sleep(1);
        if ((++sp & 255u) == 0u) { if (xb_ld(&bar[XB_TMO])) break; if (sp > XB_SPIN_CAP) { atomicAdd(&bar[XB_TMO], 1u); break; } }
    }
    nloc = mine > 0u ? mine : 1u; nx = cnt > 0u ? cnt : 1u;
}
__device__ __forceinline__ void xcd_barrier(const XcdBarrier& b) {
    asm volatile("s_waitcnt vmcnt(0)" ::: "memory");
    __syncthreads();
    if (threadIdx.x == 0) {
        unsigned* bar = b.bar;
        __builtin_amdgcn_s_waitcnt(0);
        unsigned nloc = b.st[0], nx = b.st[1];
        if (nloc == 0u) { xcd_barrier_complete(bar, b.x, nloc, nx); b.st[0] = nloc; b.st[1] = nx; }
        const unsigned old = xb_add(&bar[XB_XSUB(b.x)], 1u);
        const unsigned gen = old / nloc;
        if (old + 1u == (gen + 1u) * nloc) {
            __builtin_amdgcn_fence(__ATOMIC_RELEASE, "agent");
            asm volatile("s_waitcnt vmcnt(0)" ::: "memory");
            const unsigned og = xb_add(&bar[XB_TOP], 1u);
            const unsigned tg = og / nx;
            if (og + 1u == (tg + 1u) * nx) xb_add(&bar[XB_TOPGEN], 1u);
            else XB_SPIN(xb_ld(&bar[XB_TOPGEN]) == tg, bar);
            __builtin_amdgcn_fence(__ATOMIC_ACQUIRE, "agent");
            xb_add(&bar[XB_XGEN(b.x)], 1u);
            asm volatile("s_waitcnt vmcnt(0)" ::: "memory");
        } else {
            XB_SPIN(xb_ld(&bar[XB_XGEN(b.x)]) == gen, bar);
            __builtin_amdgcn_fence(__ATOMIC_ACQUIRE, "agent");
            asm volatile("s_waitcnt vmcnt(0)" ::: "memory");
        }
    }
    __syncthreads();
}

struct Args { const float* in[25]; float* out; unsigned char* ws; int ph_lo, ph_hi; };
struct Frame {
    LAS unsigned char* lds;
    volatile LAS unsigned* MISC;
    gu32* ctl;
    int tid, lane, wave, G;
    const float *x_p, *x_s, *c_p, *c_s, *st_sc, *st_cv, *st_ssm, *w_ada, *b_ada, *g_mpre, *g_mpost, *g_fpre, *g_fpost, *w_in, *sc_w, *cv_w, *cv_b, *dt_bias, *a_log, *d_skip, *ssm_g, *w_out, *w_gate, *w_up, *w_down;
    float* out;
    float* mod; bf16 *Win_t, *Wout_t, *Wgu_t, *Wd_t; float* dtb; bf16 *proj, *act, *xn2; bf16* fbuf; float *slab6, *slab9;
    bf16* xn1;
    bf16* xbcc;
    float* x1;
};
__device__ __forceinline__ float wave_sum(float v) {
#pragma unroll
    for (int o = 1; o < 64; o <<= 1) v += __shfl_xor(v, o);
    return v;
}
__device__ __forceinline__ const float* x_row(const Frame& F, int m) { return m < MP ? F.x_p + (size_t)m * D : F.x_s + (size_t)(m - MP) * D; }
__device__ __forceinline__ int seq_of(int m) { return m < MP ? (m >> 11) : BATCH_P + ((m - MP) >> 3); }

__device__ __forceinline__ void p0_transpose_item(const float* W, int K, int N, int nblk, bf16* WT, int mode, LAS float* scr, int item, int lane) {
    const int kb = item / nblk, nb = item % nblk, k0 = 64 * kb, n0 = 32 * nb;
    const bool ok = (n0 + (lane & 31)) < N;
#pragma unroll 8
    for (int i = 0; i < 32; ++i) { const int kk = 2 * i + (lane >> 5); scr[kk * 33 + (lane & 31)] = ok ? W[(size_t)(k0 + kk) * N + n0 + (lane & 31)] : 0.f; }
    LDS_WAIT(); asm volatile("" ::: "memory");
    const int c = lane & 7;
    const int r0 = mode == 0 ? n0 : ((n0 >> 7) * 256 + (n0 & 127) + (mode == 2 ? 128 : 0));
#pragma unroll
    for (int j = 0; j < 4; ++j) { const int n = (lane >> 3) + 8 * j; const LAS float* s = scr + (8 * c) * 33 + n;
        v4u o; o.x = pk2(s[0 * 33], s[1 * 33]); o.y = pk2(s[2 * 33], s[3 * 33]); o.z = pk2(s[4 * 33], s[5 * 33]); o.w = pk2(s[6 * 33], s[7 * 33]);
        *(v4u*)(WT + (size_t)(r0 + n) * K + k0 + 8 * c) = o; }
    LDS_WAIT(); asm volatile("" ::: "memory");
}

__device__ __forceinline__ void p0_prologue(Frame& F) {
    {
        typedef float f32x16a __attribute__((ext_vector_type(16))); typedef short bf16x8a __attribute__((ext_vector_type(8)));
        constexpr int AS = 2064;
        LAS unsigned char* L = F.lds + RING_OFF;
        const int r32 = F.lane & 31, hh = F.lane >> 5, nt = F.wave & 3, kh = F.wave >> 2;
        for (int it = blockIdx.x; it < 5 * 48; it += F.G) {
            const int mt = it / 48, j0 = (it % 48) * 128;
            { const int sl = F.tid >> 4, kq = (F.tid & 15) * 64, s = 32 * mt + sl;
              const float* cp = s < BATCH_P ? F.c_p + (size_t)s * D : F.c_s + (size_t)((s < NSEQ ? s : NSEQ - 1) - BATCH_P) * D;
              f32x4 cv[16];
#pragma unroll
              for (int i = 0; i < 16; ++i) cv[i] = *(const f32x4*)(cp + kq + 4 * i);
#pragma unroll
              for (int i = 0; i < 8; ++i) { const f32x4 a = cv[2 * i], c2 = cv[2 * i + 1]; v4u o;
                  o.x = pk2(silu_f(a.x), silu_f(a.y)); o.y = pk2(silu_f(a.z), silu_f(a.w)); o.z = pk2(silu_f(c2.x), silu_f(c2.y)); o.w = pk2(silu_f(c2.z), silu_f(c2.w));
                  if (s >= NSEQ) o = (v4u){0u, 0u, 0u, 0u};
                  *(LAS v4u*)(L + sl * AS + (kq + 8 * i) * 2) = o; } }
            LDS_WAIT(); __syncthreads();
            f32x16a acc;
#pragma unroll
            for (int i = 0; i < 16; ++i) acc[i] = 0.f;
            const float* wp = F.w_ada + (size_t)(512 * kh + 8 * hh) * 6144 + j0 + 32 * nt + r32;
#pragma unroll 4
            for (int ks = 0; ks < 32; ++ks) {
                float wv[8];
#pragma unroll
                for (int e2 = 0; e2 < 8; ++e2) wv[e2] = wp[(size_t)(16 * ks + e2) * 6144];
                pg8::u32x4 bw; bw.x = pk2(wv[0], wv[1]); bw.y = pk2(wv[2], wv[3]); bw.z = pk2(wv[4], wv[5]); bw.w = pk2(wv[6], wv[7]);
                const bf16x8a af = *(const LAS bf16x8a*)(L + r32 * AS + (512 * kh + 16 * ks + 8 * hh) * 2);
                acc = __builtin_amdgcn_mfma_f32_32x32x16_bf16(af, __builtin_bit_cast(bf16x8a, bw), acc, 0, 0, 0);
            }
            LAS float* red = (LAS float*)(L + 32 * AS);
            if (kh == 1) {
#pragma unroll
                for (int i = 0; i < 16; ++i) red[(nt * 16 + i) * 64 + F.lane] = acc[i]; }
            LDS_WAIT(); __syncthreads();
            if (kh == 0) {
                const float bj = F.b_ada[j0 + 32 * nt + r32];
#pragma unroll
                for (int i = 0; i < 16; ++i) { const int s = 32 * mt + (i & 3) + 8 * (i >> 2) + 4 * hh;
                    if (s < NSEQ) F.mod[(size_t)s * 6144 + j0 + 32 * nt + r32] = acc[i] + red[(nt * 16 + i) * 64 + F.lane] + bj; } }
            __syncthreads();
        }
    }
    LAS float* scr = (LAS float*)(F.lds + RING_OFF + F.wave * 16384);
    const int gw = blockIdx.x * NWAVES + F.wave, NGW = F.G * NWAVES;
    constexpr int I_IN = (D / 64) * (NPROJ_PAD / 32), I_OUT = (2048 / 64) * (D / 32), I_G = (D / 64) * (FF / 32), I_D = (FF / 64) * (D / 32);
    constexpr int NITEMS = I_IN + I_OUT + 2 * I_G + I_D;
    for (int it = gw; it < NITEMS; it += NGW) {
        int r = it;
        if (r < I_IN) { p0_transpose_item(F.w_in, D, NPROJ, NPROJ_PAD / 32, F.Win_t, 0, scr, r, F.lane); continue; } r -= I_IN;
        if (r < I_OUT) { p0_transpose_item(F.w_out, 2048, D, D / 32, F.Wout_t, 0, scr, r, F.lane); continue; } r -= I_OUT;
        if (r < I_G) { p0_transpose_item(F.w_gate, D, FF, FF / 32, F.Wgu_t, 1, scr, r, F.lane); continue; } r -= I_G;
        if (r < I_G) { p0_transpose_item(F.w_up, D, FF, FF / 32, F.Wgu_t, 2, scr, r, F.lane); continue; } r -= I_G;
        p0_transpose_item(F.w_down, FF, D, D / 32, F.Wd_t, 0, scr, r, F.lane);
    }
}
constexpr int NGRP = M / 4;
struct Vec16 { f32x4 v[4]; };
__device__ __forceinline__ void ldvec(const float* __restrict__ p, int lane, Vec16& o) {
#pragma unroll
    for (int j = 0; j < 4; ++j) o.v[j] = *((const f32x4*)p + lane + 64 * j);
}
__device__ __forceinline__ float sumsq16(const Vec16& a) { float s = 0.f;
#pragma unroll
    for (int j = 0; j < 4; ++j) s += (a.v[j].x * a.v[j].x + a.v[j].y * a.v[j].y) + (a.v[j].z * a.v[j].z + a.v[j].w * a.v[j].w);
    return s; }
__device__ __forceinline__ void st_bf16_row(bf16* __restrict__ row, int lane, const Vec16& h) {
    unsigned long long* o8 = (unsigned long long*)row + lane;
#pragma unroll
    for (int j = 0; j < 4; ++j) o8[64 * j] = (unsigned long long)pk2(h.v[j].x, h.v[j].y) | ((unsigned long long)pk2(h.v[j].z, h.v[j].w) << 32);
}
__device__ __forceinline__ void p1_hrows(Frame& F) {
    const int gw = blockIdx.x * NWAVES + F.wave, NGW = F.G * NWAVES;
    Vec16 g; ldvec(F.g_mpre, F.lane, g);
    for (int gi = gw; gi < NGRP; gi += NGW) {
        const int m0 = 4 * gi; const float* md = F.mod + (size_t)seq_of(m0) * 6144;
        Vec16 x[4], sh, sc;
#pragma unroll
        for (int r = 0; r < 4; ++r) ldvec(x_row(F, m0 + r), F.lane, x[r]);
        ldvec(md, F.lane, sh); ldvec(md + 1024, F.lane, sc);
#pragma unroll
        for (int r = 0; r < 4; ++r) { const float rstd = 1.0f / sqrtf(wave_sum(sumsq16(x[r])) * (1.f / D) + EPS); Vec16 h;
#pragma unroll
            for (int j = 0; j < 4; ++j) h.v[j] = (x[r].v[j] * rstd) * g.v[j] * (sc.v[j] + 1.0f) + sh.v[j];
            st_bf16_row(F.xn1 + (size_t)(m0 + r) * D, F.lane, h); }
    }
}
__device__ __forceinline__ void unpack8(const v4u q, float (&f)[8]) { f[0] = bflo(q.x); f[1] = bfhi(q.x); f[2] = bflo(q.y); f[3] = bfhi(q.y); f[4] = bflo(q.z); f[5] = bfhi(q.z); f[6] = bflo(q.w); f[7] = bfhi(q.w); }
__device__ __forceinline__ void ld8f(const float* p, float (&f)[8]) { const f32x4 a = *(const f32x4*)p, b = *(const f32x4*)(p + 4); f[0] = a.x; f[1] = a.y; f[2] = a.z; f[3] = a.w; f[4] = b.x; f[5] = b.y; f[6] = b.z; f[7] = b.w; }
__device__ __forceinline__ void st8f(float* p, const float (&f)[8]) { *(f32x4*)p = (f32x4){f[0], f[1], f[2], f[3]}; *(f32x4*)(p + 4) = (f32x4){f[4], f[5], f[6], f[7]}; }
__device__ __forceinline__ void p3_conv(Frame& F) {
    const int total = (M / 4) * 384;
    for (int idx = blockIdx.x * NTHREADS + F.tid; idx < total; idx += F.G * NTHREADS) {
        const int qd = idx / 384, ch = idx - qd * 384, r0 = 4 * qd;
        int b, t0, L; bool samp;
        if (r0 < MP) { b = r0 >> 11; t0 = r0 & 2047; L = SEQ_P; samp = false; } else { const int rr = r0 - MP; b = rr >> 3; t0 = rr & 7; L = SEQ_S; samp = true; }
        const bf16* prow = F.proj + (size_t)r0 * PROJ_LD;
        const bool first = (t0 == 0), lastq = (t0 == L - 4);
        if (ch < 128) {
            const int c0 = ch * 8;
            v4u qc[6], qx[6], qb[4];
#pragma unroll
            for (int k = 0; k < 6; ++k) { const bf16* pr = prow + (ptrdiff_t)((k < 2 && first) ? 0 : k - 2) * PROJ_LD; qc[k] = *(const v4u*)(pr + C_SCC + c0); qx[k] = *(const v4u*)(pr + C_SCX + c0); }
#pragma unroll
            for (int k = 0; k < 4; ++k) qb[k] = *(const v4u*)(prow + (size_t)k * PROJ_LD + C_SCB + c0);
            float w[3][8];
#pragma unroll
            for (int j = 0; j < 3; ++j) ld8f(F.sc_w + (size_t)j * SCW + c0, w[j]);
            float sbuf[2][8];
#pragma unroll
            for (int k = 0; k < 2; ++k) ld8f(F.st_sc + ((size_t)b * 2 + k) * SCW + c0, sbuf[k]);
            asm volatile("" ::: "memory");
            float u[6][8];
#pragma unroll
            for (int k = 0; k < 6; ++k) {
                float cc[8], xx[8]; unpack8(qc[k], cc); unpack8(qx[k], xx);
#pragma unroll
                for (int i = 0; i < 8; ++i) u[k][i] = cc[i] * xx[i];
                if (k < 2) {
#pragma unroll
                    for (int i = 0; i < 8; ++i) u[k][i] = first ? (samp ? sbuf[k][i] : 0.f) : u[k][i]; } }
            if (lastq) { float* op = F.out + (samp ? O_SCS : O_SCP) + ((size_t)b * 2) * SCW + c0; st8f(op, u[4]); st8f(op + SCW, u[5]); }
#pragma unroll
            for (int i4 = 0; i4 < 4; ++i4) { float bb[8]; unpack8(qb[i4], bb); float o[8];
#pragma unroll
                for (int i = 0; i < 8; ++i) o[i] = bb[i] * (w[0][i] * u[i4][i] + w[1][i] * u[i4 + 1][i] + w[2][i] * u[i4 + 2][i]);
                v4u ov; ov.x = pk2(o[0], o[1]); ov.y = pk2(o[2], o[3]); ov.z = pk2(o[4], o[5]); ov.w = pk2(o[6], o[7]);
                *(v4u*)(F.proj + (size_t)(r0 + i4) * PROJ_LD + C_SCB + c0) = ov; }
        } else {
            const int c0 = (ch - 128) * 8;
            v4u qv[7];
#pragma unroll
            for (int k = 0; k < 7; ++k) qv[k] = *(const v4u*)(prow + (ptrdiff_t)((k < 3 && first) ? 0 : k - 3) * PROJ_LD + C_XBC + c0);
            float w[4][8], bias[8];
#pragma unroll
            for (int j = 0; j < 4; ++j) ld8f(F.cv_w + (size_t)j * XBC + c0, w[j]);
            ld8f(F.cv_b + c0, bias);
            float sbuf[3][8];
#pragma unroll
            for (int k = 0; k < 3; ++k) ld8f(F.st_cv + ((size_t)b * 3 + k) * XBC + c0, sbuf[k]);
            asm volatile("" ::: "memory");
            float xe[7][8];
#pragma unroll
            for (int k = 0; k < 7; ++k) {
                unpack8(qv[k], xe[k]);
                if (k < 3) {
#pragma unroll
                    for (int i = 0; i < 8; ++i) xe[k][i] = first ? (samp ? sbuf[k][i] : 0.f) : xe[k][i]; } }
            if (lastq) { float* op = F.out + (samp ? O_CVS : O_CVP) + ((size_t)b * 3) * XBC + c0; st8f(op, xe[4]); st8f(op + XBC, xe[5]); st8f(op + 2 * XBC, xe[6]); }
#pragma unroll
            for (int i4 = 0; i4 < 4; ++i4) { float o[8];
#pragma unroll
                for (int i = 0; i < 8; ++i) o[i] = silu_f(bias[i] + w[0][i] * xe[i4][i] + w[1][i] * xe[i4 + 1][i] + w[2][i] * xe[i4 + 2][i] + w[3][i] * xe[i4 + 3][i]);
                v4u ov; ov.x = pk2(o[0], o[1]); ov.y = pk2(o[2], o[3]); ov.z = pk2(o[4], o[5]); ov.w = pk2(o[6], o[7]);
                *(v4u*)(F.xbcc + (size_t)(r0 + i4) * XBC + c0) = ov; }
        }
    }
}
__device__ __forceinline__ void scan_item(Frame& F, int s, int h) {
    const int p = F.tid >> 3, nq = F.tid & 7, g = h >> 2;
    const bool samp = s >= BATCH_P; const int b = samp ? s - BATCH_P : s; const int L = samp ? SEQ_S : SEQ_P; const int row0 = samp ? MP + b * SEQ_S : b * SEQ_P;
    float S[16];
    if (samp) { const float* sp = F.st_ssm + (((size_t)b * NH + h) * HP + p) * NS + nq * 16;
#pragma unroll
        for (int i = 0; i < 4; ++i) { const f32x4 a = *(const f32x4*)(sp + 4 * i); S[4 * i] = a.x; S[4 * i + 1] = a.y; S[4 * i + 2] = a.z; S[4 * i + 3] = a.w; } }
    else {
#pragma unroll
        for (int i = 0; i < 16; ++i) S[i] = 0.f; }
    const float Dh = F.d_skip[h];
    for (int t0 = 0; t0 < L; t0 += 8) {
        v4u Bq[8][2], Cq[8][2]; float xv[8], dtv[8], a2v[8];
#pragma unroll
        for (int u = 0; u < 8; ++u) { const int r = row0 + t0 + u; const bf16* xr = F.xbcc + (size_t)r * XBC;
            Bq[u][0] = *(const v4u*)(xr + 1024 + g * NS + nq * 16); Bq[u][1] = *(const v4u*)(xr + 1024 + g * NS + nq * 16 + 8);
            Cq[u][0] = *(const v4u*)(xr + 1536 + g * NS + nq * 16); Cq[u][1] = *(const v4u*)(xr + 1536 + g * NS + nq * 16 + 8);
            xv[u] = bf1(xr[h * HP + p]); dtv[u] = F.dtb[(size_t)r * 32 + h]; a2v[u] = F.dtb[(size_t)r * 32 + 16 + h]; }
#pragma unroll
        for (int u = 0; u < 8; ++u) {
            const float dt = dtv[u], dA = __builtin_amdgcn_exp2f(a2v[u]), xdt = dt * xv[u];
            float Bf[16], Cf[16]; { float t8[8]; unpack8(Bq[u][0], t8);
#pragma unroll
                for (int i = 0; i < 8; ++i) Bf[i] = t8[i];
                unpack8(Bq[u][1], t8);
#pragma unroll
                for (int i = 0; i < 8; ++i) Bf[8 + i] = t8[i];
                unpack8(Cq[u][0], t8);
#pragma unroll
                for (int i = 0; i < 8; ++i) Cf[i] = t8[i];
                unpack8(Cq[u][1], t8);
#pragma unroll
                for (int i = 0; i < 8; ++i) Cf[8 + i] = t8[i]; }
            float y = 0.f;
#pragma unroll
            for (int i = 0; i < 16; ++i) { S[i] = S[i] * dA + xdt * Bf[i]; y += Cf[i] * S[i]; }
            y += __shfl_xor(y, 1); y += __shfl_xor(y, 2); y += __shfl_xor(y, 4);
            y += Dh * xv[u];
            if (nq == 0) F.proj[(size_t)(row0 + t0 + u) * PROJ_LD + C_SCX + h * HP + p] = (bf16)f2bf(y);
        }
    }
    float* op = F.out + (samp ? O_SSMS : O_SSMP) + (((size_t)b * NH + h) * HP + p) * NS + nq * 16;
#pragma unroll
    for (int i = 0; i < 4; ++i) *(f32x4*)(op + 4 * i) = (f32x4){S[4 * i], S[4 * i + 1], S[4 * i + 2], S[4 * i + 3]};
}
typedef float f32x16 __attribute__((ext_vector_type(16)));
typedef short bf16x8 __attribute__((ext_vector_type(8)));
constexpr int SSD_Q = 128, SSD_NC = SEQ_P / SSD_Q;
constexpr int SB_STRIDE = 272, SX_STRIDE = 144;
constexpr int L_BS = 0, L_CS = L_BS + SSD_Q * SB_STRIDE, L_XS = L_CS + SSD_Q * SB_STRIDE, L_SB = L_XS + SSD_Q * SX_STRIDE, L_A2 = L_SB + 2 * 16384, L_LA2 = L_A2 + 512, L_PS = L_LA2 + 512, L_WL = L_PS + 512, L_QL = L_WL + 512, L_TT = L_QL + 512, L_SSD_END = L_TT + 64;
static_assert(L_SSD_END <= RING_BYTES, "SSD LDS map");
constexpr float LOG2E = 1.4426950408889634f;
__device__ __forceinline__ void pack_tile(const f32x16& x, bf16x8 (&f)[2]) {
#pragma unroll
    for (int s = 0; s < 2; ++s) { pg8::u32x4 w;
#pragma unroll
        for (int k = 0; k < 4; ++k) w[k] = pk2(x[8 * s + 2 * k], x[8 * s + 2 * k + 1]);
        f[s] = __builtin_bit_cast(bf16x8, w); }
}
__device__ __forceinline__ void ssd_prompt_item(Frame& F, int b, int h) {
    LAS unsigned char* L = F.lds + RING_OFF;
    const int tid = F.tid, lane = F.lane, wid = F.wave, r32 = lane & 31, hh = lane >> 5;
    const int pt = wid >> 2, jj = wid & 3, j = pt ? 3 - jj : jj, q = jj, g = h >> 2;
    const float Dh = F.d_skip[h];
    bf16x8 Id[2];
#pragma unroll
    for (int ks = 0; ks < 2; ++ks)
#pragma unroll
        for (int e = 0; e < 8; ++e) Id[ks][e] = (16 * ks + 8 * hh + e == r32) ? (short)0x3F80 : (short)0;
    for (int i = tid; i < 16384 / 16; i += NTHREADS) *(LAS v4u*)(L + L_SB + i * 16) = (v4u){0u, 0u, 0u, 0u};
    f32x16 S;
#pragma unroll
    for (int i = 0; i < 16; ++i) S[i] = 0.f;
    const bf16* xb = F.xbcc + (size_t)(b * SEQ_P) * XBC;
    const float* dtr = F.dtb + (size_t)(b * SEQ_P) * 32 + h;
    v4u pB[4], pC[4], pX[2]; float pd0 = 0.f, pd1 = 0.f, pa0 = 0.f, pa1 = 0.f;
#define SSD_LOAD(c) do { const bf16* xc = xb + (size_t)(c) * SSD_Q * XBC; \
        _Pragma("unroll") for (int k = 0; k < 4; ++k) { const int qq = tid + NTHREADS * k, row = qq >> 4, ch = qq & 15; \
            pB[k] = *(const v4u*)(xc + (size_t)row * XBC + 1024 + g * NS + ch * 8); pC[k] = *(const v4u*)(xc + (size_t)row * XBC + 1536 + g * NS + ch * 8); } \
        _Pragma("unroll") for (int k = 0; k < 2; ++k) { const int qq = tid + NTHREADS * k, row = qq >> 3, ch = qq & 7; pX[k] = *(const v4u*)(xc + (size_t)row * XBC + h * HP + ch * 8); } \
        if (wid == 0) { const float* dp_ = dtr + (size_t)((c) * SSD_Q + 2 * lane) * 32; pd0 = dp_[0]; pa0 = dp_[16]; pd1 = dp_[32]; pa1 = dp_[48]; } } while (0)
    SSD_LOAD(0);
    for (int c = 0; c < SSD_NC; ++c) {
#pragma unroll
        for (int k = 0; k < 4; ++k) { const int qq = tid + NTHREADS * k, row = qq >> 4, ch = qq & 15;
            *(LAS v4u*)(L + L_BS + row * SB_STRIDE + ch * 16) = pB[k]; *(LAS v4u*)(L + L_CS + row * SB_STRIDE + ch * 16) = pC[k]; }
#pragma unroll
        for (int k = 0; k < 2; ++k) { const int qq = tid + NTHREADS * k, row = qq >> 3, ch = qq & 7; *(LAS v4u*)(L + L_XS + row * SX_STRIDE + ch * 16) = pX[k]; }
        if (wid == 0) {
            const float d0 = pd0, d1 = pd1, a0 = pa0, a1 = pa1;
            float pfx = a0 + a1;
#pragma unroll
            for (int o = 1; o < 64; o <<= 1) { const float t = __shfl_up(pfx, o); if (lane >= o) pfx += t; }
            const float c1 = pfx, c0 = pfx - a1;
            const float ce = __shfl(c1, (lane & 48) + 15), cs = __shfl(c0, lane & 48), cend = __shfl(c1, 63);
            *(LAS float*)(L + L_A2 + (2 * lane) * 4) = c0; *(LAS float*)(L + L_A2 + (2 * lane + 1) * 4) = c1;
            *(LAS float*)(L + L_LA2 + (2 * lane) * 4) = c0 - __log2f(d0); *(LAS float*)(L + L_LA2 + (2 * lane + 1) * 4) = c1 - __log2f(d1);
            *(LAS float*)(L + L_PS + (2 * lane) * 4) = d0 * __builtin_amdgcn_exp2f(ce - c0); *(LAS float*)(L + L_PS + (2 * lane + 1) * 4) = d1 * __builtin_amdgcn_exp2f(ce - c1);
            *(LAS float*)(L + L_QL + (2 * lane) * 4) = __builtin_amdgcn_exp2f(c0 - cs); *(LAS float*)(L + L_QL + (2 * lane + 1) * 4) = __builtin_amdgcn_exp2f(c1 - cs);
            *(LAS float*)(L + L_WL + (2 * lane) * 4) = d0 * __builtin_amdgcn_exp2f(cend - c0); *(LAS float*)(L + L_WL + (2 * lane + 1) * 4) = d1 * __builtin_amdgcn_exp2f(cend - c1);
            { const int ti = (lane >> 2) & 3, tj = lane & 3; const float ei = __shfl(c1, 16 * ti + 15), sj = __shfl(c0, 16 * tj);
              if (lane < 16) *(LAS float*)(L + L_TT + lane * 4) = (ti < tj) ? __builtin_amdgcn_exp2f(sj - ei) : 0.f; }
        }
        LDS_WAIT(); __syncthreads();
        if (c + 1 < SSD_NC) SSD_LOAD(c + 1);
        LAS unsigned char* SBc = L + L_SB + (c & 1) * 16384; LAS unsigned char* SBn = L + L_SB + ((c + 1) & 1) * 16384;
        const float a2end = *(LAS float*)(L + L_A2 + 127 * 4);
#define SSD_T1(i, dst) do { f32x16 acc_; _Pragma("unroll") for (int e = 0; e < 16; ++e) acc_[e] = 0.f; \
            _Pragma("unroll") for (int ks = 0; ks < 2; ++ks) { const bf16x8 a_ = *(const LAS bf16x8*)(L + L_XS + (32 * (i) + r32) * SX_STRIDE + (32 * pt + 16 * ks + 8 * hh) * 2); \
                acc_ = __builtin_amdgcn_mfma_f32_32x32x16_bf16(a_, Id[ks], acc_, 0, 0, 0); } \
            pack_tile(acc_, dst); } while (0)
        const int lrow = 32 * j + r32; const float a2l = *(LAS float*)(L + L_A2 + lrow * 4), ql = *(LAS float*)(L + L_QL + lrow * 4);
        f32x16 Y;
#pragma unroll
        for (int e = 0; e < 16; ++e) Y[e] = 0.f;
#pragma unroll
        for (int qq = 0; qq < 4; ++qq)
#pragma unroll
            for (int s = 0; s < 2; ++s) { const bf16x8 a = *(const LAS bf16x8*)(SBc + ((qq * 2 + pt) * 2 + s) * 1024 + lane * 16);
                const LAS unsigned char* cp = L + L_CS + lrow * SB_STRIDE + (32 * qq + 16 * s + 4 * hh) * 2;
                const v2u c0 = *(const LAS v2u*)cp, c1 = *(const LAS v2u*)(cp + 16);
                const bf16x8 bb = __builtin_bit_cast(bf16x8, ((v4u){c0.x, c0.y, c1.x, c1.y}));
                Y = __builtin_amdgcn_mfma_f32_32x32x16_bf16(a, bb, Y, 0, 0, 0); }
        { const float el = __builtin_amdgcn_exp2f(a2l);
#pragma unroll
            for (int e = 0; e < 16; ++e) Y[e] *= el; }
        for (int i = 0; i <= j; ++i) {
            bf16x8 t1[2]; SSD_T1(i, t1);
            f32x16 X;
#pragma unroll
            for (int e = 0; e < 16; ++e) X[e] = 0.f;
#pragma unroll
            for (int ks = 0; ks < 8; ++ks) { const bf16x8 a = *(const LAS bf16x8*)(L + L_BS + (32 * i + r32) * SB_STRIDE + (16 * ks + 8 * hh) * 2);
                const bf16x8 bb = *(const LAS bf16x8*)(L + L_CS + lrow * SB_STRIDE + (16 * ks + 8 * hh) * 2);
                X = __builtin_amdgcn_mfma_f32_32x32x16_bf16(a, bb, X, 0, 0, 0); }
            if (i == j) {
#pragma unroll
                for (int rg = 0; rg < 4; ++rg) { const int sb = 32 * i + 8 * rg + 4 * hh; const f32x4 la = *(const LAS f32x4*)(L + L_LA2 + sb * 4);
#pragma unroll
                    for (int e = 0; e < 4; ++e) { const int s = sb + e; float v = X[4 * rg + e] * __builtin_amdgcn_exp2f(a2l - la[e]); v = (s <= lrow) ? v : 0.f; v += (s == lrow) ? Dh : 0.f; X[4 * rg + e] = v; } }
            } else { const float qt = ql * *(const LAS float*)(L + L_TT + (i * 4 + j) * 4);
#pragma unroll
                for (int rg = 0; rg < 4; ++rg) { const int sb = 32 * i + 8 * rg + 4 * hh; const f32x4 ps = *(const LAS f32x4*)(L + L_PS + sb * 4);
#pragma unroll
                    for (int e = 0; e < 4; ++e) X[4 * rg + e] *= qt * ps[e]; } }
            bf16x8 xf[2]; pack_tile(X, xf);
#pragma unroll
            for (int s = 0; s < 2; ++s) Y = __builtin_amdgcn_mfma_f32_32x32x16_bf16(t1[s], xf[s], Y, 0, 0, 0);
        }
        { bf16* yrow = F.proj + (size_t)(b * SEQ_P + c * SSD_Q + lrow) * PROJ_LD + C_SCX + h * HP + 32 * pt + 4 * hh;
#pragma unroll
            for (int rg = 0; rg < 4; ++rg) { v2u o; o.x = pk2(Y[4 * rg], Y[4 * rg + 1]); o.y = pk2(Y[4 * rg + 2], Y[4 * rg + 3]); *(v2u*)(yrow + 8 * rg) = o; } }
        { const float dec = __builtin_amdgcn_exp2f(a2end);
#pragma unroll
            for (int e = 0; e < 16; ++e) S[e] *= dec; }
        for (int i = 0; i < 4; ++i) {
            bf16x8 t1[2]; SSD_T1(i, t1);
            f32x16 acc;
#pragma unroll
            for (int e = 0; e < 16; ++e) acc[e] = 0.f;
#pragma unroll
            for (int ks = 0; ks < 2; ++ks) { const bf16x8 a = *(const LAS bf16x8*)(L + L_BS + (32 * i + r32) * SB_STRIDE + (32 * q + 16 * ks + 8 * hh) * 2);
                acc = __builtin_amdgcn_mfma_f32_32x32x16_bf16(a, Id[ks], acc, 0, 0, 0); }
#pragma unroll
            for (int rg = 0; rg < 4; ++rg) { const int sb = 32 * i + 8 * rg + 4 * hh; const f32x4 wl = *(const LAS f32x4*)(L + L_WL + sb * 4);
#pragma unroll
                for (int e = 0; e < 4; ++e) acc[4 * rg + e] *= wl[e]; }
            bf16x8 t2[2]; pack_tile(acc, t2);
#pragma unroll
            for (int s = 0; s < 2; ++s) S = __builtin_amdgcn_mfma_f32_32x32x16_bf16(t2[s], t1[s], S, 0, 0, 0);
        }
        if (c + 1 < SSD_NC) { bf16x8 sf[2]; pack_tile(S, sf);
#pragma unroll
            for (int s = 0; s < 2; ++s) *(LAS bf16x8*)(SBn + ((q * 2 + pt) * 2 + s) * 1024 + lane * 16) = sf[s]; }
        else { float* op = F.out + O_SSMP + (((size_t)b * NH + h) * HP + 32 * pt + r32) * NS + 32 * q + 4 * hh;
#pragma unroll
            for (int rg = 0; rg < 4; ++rg) *(f32x4*)(op + 8 * rg) = (f32x4){S[4 * rg], S[4 * rg + 1], S[4 * rg + 2], S[4 * rg + 3]}; }
        LDS_WAIT(); __syncthreads();
    }
#undef SSD_LOAD
#undef SSD_T1
}
__device__ __forceinline__ void p4_scan(Frame& F) {
    const int np = (F.G >= 256) ? 128 : F.G;
    if ((int)blockIdx.x < np) for (int it = blockIdx.x; it < BATCH_P * NH; it += np) ssd_prompt_item(F, it / NH, it % NH);
    gu32* ctr = F.ctl + CW_SCAN;
    for (;;) {
        __syncthreads();
        if (F.tid == 0) F.MISC[16] = __hip_atomic_fetch_add(ctr, 4u, RLX_AGENT);
        __syncthreads();
        const int base = (int)F.MISC[16];
        if (base >= BATCH_S * NH) break;
        for (int k = 0; k < 4; ++k) { const int it = base + k; if (it < BATCH_S * NH) scan_item(F, BATCH_P + it / NH, it % NH); }
    }
}
__device__ __forceinline__ void p5_gatenorm(Frame& F) {
    const int gw = blockIdx.x * NWAVES + F.wave, NGW = F.G * NWAVES; constexpr int R5 = 8;
    for (int it0 = gw; it0 < M * NG; it0 += R5 * NGW) {
        v2u yq[R5], zq[R5];
#pragma unroll
        for (int r = 0; r < R5; ++r) { int it = it0 + r * NGW; it = it < M * NG ? it : it0; const bf16* prow = F.proj + (size_t)(it >> 2) * PROJ_LD; const int c = (it & 3) * 256 + 4 * F.lane;
            yq[r] = *(const v2u*)(prow + C_SCX + c); zq[r] = *(const v2u*)(prow + C_Z + c); }
        asm volatile("" ::: "memory");
#pragma unroll
        for (int r = 0; r < R5; ++r) { int it = it0 + r * NGW; it = it < M * NG ? it : it0; bf16* prow = F.proj + (size_t)(it >> 2) * PROJ_LD; const int c = (it & 3) * 256 + 4 * F.lane;
            float v[4]; v[0] = bflo(yq[r].x) * silu_f(bflo(zq[r].x)); v[1] = bfhi(yq[r].x) * silu_f(bfhi(zq[r].x)); v[2] = bflo(yq[r].y) * silu_f(bflo(zq[r].y)); v[3] = bfhi(yq[r].y) * silu_f(bfhi(zq[r].y));
            const float ss = wave_sum((v[0] * v[0] + v[1] * v[1]) + (v[2] * v[2] + v[3] * v[3]));
            const float rstd = 1.0f / sqrtf(ss * (1.f / 256.f) + EPS); const f32x4 gg = *(const f32x4*)(F.ssm_g + c);
            v2u o; o.x = pk2(v[0] * rstd * gg.x, v[1] * rstd * gg.y); o.y = pk2(v[2] * rstd * gg.z, v[3] * rstd * gg.w);
            *(v2u*)(prow + C_SCC + c) = o; }
    }
}
__device__ __forceinline__ void ld_bf16_row(const bf16* __restrict__ row, int lane, Vec16& o) {
    const v2u* r = (const v2u*)row + lane; v2u q[4];
#pragma unroll
    for (int j = 0; j < 4; ++j) q[j] = r[64 * j];
#pragma unroll
    for (int j = 0; j < 4; ++j) o.v[j] = (f32x4){bflo(q[j].x), bfhi(q[j].x), bflo(q[j].y), bfhi(q[j].y)};
}
template <int NSL> __device__ __forceinline__ void ld_slab_rows(const float* __restrict__ ps, int ld, int r0, int lane, Vec16 (&v)[4]) {
#pragma unroll
    for (int rp = 0; rp < 4; rp += 2) {
        ldvec(ps + (size_t)(r0 + rp) * ld, lane, v[rp]); ldvec(ps + (size_t)(r0 + rp + 1) * ld, lane, v[rp + 1]);
        for (int s = 1; s < NSL; ++s) { Vec16 t0, t1;
            ldvec(ps + (size_t)(s * MS + r0 + rp) * ld, lane, t0); ldvec(ps + (size_t)(s * MS + r0 + rp + 1) * ld, lane, t1);
#pragma unroll
            for (int j = 0; j < 4; ++j) { v[rp].v[j] += t0.v[j]; v[rp + 1].v[j] += t1.v[j]; } } }
}
__device__ __forceinline__ void p7_rows(Frame& F) {
    const int gw = blockIdx.x * NWAVES + F.wave, NGW = F.G * NWAVES;
    for (int gi = gw; gi < NGRP; gi += NGW) {
        const int m0 = 4 * gi; const float* md = F.mod + (size_t)seq_of(m0) * 6144;
        Vec16 mx[4], x[4], gt, g;
        if (m0 < MP) {
#pragma unroll
            for (int r = 0; r < 4; ++r) ld_bf16_row((const bf16*)F.x1 + (size_t)(m0 + r) * 2 * D, F.lane, mx[r]);
        } else ld_slab_rows<8>(F.slab6, PROJ_LD / 2, m0 - MP, F.lane, mx);
#pragma unroll
        for (int r = 0; r < 4; ++r) ldvec(x_row(F, m0 + r), F.lane, x[r]);
        ldvec(md + 2048, F.lane, gt); ldvec(F.g_mpost, F.lane, g);
        asm volatile("" ::: "memory");
#pragma unroll
        for (int r = 0; r < 4; ++r) { const float rstd = 1.0f / sqrtf(wave_sum(sumsq16(mx[r])) * (1.f / D) + EPS);
#pragma unroll
            for (int j = 0; j < 4; ++j) x[r].v[j] = x[r].v[j] + gt.v[j] * ((mx[r].v[j] * rstd) * g.v[j]); }
        Vec16 sh, sc; ldvec(F.g_fpre, F.lane, g); ldvec(md + 3072, F.lane, sh); ldvec(md + 4096, F.lane, sc);
#pragma unroll
        for (int r = 0; r < 4; ++r) { f32x4* mr = (f32x4*)(F.x1 + (size_t)(m0 + r) * D) + F.lane;
#pragma unroll
            for (int j = 0; j < 4; ++j) mr[64 * j] = x[r].v[j]; }
#pragma unroll
        for (int r = 0; r < 4; ++r) { const float rstd2 = 1.0f / sqrtf(wave_sum(sumsq16(x[r])) * (1.f / D) + EPS); Vec16 h;
#pragma unroll
            for (int j = 0; j < 4; ++j) h.v[j] = (x[r].v[j] * rstd2) * g.v[j] * (sc.v[j] + 1.0f) + sh.v[j];
            st_bf16_row(F.xn2 + (size_t)(m0 + r) * D, F.lane, h); }
    }
}
__device__ __forceinline__ void p10_rows(Frame& F) {
    const int gw = blockIdx.x * NWAVES + F.wave, NGW = F.G * NWAVES;
    Vec16 g; ldvec(F.g_fpost, F.lane, g);
    for (int gi = gw; gi < NGRP; gi += NGW) {
        const int m0 = 4 * gi; const float* md = F.mod + (size_t)seq_of(m0) * 6144;
        Vec16 fv[4], x[4], gt;
        if (m0 < MP) {
#pragma unroll
            for (int r = 0; r < 4; ++r) ld_bf16_row(F.fbuf + (size_t)(m0 + r) * D, F.lane, fv[r]);
        } else ld_slab_rows<11>(F.slab9, D, m0 - MP, F.lane, fv);
#pragma unroll
        for (int r = 0; r < 4; ++r) ldvec(F.out + (size_t)(m0 + r) * D, F.lane, x[r]);
        ldvec(md + 5120, F.lane, gt);
        asm volatile("" ::: "memory");
#pragma unroll
        for (int r = 0; r < 4; ++r) { const float rstd = 1.0f / sqrtf(wave_sum(sumsq16(fv[r])) * (1.f / D) + EPS); f32x4* yr = (f32x4*)(F.out + (size_t)(m0 + r) * D) + F.lane;
#pragma unroll
            for (int j = 0; j < 4; ++j) yr[64 * j] = x[r].v[j] + gt.v[j] * ((fv[r].v[j] * rstd) * g.v[j]); }
    }
}

constexpr int NPHASE = 11;
#ifndef MK_ONE_LAUNCH
#define MK_ONE_LAUNCH 1
#endif
__global__ void __launch_bounds__(NTHREADS, 2) hymba_fwd(Args args) {
    extern __shared__ __attribute__((aligned(16))) unsigned char lds[];
    Frame F;
    F.lds = (LAS unsigned char*)lds;
    F.MISC = (volatile LAS unsigned*)(F.lds + MISC_OFF);
    F.tid = threadIdx.x; F.lane = F.tid & 63; F.wave = __builtin_amdgcn_readfirstlane(F.tid >> 6);
    F.G = gridDim.x;
    unsigned char* ws = args.ws;
    F.ctl = (gu32*)(ws + WS_CTL);
    F.x_p = args.in[0]; F.x_s = args.in[1]; F.c_p = args.in[2]; F.c_s = args.in[3]; F.st_sc = args.in[4]; F.st_cv = args.in[5]; F.st_ssm = args.in[6];
    F.w_ada = args.in[7]; F.b_ada = args.in[8]; F.g_mpre = args.in[9]; F.g_mpost = args.in[10]; F.g_fpre = args.in[11]; F.g_fpost = args.in[12];
    F.w_in = args.in[13]; F.sc_w = args.in[14]; F.cv_w = args.in[15]; F.cv_b = args.in[16]; F.dt_bias = args.in[17]; F.a_log = args.in[18]; F.d_skip = args.in[19];
    F.ssm_g = args.in[20]; F.w_out = args.in[21]; F.w_gate = args.in[22]; F.w_up = args.in[23]; F.w_down = args.in[24];
    F.out = args.out;
    F.mod = (float*)(ws + WS_MOD); F.Win_t = (bf16*)(ws + WS_WIN); F.Wout_t = (bf16*)(ws + WS_WOUT); F.Wgu_t = (bf16*)(ws + WS_WGU); F.Wd_t = (bf16*)(ws + WS_WD);
    F.dtb = (float*)(ws + WS_DT); F.proj = (bf16*)(ws + WS_PROJ); F.act = (bf16*)(ws + WS_ACT); F.xn2 = (bf16*)(ws + WS_XN2); F.fbuf = (bf16*)(ws + WS_F); F.slab6 = (float*)(F.proj + C_XBC); F.slab9 = (float*)(ws + WS_SLAB9);
    F.xn1 = (bf16*)(args.out + O_Y); F.xbcc = (bf16*)(args.out + O_Y); F.x1 = args.out + O_Y;
    for (int u = F.tid; u < (LDS_BYTES - LDSCTL_OFF) / 4; u += NTHREADS) ((LAS unsigned*)(F.lds + LDSCTL_OFF))[u] = 0u;
    __syncthreads();
    XcdBarrier bar; bar.bar = (unsigned*)(F.ctl + CW_BAR); bar.x = 0; bar.st = nullptr;
    const int lo = args.ph_lo, hi = args.ph_hi;
    if (hi - lo > 1) bar = xcd_barrier_post((unsigned*)(F.ctl + CW_BAR), F.MISC + 8);
#define IN(k) (lo <= (k) && (k) < hi)
#define SEAM(k) do { if (IN(k) && IN((k) + 1)) xcd_barrier(bar); } while (0)

    if (IN(0)) { p0_prologue(F); } SEAM(0);
    if (IN(1)) { p1_hrows(F); } SEAM(1);
    if (IN(2)) {
        pg8::Gemm g{F.xn1, F.Win_t, M, NPROJ_PAD, D, D, D}; pg8::StaticOrder S; S.init(M, NPROJ_PAD, F.G, (int)blockIdx.x);
        pg8::EpiProj E{F.proj, PROJ_LD, F.dtb, PROJ_LD / 256, F.dt_bias, F.a_log};
        pg8::gemm_phase<pg8::EpiProj, pg8::StaticOrder, true, true>(F.lds + RING_OFF, g, S, E);
    } SEAM(2);
    if (IN(3)) { p3_conv(F); } SEAM(3);
    if (IN(4)) { p4_scan(F); } SEAM(4);
    if (IN(5)) { p5_gatenorm(F); } SEAM(5);
    if (IN(6)) {
        { pg8::Gemm g{F.proj, F.Wout_t, MP, D, 2048, PROJ_LD, 2048}; pg8::StaticOrder S; S.init(MP, D, F.G, (int)blockIdx.x);
          pg8::EpiBf16Plain E{(bf16*)F.x1, 2 * D};
          pg8::gemm_phase<pg8::EpiBf16Plain, pg8::StaticOrder, true, true>(F.lds + RING_OFF, g, S, E); }
        { int kl = 256; asm volatile("" : "+s"(kl));
          pg8::Gemm g{F.proj, F.Wout_t, M, D, 2048, PROJ_LD, kl}; typedef pg8::SplitKOrder<8, 256, MP / 256, D / 256, 16> SK; SK S{F.G, (int)blockIdx.x};
          pg8::EpiSlabF32 E{F.slab6, PROJ_LD / 2, MP / 256, 256, MS};
          pg8::gemm_phase<pg8::EpiSlabF32, SK, true, true>(F.lds + RING_OFF, g, S, E); }
    } SEAM(6);
    if (IN(7)) { p7_rows(F); } SEAM(7);
    if (IN(8)) {
        pg8::Gemm g{F.xn2, F.Wgu_t, M, NGU, D, D, D}; pg8::StaticOrder S; S.init(M, NGU, F.G, (int)blockIdx.x);
        pg8::EpiSwiGLU E{F.act, FF};
        pg8::gemm_phase<pg8::EpiSwiGLU, pg8::StaticOrder, true, true>(F.lds + RING_OFF, g, S, E);
    } SEAM(8);
    if (IN(9)) {
        { pg8::Gemm g{F.act, F.Wd_t, MP, D, FF, FF, FF}; pg8::StaticOrder S; S.init(MP, D, F.G, (int)blockIdx.x);
          pg8::EpiBf16Plain E{F.fbuf, D};
          pg8::gemm_phase<pg8::EpiBf16Plain, pg8::StaticOrder, true, true>(F.lds + RING_OFF, g, S, E); }
        { int kl = 256; asm volatile("" : "+s"(kl));
          pg8::Gemm g{F.act, F.Wd_t, M, D, FF, FF, kl}; typedef pg8::SplitKOrder<11, 256, MP / 256, D / 256, 16> SK; SK S{F.G, (int)blockIdx.x};
          pg8::EpiSlabF32 E{F.slab9, D, MP / 256, 256, MS};
          pg8::gemm_phase<pg8::EpiSlabF32, SK, true, true>(F.lds + RING_OFF, g, S, E); }
    } SEAM(9);
    if (IN(10)) { p10_rows(F); }
#undef IN
#undef SEAM
}

extern "C" void kernel_launch(void* const* d_in, const int* in_sizes, int n_in, void* d_out, int out_size, void* d_ws, size_t ws_size, hipStream_t stream) {
    static int grid = 0;
    if (grid == 0) {
        if (n_in != 25 || out_size != (int)O_END || ws_size < WS_END) { fprintf(stderr, "kernel_launch: unexpected sizes n_in %d out %d ws %zu; nothing launched\n", n_in, out_size, ws_size); grid = -1; return; }
        int dev = 0, cus = 0, per_cu = 0;
        if (hipGetDevice(&dev) != hipSuccess || hipDeviceGetAttribute(&cus, hipDeviceAttributeMultiprocessorCount, dev) != hipSuccess) { grid = -1; return; }
        if (hipFuncSetAttribute((const void*)hymba_fwd, hipFuncAttributeMaxDynamicSharedMemorySize, LDS_BYTES) != hipSuccess) { fprintf(stderr, "kernel_launch: hipFuncSetAttribute failed\n"); grid = -1; return; }
        if (hipOccupancyMaxActiveBlocksPerMultiprocessor(&per_cu, (const void*)hymba_fwd, NTHREADS, LDS_BYTES) != hipSuccess || per_cu < 1) { fprintf(stderr, "kernel_launch: occupancy query says %d\n", per_cu); per_cu = 1; }
        (void)hipGetLastError();
        grid = cus;
    }
    if (grid < 0) return;
    (void)hipMemsetAsync((char*)d_ws + WS_CTL, 0, CTL_ZERO_BYTES, stream);
    Args a{};
    for (int i = 0; i < 25; ++i) a.in[i] = (const float*)d_in[i];
    a.out = (float*)d_out; a.ws = (unsigned char*)d_ws;
#if MK_ONE_LAUNCH
    a.ph_lo = 0; a.ph_hi = NPHASE;
    hipLaunchKernelGGL(hymba_fwd, dim3(grid), dim3(NTHREADS), LDS_BYTES, stream, a);
#else
    for (int ph = 0; ph < NPHASE; ++ph) { a.ph_lo = ph; a.ph_hi = ph + 1; hipLaunchKernelGGL(hymba_fwd, dim3(grid), dim3(NTHREADS), LDS_BYTES, stream, a); }
#endif
}
```

```cpp
#include <hip/hip_runtime.h>
#include <cstdio>
#include <cstdint>
namespace pg8 {
#define PG8_LAS __attribute__((address_space(3)))
typedef unsigned short bf16_t;
typedef short bf16x8 __attribute__((ext_vector_type(8)));
typedef float f32x4 __attribute__((ext_vector_type(4)));
typedef unsigned u32x4 __attribute__((ext_vector_type(4)));
constexpr int BM = 256, BK = 64, HALF = 128, HTB = HALF * BK * 2  , STAGE_BYTES = 8 * HTB, NXCD = 8, WGM = 8;

__host__ __device__ __forceinline__ int lds_byte(int r, int c) { const int st = (r >> 4) * 2 + (c >> 5), rr = r & 15, cc = c & 31, ob = rr * 64 + cc * 2; return st * 1024 + (ob ^ (((ob >> 9) & 1) << 5)); }
__host__ __device__ __forceinline__ void stage_rc(int b, int& R, int& C) { const int st = b / 1024, sb = b % 1024, swz = sb ^ (((sb >> 9) & 1) << 5); R = (st >> 1) * 16 + swz / 64; C = (st & 1) * 32 + (swz % 64) / 2; }
__host__ __device__ __forceinline__ int perm32(int rho) { const int n = rho >> 4, i = rho & 15; return 8 * (i >> 2) + 4 * n + (i & 3); }

struct Unit { int pm, pn, kb; };
struct Gemm { const bf16_t* A; const bf16_t* Bt; int M, N, K, lda, Kloop; };

struct StaticOrder {
    int nM, nN, nwg, G, c;
    __host__ __device__ void init(int M, int N, int G_, int c_) { nM = M / BM; nN = N / BM; nwg = nM * nN; G = G_; c = c_; }
    __host__ __device__ bool next(int i, Unit& u) const {
        const long L = (long)i * G + c; if (L >= nwg) return false;
        int wgid = (int)L; { const int q = nwg / NXCD, r = nwg % NXCD, xcd = wgid % NXCD, off = wgid / NXCD; wgid = (xcd < r ? xcd * (q + 1) : r * (q + 1) + (xcd - r) * q) + off; }
        const int nig = WGM * nN, gid = wgid / nig, fm = gid * WGM, gsz = (nM - fm) < WGM ? (nM - fm) : WGM;
        u.pm = fm + ((wgid % nig) % gsz); u.pn = (wgid % nig) / gsz; u.kb = 0; return true;
    }
    __device__ __forceinline__ void a_ready(const Unit&) const {}
    __device__ __forceinline__ void done(const Unit&) const {}
};

template <int NKS, int KSLICE, int PM0, int NN, int NUNITS> struct SplitKOrder {
    int G, c;
    __host__ __device__ bool next(int i, Unit& u) const {
        const int L = i * G + c; if (L >= NUNITS * NKS) return false;
        const int unit = L / NKS, ks = L % NKS; u.pm = PM0 + unit / NN; u.pn = unit % NN; u.kb = ks * KSLICE; return true;
    }
    __device__ __forceinline__ void a_ready(const Unit&) const {}
    __device__ __forceinline__ void done(const Unit&) const {}
};

__device__ __forceinline__ unsigned cvt_pk_bf16(float lo, float hi) { unsigned r; asm volatile("v_cvt_pk_bf16_f32 %0, %1, %2" : "=v"(r) : "v"(lo), "v"(hi)); return r; }

struct EpiF32 {
    static constexpr bool PERM = false, AFTER_DRAIN = false;
    float* C; int ldc;
    __device__ __forceinline__ void operator()(const f32x4 (&acc)[2][2][4][2], const Unit& u, int wr, int wc, int fr, int fq) const {
        const int row0 = u.pm * BM + wr * 64 + fr, col0 = u.pn * BM + wc * 32 + 4 * fq;
#pragma unroll
        for (int ai = 0; ai < 2; ++ai)
#pragma unroll
            for (int m = 0; m < 4; ++m) { float* rowp = C + (size_t)(row0 + ai * HALF + m * 16) * ldc + col0;
#pragma unroll
                for (int bj = 0; bj < 2; ++bj)
#pragma unroll
                    for (int n = 0; n < 2; ++n) *(f32x4*)(rowp + bj * HALF + n * 16) = acc[ai][bj][m][n]; }
    }
};
struct EpiBf16Plain {
    static constexpr bool PERM = true, AFTER_DRAIN = false;
    bf16_t* O; int ldc;
    __device__ __forceinline__ void operator()(const f32x4 (&acc)[2][2][4][2], const Unit& u, int wr, int wc, int fr, int fq) const {
        const int row0 = u.pm * BM + wr * 64 + fr, col0 = u.pn * BM + wc * 32 + 8 * fq;
#pragma unroll
        for (int ai = 0; ai < 2; ++ai)
#pragma unroll
            for (int m = 0; m < 4; ++m) { bf16_t* rowp = O + (size_t)(row0 + ai * HALF + m * 16) * ldc + col0;
#pragma unroll
                for (int bj = 0; bj < 2; ++bj) { const f32x4 v0 = acc[ai][bj][m][0], v1 = acc[ai][bj][m][1];
                    u32x4 w; w.x = cvt_pk_bf16(v0[0], v0[1]); w.y = cvt_pk_bf16(v0[2], v0[3]); w.z = cvt_pk_bf16(v1[0], v1[1]); w.w = cvt_pk_bf16(v1[2], v1[3]);
                    *(u32x4*)(rowp + bj * HALF) = w; } }
    }
};
struct EpiSlabF32 {
    static constexpr bool PERM = false, AFTER_DRAIN = false;
    float* C; int ldc, pm0, kslice, rows_per_slab;
    __device__ __forceinline__ void operator()(const f32x4 (&acc)[2][2][4][2], const Unit& u, int wr, int wc, int fr, int fq) const {
        const int row0 = (u.kb / kslice) * rows_per_slab + (u.pm - pm0) * BM + wr * 64 + fr, col0 = u.pn * BM + wc * 32 + 4 * fq;
#pragma unroll
        for (int ai = 0; ai < 2; ++ai)
#pragma unroll
            for (int m = 0; m < 4; ++m) { float* rowp = C + (size_t)(row0 + ai * HALF + m * 16) * ldc + col0;
#pragma unroll
                for (int bj = 0; bj < 2; ++bj)
#pragma unroll
                    for (int n = 0; n < 2; ++n) *(f32x4*)(rowp + bj * HALF + n * 16) = acc[ai][bj][m][n]; }
    }
};
struct EpiProj {
    static constexpr bool PERM = true, AFTER_DRAIN = false;
    bf16_t* O; int ldc; float* dt; int dt_tile; const float* dt_bias; const float* a_log;
    __device__ __forceinline__ void operator()(const f32x4 (&acc)[2][2][4][2], const Unit& u, int wr, int wc, int fr, int fq) const {
        const int row0 = u.pm * BM + wr * 64 + fr;
        if (u.pn == dt_tile) {
            if (wc == 0 && fq < 2) {
                float bias[8], a2f[8];
#pragma unroll
                for (int e = 0; e < 8; ++e) { bias[e] = dt_bias[8 * fq + e]; a2f[e] = -__expf(a_log[8 * fq + e]) * 1.4426950408889634f; }
#pragma unroll
                for (int ai = 0; ai < 2; ++ai)
#pragma unroll
                    for (int m = 0; m < 4; ++m) { float* rowp = dt + (size_t)(row0 + ai * HALF + m * 16) * 32 + 8 * fq; float d[8];
#pragma unroll
                        for (int e = 0; e < 8; ++e) { const float v = acc[ai][0][m][e >> 2][e & 3] + bias[e]; d[e] = v > 20.f ? v : log1pf(__expf(v)); }
                        *(f32x4*)(rowp) = (f32x4){d[0], d[1], d[2], d[3]}; *(f32x4*)(rowp + 4) = (f32x4){d[4], d[5], d[6], d[7]};
                        *(f32x4*)(rowp + 16) = (f32x4){d[0] * a2f[0], d[1] * a2f[1], d[2] * a2f[2], d[3] * a2f[3]}; *(f32x4*)(rowp + 20) = (f32x4){d[4] * a2f[4], d[5] * a2f[5], d[6] * a2f[6], d[7] * a2f[7]}; }
            }
            return;
        }
        const int col0 = u.pn * BM + wc * 32 + 8 * fq;
#pragma unroll
        for (int ai = 0; ai < 2; ++ai)
#pragma unroll
            for (int m = 0; m < 4; ++m) { bf16_t* rowp = O + (size_t)(row0 + ai * HALF + m * 16) * ldc + col0;
#pragma unroll
                for (int bj = 0; bj < 2; ++bj) { const f32x4 v0 = acc[ai][bj][m][0], v1 = acc[ai][bj][m][1];
                    u32x4 w; w.x = cvt_pk_bf16(v0[0], v0[1]); w.y = cvt_pk_bf16(v0[2], v0[3]); w.z = cvt_pk_bf16(v1[0], v1[1]); w.w = cvt_pk_bf16(v1[2], v1[3]);
                    *(u32x4*)(rowp + bj * HALF) = w; } }
    }
};
struct EpiSwiGLU {
    static constexpr bool PERM = true, AFTER_DRAIN = false;
    bf16_t* O; int ldc;
    __device__ __forceinline__ void operator()(const f32x4 (&acc)[2][2][4][2], const Unit& u, int wr, int wc, int fr, int fq) const {
        const int row0 = u.pm * BM + wr * 64 + fr, col0 = u.pn * HALF + wc * 32 + 8 * fq;
#pragma unroll
        for (int ai = 0; ai < 2; ++ai)
#pragma unroll
            for (int m = 0; m < 4; ++m) { bf16_t* rowp = O + (size_t)(row0 + ai * HALF + m * 16) * ldc + col0;
                float r[8];
#pragma unroll
                for (int n = 0; n < 2; ++n)
#pragma unroll
                    for (int i = 0; i < 4; ++i) { const float g = acc[ai][0][m][n][i], up = acc[ai][1][m][n][i];
                        r[n * 4 + i] = g * up * __builtin_amdgcn_rcpf(1.0f + __builtin_amdgcn_exp2f(-1.4426950408889634f * g)); }
                u32x4 w; w.x = cvt_pk_bf16(r[0], r[1]); w.y = cvt_pk_bf16(r[2], r[3]); w.z = cvt_pk_bf16(r[4], r[5]); w.w = cvt_pk_bf16(r[6], r[7]);
                *(u32x4*)(rowp) = w; }
    }
};

template <class Epi, class Sched, bool ALIGN_EPI = false, bool SP2 = false>
__device__ __forceinline__ void gemm_phase(PG8_LAS unsigned char* lds, const Gemm g, const Sched& S, const Epi& E) {
    const int tid = threadIdx.x, wid = __builtin_amdgcn_readfirstlane(tid >> 6), lane = tid & 63, wr = wid >> 2, wc = wid & 3, fr = lane & 15, fq = lane >> 4;
    const int K = g.K, nt = g.Kloop / BK;
    unsigned voffA[2], voffB[2];
#pragma unroll
    for (int i = 0; i < 2; ++i) { int R, C; stage_rc(tid * 16 + i * 8192, R, C); const int Rb = Epi::PERM ? ((R & ~31) + perm32(R & 31)) : R;
        voffA[i] = (unsigned)(R * g.lda + C) * 2u; voffB[i] = (unsigned)(Rb * K + C) * 2u; }
    const size_t kstep = (size_t)(BK * 2);
    const size_t hstep = (size_t)HALF * K * 2, hstepA = (size_t)HALF * g.lda * 2;
    const size_t tstep = 2 * hstep, tstepA = 2 * hstepA;
    const unsigned ldsw = (unsigned)wid * 1024u;
    const int aoff = lds_byte(wr * 64 + fr, fq * 8), boff = lds_byte(wc * 32 + fr, fq * 8);
#define PG8_SA(b, h) (((b) * 2 + (h)) * HTB)
#define PG8_SB(b, h) ((4 + (b) * 2 + (h)) * HTB)
#define PG8_STAGE(bufoff, gbase, voff) do { _Pragma("unroll") for (int _i = 0; _i < 2; ++_i) \
        __builtin_amdgcn_global_load_lds((const unsigned*)((const char*)(gbase) + (voff)[_i]), (PG8_LAS unsigned*)(lds + (bufoff) + ldsw + _i * 8192), 16, 0, 0); } while (0)
#define PG8_LDA(dst, b, h) do { _Pragma("unroll") for (int m = 0; m < 4; ++m) _Pragma("unroll") for (int k = 0; k < 2; ++k) dst[m][k] = *(const PG8_LAS bf16x8*)(lds + PG8_SA(b, h) + aoff + m * 2048 + k * 1024); } while (0)
#define PG8_LDB(dst, b, h) do { _Pragma("unroll") for (int n = 0; n < 2; ++n) _Pragma("unroll") for (int k = 0; k < 2; ++k) dst[n][k] = *(const PG8_LAS bf16x8*)(lds + PG8_SB(b, h) + boff + n * 2048 + k * 1024); } while (0)
#define PG8_MMA(ai, bj, At, Bt) do { __builtin_amdgcn_s_setprio(1); _Pragma("unroll") for (int m = 0; m < 4; ++m) _Pragma("unroll") for (int n = 0; n < 2; ++n) _Pragma("unroll") for (int k = 0; k < 2; ++k) \
        acc[ai][bj][m][n] = __builtin_amdgcn_mfma_f32_16x16x32_bf16(Bt[n][k], At[m][k], acc[ai][bj][m][n], 0, 0, 0); __builtin_amdgcn_s_setprio(0); } while (0)
#define PG8_WAIT_V(n) asm volatile("s_waitcnt vmcnt(" #n ")" ::: "memory")
#define PG8_WAIT_L(n) asm volatile("s_waitcnt lgkmcnt(" #n ")" ::: "memory")
#define PG8_BAR __builtin_amdgcn_s_barrier()
#define PG8_SCHED __builtin_amdgcn_sched_barrier(0)
    Unit cur, nxt; int ui = 0;
    if (!S.next(0, cur)) return;
    f32x4 acc[2][2][4][2];
#pragma unroll
    for (int a = 0; a < 2; ++a)
#pragma unroll
        for (int b = 0; b < 2; ++b)
#pragma unroll
            for (int m = 0; m < 4; ++m)
#pragma unroll
                for (int n = 0; n < 2; ++n) acc[a][b][m][n] = (f32x4){0.f, 0.f, 0.f, 0.f};
    bf16x8 At[4][2], B0[2][2], B1[2][2];
    const char* cA = (const char*)g.A + (size_t)cur.pm * tstepA + (size_t)cur.kb * 2; const char* cB = (const char*)g.Bt + (size_t)cur.pn * tstep + (size_t)cur.kb * 2;
    S.a_ready(cur);
    if constexpr (SP2) {
        PG8_STAGE(PG8_SB(0, 0), cB, voffB); PG8_STAGE(PG8_SB(0, 1), cB + hstep, voffB); PG8_STAGE(PG8_SA(0, 0), cA, voffA); PG8_STAGE(PG8_SA(0, 1), cA + hstepA, voffA);
        if (wr == 1) PG8_BAR;
        PG8_WAIT_V(2); PG8_BAR;
        PG8_STAGE(PG8_SB(1, 0), cB + kstep, voffB); PG8_STAGE(PG8_SA(1, 0), cA + kstep, voffA); PG8_STAGE(PG8_SB(1, 1), cB + hstep + kstep, voffB);
        PG8_WAIT_V(6); PG8_BAR;
    } else {
        PG8_STAGE(PG8_SB(0, 0), cB, voffB); PG8_STAGE(PG8_SA(0, 0), cA, voffA); PG8_STAGE(PG8_SB(0, 1), cB + hstep, voffB); PG8_STAGE(PG8_SA(0, 1), cA + hstepA, voffA);
        if (wr == 1) PG8_BAR;
        PG8_WAIT_V(4); PG8_BAR;
        PG8_STAGE(PG8_SB(1, 0), cB + kstep, voffB); PG8_STAGE(PG8_SA(1, 0), cA + kstep, voffA); PG8_STAGE(PG8_SB(1, 1), cB + hstep + kstep, voffB);
        PG8_WAIT_V(6); PG8_BAR;
    }
    for (;;) {
        const bool has_next = S.next(ui + 1, nxt);
        const char* nA = has_next ? (const char*)g.A + (size_t)nxt.pm * tstepA + (size_t)nxt.kb * 2 : cA; const char* nB = has_next ? (const char*)g.Bt + (size_t)nxt.pn * tstep + (size_t)nxt.kb * 2 : cB;
        for (int t = 0; t < nt; t += 2) {
            const bool last = (t == nt - 2);
            const char* a1 = cA + (size_t)(t + 1) * kstep;
            const char* a2 = last ? nA : cA + (size_t)(t + 2) * kstep; const char* b2 = last ? nB : cB + (size_t)(t + 2) * kstep;
            const char* a3 = a2 + kstep; const char* b3 = b2 + kstep;
            if (last && has_next) S.a_ready(nxt);
            if constexpr (SP2) {
            PG8_LDB(B0, 0, 0); PG8_LDB(B1, 0, 1); PG8_SCHED; PG8_LDA(At, 0, 0); PG8_STAGE(PG8_SA(1, 1), a1 + hstepA, voffA);
            PG8_WAIT_V(8); PG8_WAIT_L(0); PG8_BAR; PG8_MMA(0, 0, At, B0); PG8_MMA(0, 1, At, B1); PG8_BAR; PG8_SCHED;
            PG8_LDA(At, 0, 1); PG8_STAGE(PG8_SB(0, 0), b2, voffB); PG8_STAGE(PG8_SB(0, 1), b2 + hstep, voffB); PG8_STAGE(PG8_SA(0, 0), a2, voffA);
            PG8_WAIT_V(8); PG8_WAIT_L(0); PG8_BAR; PG8_MMA(1, 0, At, B0); PG8_MMA(1, 1, At, B1); PG8_BAR; PG8_SCHED;
            PG8_LDB(B0, 1, 0); PG8_LDB(B1, 1, 1); PG8_SCHED; PG8_LDA(At, 1, 0); PG8_STAGE(PG8_SA(0, 1), a2 + hstepA, voffA);
            PG8_WAIT_V(8); PG8_WAIT_L(0); PG8_BAR; PG8_MMA(0, 0, At, B0); PG8_MMA(0, 1, At, B1); PG8_BAR; PG8_SCHED;
            PG8_LDA(At, 1, 1); PG8_STAGE(PG8_SB(1, 0), b3, voffB); PG8_STAGE(PG8_SB(1, 1), b3 + hstep, voffB); PG8_STAGE(PG8_SA(1, 0), a3, voffA);
            PG8_WAIT_V(8); PG8_WAIT_L(0); PG8_BAR; PG8_MMA(1, 0, At, B0); PG8_MMA(1, 1, At, B1); PG8_BAR; PG8_SCHED;
            } else {
            PG8_LDB(B0, 0, 0); PG8_SCHED; PG8_LDA(At, 0, 0); PG8_STAGE(PG8_SA(1, 1), a1 + hstepA, voffA);
            PG8_WAIT_L(8); PG8_BAR; PG8_WAIT_L(0); PG8_MMA(0, 0, At, B0); PG8_BAR; PG8_SCHED;
            PG8_LDB(B1, 0, 1); PG8_STAGE(PG8_SB(0, 0), b2, voffB);
            PG8_BAR; PG8_WAIT_L(0); PG8_MMA(0, 1, At, B1); PG8_BAR;
            PG8_LDA(At, 0, 1); PG8_STAGE(PG8_SA(0, 0), a2, voffA);
            PG8_BAR; PG8_WAIT_L(0); PG8_MMA(1, 0, At, B0); PG8_BAR; PG8_SCHED;
            PG8_STAGE(PG8_SB(0, 1), b2 + hstep, voffB);
            PG8_WAIT_V(6); PG8_BAR; PG8_MMA(1, 1, At, B1); PG8_BAR;
            PG8_LDB(B0, 1, 0); PG8_SCHED; PG8_LDA(At, 1, 0); PG8_STAGE(PG8_SA(0, 1), a2 + hstepA, voffA);
            PG8_WAIT_L(8); PG8_BAR; PG8_WAIT_L(0); PG8_MMA(0, 0, At, B0); PG8_BAR; PG8_SCHED;
            PG8_LDB(B1, 1, 1); PG8_STAGE(PG8_SB(1, 0), b3, voffB);
            PG8_BAR; PG8_WAIT_L(0); PG8_MMA(0, 1, At, B1); PG8_BAR;
            PG8_LDA(At, 1, 1); PG8_STAGE(PG8_SA(1, 0), a3, voffA);
            PG8_BAR; PG8_WAIT_L(0); PG8_MMA(1, 0, At, B0); PG8_BAR; PG8_SCHED;
            PG8_STAGE(PG8_SB(1, 1), b3 + hstep, voffB);
            PG8_WAIT_V(6); PG8_BAR; PG8_MMA(1, 1, At, B1); PG8_BAR;
            }
        }
        if constexpr (ALIGN_EPI) { if (wr == 0) PG8_BAR; }
        if constexpr (!Epi::AFTER_DRAIN) { E(acc, cur, wr, wc, fr, fq); S.done(cur); }
        if (!has_next) break;
#pragma unroll
        for (int a = 0; a < 2; ++a)
#pragma unroll
            for (int b = 0; b < 2; ++b)
#pragma unroll
                for (int m = 0; m < 4; ++m)
#pragma unroll
                    for (int n = 0; n < 2; ++n) acc[a][b][m][n] = (f32x4){0.f, 0.f, 0.f, 0.f};
        cur = nxt; cA = nA; cB = nB; ++ui;
        if constexpr (ALIGN_EPI) { if (wr == 1) PG8_BAR; }
    }
    PG8_WAIT_V(0);
    if constexpr (!ALIGN_EPI) { if (wr == 0) PG8_BAR; }
    PG8_BAR;
    if constexpr (Epi::AFTER_DRAIN) { E.fused(acc, cur, wr, wc, fr, fq, lds, wid, lane); S.done(cur); }
#undef PG8_SA
#undef PG8_SB
#undef PG8_STAGE
#undef PG8_LDA
#undef PG8_LDB
#undef PG8_MMA
#undef PG8_WAIT_V
#undef PG8_WAIT_L
#undef PG8_BAR
#undef PG8_SCHED
}}

constexpr int NWAVES = 8, NTHREADS = NWAVES * 64;
constexpr int D = 1024, BATCH_P = 8, SEQ_P = 2048, BATCH_S = 128, SEQ_S = 8;
constexpr int MP = BATCH_P * SEQ_P, MS = BATCH_S * SEQ_S, M = MP + MS;
constexpr int NSEQ = BATCH_P + BATCH_S;
constexpr int SCW = 1024, SSMW = 1024, NH = 16, HP = 64, NG = 4, NS = 128, XBC = 2048;
constexpr int NPROJ = 6160, NPROJ_PAD = 6400, PROJ_LD = 6144;
constexpr int C_SCB = 0, C_SCC = 1024, C_SCX = 2048, C_Z = 3072, C_XBC = 4096;
constexpr int C_Y = C_XBC;
constexpr int FF = 2816, NGU = 2 * FF;
constexpr float EPS = 1e-6f;
constexpr size_t O_Y = 0, O_SCP = (size_t)M * D, O_CVP = O_SCP + (size_t)BATCH_P * 2 * SCW, O_SSMP = O_CVP + (size_t)BATCH_P * 3 * XBC,
                 O_SCS = O_SSMP + (size_t)BATCH_P * NH * HP * NS, O_CVS = O_SCS + (size_t)BATCH_S * 2 * SCW, O_SSMS = O_CVS + (size_t)BATCH_S * 3 * XBC,
                 O_END = O_SSMS + (size_t)BATCH_S * NH * HP * NS;
static_assert(O_END == 36765696ull, "output size");
constexpr size_t MiB = 1u << 20;
constexpr size_t WS_CTL = 0, CTL_ZERO_BYTES = 1 * MiB;
constexpr size_t WS_MOD = 1 * MiB;
constexpr size_t WS_WIN = 5 * MiB;
constexpr size_t WS_WOUT = 18 * MiB;
constexpr size_t WS_WGU = 22 * MiB;
constexpr size_t WS_WD = 33 * MiB;
constexpr size_t WS_DT = 38 * MiB + 512 * 1024;
constexpr size_t WS_PROJ = 41 * MiB;
constexpr size_t WS_ACT = 41 * MiB;
constexpr size_t WS_XN2 = 138 * MiB;
constexpr size_t WS_F = 172 * MiB;
constexpr size_t WS_SLAB9 = 204 * MiB;
constexpr size_t WS_END = 256 * MiB;
static_assert(WS_XN2 >= WS_PROJ + (size_t)8192 * PROJ_LD * 2 && WS_PROJ + (size_t)M * PROJ_LD * 2 <= WS_END && WS_ACT + (size_t)M * FF * 2 <= WS_XN2 && WS_XN2 + (size_t)M * D * 2 <= WS_F && WS_F + (size_t)MP * D * 2 <= WS_SLAB9 && WS_SLAB9 + (size_t)11 * MS * D * 4 <= WS_END, "d_ws map");
static_assert(WS_WIN + (size_t)NPROJ_PAD * D * 2 <= WS_WOUT && WS_WD + (size_t)D * FF * 2 <= WS_DT && WS_DT + (size_t)M * 32 * 4 <= WS_PROJ, "d_ws map 2");
constexpr int CW_BAR = 4096;
constexpr int CW_SCAN = 64, CW_TASK = 128;
constexpr int RING_OFF = 0, RING_BYTES = 131072;
constexpr int LDSCTL_OFF = RING_BYTES, MISC_OFF = LDSCTL_OFF + 320;
constexpr int LDS_BYTES = 147456;
static_assert(MISC_OFF + 128 <= LDS_BYTES, "LDS map");

#define GAS __attribute__((address_space(1)))
#define LAS __attribute__((address_space(3)))
typedef unsigned short bf16;
typedef unsigned v4u __attribute__((ext_vector_type(4)));
typedef unsigned v2u __attribute__((ext_vector_type(2)));
typedef float f32x4 __attribute__((ext_vector_type(4)));
typedef GAS unsigned gu32;
#define RLX_AGENT __ATOMIC_RELAXED, __HIP_MEMORY_SCOPE_AGENT
#define LDS_WAIT() asm volatile("s_waitcnt lgkmcnt(0)" ::: "memory")
#define VM_WAIT() asm volatile("s_waitcnt vmcnt(0)" ::: "memory")
__device__ __forceinline__ unsigned f2bf(float f) { unsigned u = __builtin_bit_cast(unsigned, f); return (u + 0x7fffu + ((u >> 16) & 1u)) >> 16; }
typedef float f32x2_t __attribute__((ext_vector_type(2))); typedef __bf16 bf16x2_t __attribute__((ext_vector_type(2)));
__device__ __forceinline__ unsigned pk2(float lo, float hi) { f32x2_t v = {lo, hi}; bf16x2_t b = __builtin_convertvector(v, bf16x2_t); return __builtin_bit_cast(unsigned, b); }
__device__ __forceinline__ float bflo(unsigned u) { return __builtin_bit_cast(float, u << 16); }
__device__ __forceinline__ float bfhi(unsigned u) { return __builtin_bit_cast(float, u & 0xffff0000u); }
__device__ __forceinline__ float bf1(bf16 h) { return __builtin_bit_cast(float, (unsigned)h << 16); }
__device__ __forceinline__ float silu_f(float v) { return v * __builtin_amdgcn_rcpf(1.0f + __builtin_amdgcn_exp2f(-1.4426950408889634f * v)); }
__device__ __forceinline__ float softplus_f(float v) { return v > 20.f ? v : log1pf(__expf(v)); }

#define XB_TMO      128
#define XB_XCNT(j)  (256  + 64 * (j))
#define XB_XSUB(j)  (1280 + 64 * (j))
#define XB_XGEN(j)  (2304 + 64 * (j))
#define XB_TOP      3328
#define XB_TOPGEN   3392
#define XCD_BAR_WORDS 3456
#define XB_SPIN_CAP (1u << 18)
__device__ __forceinline__ unsigned xb_ld(unsigned* p)              { return __hip_atomic_load(p, __ATOMIC_RELAXED, __HIP_MEMORY_SCOPE_AGENT); }
__device__ __forceinline__ unsigned xb_add(unsigned* p, unsigned v) { return __hip_atomic_fetch_add(p, v, __ATOMIC_RELAXED, __HIP_MEMORY_SCOPE_AGENT); }
__device__ __forceinline__ unsigned xb_xcc_id() { return (unsigned)__builtin_amdgcn_s_getreg((3 << 11) | 20) & 0xFu; }
#define XB_SPIN(cond, bar) do { unsigned _sp = 0; while (cond) { __builtin_amdgcn_s_sleep(1); \
    if ((++_sp & 255u) == 0u) { if (xb_ld(&(bar)[XB_TMO])) break; if (_sp > XB_SPIN_CAP) { atomicAdd(&(bar)[XB_TMO], 1u); break; } } } } while (0)
struct XcdBarrier { unsigned* bar; unsigned x; volatile LAS unsigned* st; };
__device__ __forceinline__ XcdBarrier xcd_barrier_post(unsigned* bar, volatile LAS unsigned* st) {
    XcdBarrier b; b.bar = bar; b.x = xb_xcc_id(); b.st = st;
    if (threadIdx.x == 0) (void)xb_add(&bar[XB_XCNT(b.x)], 1u);
    return b;
}
__device__ __forceinline__ void xcd_barrier_complete(unsigned* bar, unsigned x, unsigned& nloc, unsigned& nx) {
    const unsigned G = gridDim.x * gridDim.y * gridDim.z;
    unsigned sum, cnt, mine, sp = 0u;
    for (;;) {
        sum = 0u; cnt = 0u; mine = 0u;
#pragma unroll
        for (unsigned j = 0; j < 16; ++j) { const unsigned c = xb_ld(&bar[XB_XCNT(j)]); sum += c; cnt += (c > 0u) ? 1u : 0u; mine = (j == x) ? c : mine; }
        if (sum == G) break;
        __builtin_amdgcn_s_sleep(1);
        if ((++sp & 255u) == 0u) { if (xb_ld(&bar[XB_TMO])) break; if (sp > XB_SPIN_CAP) { atomicAdd(&bar[XB_TMO], 1u); break; } }
    }
    nloc = mine > 0u ? mine : 1u; nx = cnt > 0u ? cnt : 1u;
}
__device__ __forceinline__ void xcd_barrier(const XcdBarrier& b) {
    asm volatile("s_waitcnt vmcnt(0)" ::: "memory");
    __syncthreads();
    if (threadIdx.x == 0) {
        unsigned* bar = b.bar;
        __builtin_amdgcn_s_waitcnt(0);
        unsigned nloc = b.st[0], nx = b.st[1];
        if (nloc == 0u) { xcd_barrier_complete(bar, b.x, nloc, nx); b.st[0] = nloc; b.st[1] = nx; }
        const unsigned old = xb_add(&bar[XB_XSUB(b.x)], 1u);
        const unsigned gen = old / nloc;
        if (old + 1u == (gen + 1u) * nloc) {
            __builtin_amdgcn_fence(__ATOMIC_RELEASE, "agent");
            asm volatile("s_waitcnt vmcnt(0)" ::: "memory");
            const unsigned og = xb_add(&bar[XB_TOP], 1u);
            const unsigned tg = og / nx;
            if (og + 1u == (tg + 1u) * nx) xb_add(&bar[XB_TOPGEN], 1u);
            else XB_SPIN(xb_ld(&bar[XB_TOPGEN]) == tg, bar);
            __builtin_amdgcn_fence(__ATOMIC_ACQUIRE, "agent");
            xb_add(&bar[XB_XGEN(b.x)], 1u);
            asm volatile("s_waitcnt vmcnt(0)" ::: "memory");
        } else {
            XB_SPIN(xb_ld(&bar[XB_XGEN(b.x)]) == gen, bar);
            __builtin_amdgcn_fence(__ATOMIC_ACQUIRE, "agent");
            asm volatile("s_waitcnt vmcnt(0)" ::: "memory");
        }
    }
    __syncthreads();
}

struct Args { const float* in[25]; float* out; unsigned char* ws; int ph_lo, ph_hi; };
struct Frame {
    LAS unsigned char* lds;
    volatile LAS unsigned* MISC;
    gu32* ctl;
    int tid, lane, wave, G;
    const float *x_p, *x_s, *c_p, *c_s, *st_sc, *st_cv, *st_ssm, *w_ada, *b_ada, *g_mpre, *g_mpost, *g_fpre, *g_fpost, *w_in, *sc_w, *cv_w, *cv_b, *dt_bias, *a_log, *d_skip, *ssm_g, *w_out, *w_gate, *w_up, *w_down;
    float* out;
    float* mod; bf16 *Win_t, *Wout_t, *Wgu_t, *Wd_t; float* dtb; bf16 *proj, *act, *xn2; bf16* fbuf; float *slab6, *slab9;
    bf16* xn1;
    bf16* xbcc;
    float* x1;
};
__device__ __forceinline__ float wave_sum(float v) {
#pragma unroll
    for (int o = 1; o < 64; o <<= 1) v += __shfl_xor(v, o);
    return v;
}
__device__ __forceinline__ const float* x_row(const Frame& F, int m) { return m < MP ? F.x_p + (size_t)m * D : F.x_s + (size_t)(m - MP) * D; }
__device__ __forceinline__ int seq_of(int m) { return m < MP ? (m >> 11) : BATCH_P + ((m - MP) >> 3); }

__device__ __forceinline__ void p0_transpose_item(const float* __restrict__ W, int K, int N, int nblk, bf16* __restrict__ WT, int mode, LAS float* scr, int item, int lane) {
    const int kb = item / nblk, nb = item % nblk, k0 = 64 * kb, n0 = 32 * nb;
    const int nn = n0 + (lane & 31); const bool ok = nn < N; const float* src = W + (size_t)(k0 + (lane >> 5)) * N + (ok ? nn : 0);
    float v[32];
#pragma unroll
    for (int i = 0; i < 32; ++i) v[i] = src[(size_t)(2 * i) * N];
#pragma unroll
    for (int i = 0; i < 32; ++i) scr[(2 * i + (lane >> 5)) * 33 + (lane & 31)] = ok ? v[i] : 0.f;
    LDS_WAIT(); asm volatile("" ::: "memory");
    const int c = lane & 7;
    const int r0 = mode == 0 ? n0 : ((n0 >> 7) * 256 + (n0 & 127) + (mode == 2 ? 128 : 0));
#pragma unroll
    for (int j = 0; j < 4; ++j) { const int n = (lane >> 3) + 8 * j; const LAS float* s = scr + (8 * c) * 33 + n;
        v4u o; o.x = pk2(s[0 * 33], s[1 * 33]); o.y = pk2(s[2 * 33], s[3 * 33]); o.z = pk2(s[4 * 33], s[5 * 33]); o.w = pk2(s[6 * 33], s[7 * 33]);
        *(v4u*)(WT + (size_t)(r0 + n) * K + k0 + 8 * c) = o; }
    LDS_WAIT(); asm volatile("" ::: "memory");
}
__device__ __forceinline__ void p0_prologue(Frame& F) {
    {
        typedef float f32x16a __attribute__((ext_vector_type(16))); typedef short bf16x8a __attribute__((ext_vector_type(8)));
        constexpr int AS = 2064;
        LAS unsigned char* L = F.lds + RING_OFF;
        const int r32 = F.lane & 31, hh = F.lane >> 5, nt = F.wave & 3, kh = F.wave >> 2;
        for (int it = blockIdx.x; it < 5 * 48; it += F.G) {
            const int mt = it / 48, j0 = (it % 48) * 128;
            { const int sl = F.tid >> 4, kq = (F.tid & 15) * 64, s = 32 * mt + sl;
              const float* cp = s < BATCH_P ? F.c_p + (size_t)s * D : F.c_s + (size_t)((s < NSEQ ? s : NSEQ - 1) - BATCH_P) * D;
              f32x4 cv[16];
#pragma unroll
              for (int i = 0; i < 16; ++i) cv[i] = *(const f32x4*)(cp + kq + 4 * i);
#pragma unroll
              for (int i = 0; i < 8; ++i) { const f32x4 a = cv[2 * i], c2 = cv[2 * i + 1]; v4u o;
                  o.x = pk2(silu_f(a.x), silu_f(a.y)); o.y = pk2(silu_f(a.z), silu_f(a.w)); o.z = pk2(silu_f(c2.x), silu_f(c2.y)); o.w = pk2(silu_f(c2.z), silu_f(c2.w));
                  if (s >= NSEQ) o = (v4u){0u, 0u, 0u, 0u};
                  *(LAS v4u*)(L + sl * AS + (kq + 8 * i) * 2) = o; } }
            LDS_WAIT(); __syncthreads();
            f32x16a acc;
#pragma unroll
            for (int i = 0; i < 16; ++i) acc[i] = 0.f;
            const float* wp = F.w_ada + (size_t)(512 * kh + 8 * hh) * 6144 + j0 + 32 * nt + r32;
#pragma unroll 4
            for (int ks = 0; ks < 32; ++ks) {
                float wv[8];
#pragma unroll
                for (int e2 = 0; e2 < 8; ++e2) wv[e2] = wp[(size_t)(16 * ks + e2) * 6144];
                pg8::u32x4 bw; bw.x = pk2(wv[0], wv[1]); bw.y = pk2(wv[2], wv[3]); bw.z = pk2(wv[4], wv[5]); bw.w = pk2(wv[6], wv[7]);
                const bf16x8a af = *(const LAS bf16x8a*)(L + r32 * AS + (512 * kh + 16 * ks + 8 * hh) * 2);
                acc = __builtin_amdgcn_mfma_f32_32x32x16_bf16(af, __builtin_bit_cast(bf16x8a, bw), acc, 0, 0, 0);
            }
            LAS float* red = (LAS float*)(L + 32 * AS);
            if (kh == 1) {
#pragma unroll
                for (int i = 0; i < 16; ++i) red[(nt * 16 + i) * 64 + F.lane] = acc[i]; }
            LDS_WAIT(); __syncthreads();
            if (kh == 0) {
                const float bj = F.b_ada[j0 + 32 * nt + r32];
#pragma unroll
                for (int i = 0; i < 16; ++i) { const int s = 32 * mt + (i & 3) + 8 * (i >> 2) + 4 * hh;
                    if (s < NSEQ) F.mod[(size_t)s * 6144 + j0 + 32 * nt + r32] = acc[i] + red[(nt * 16 + i) * 64 + F.lane] + bj; } }
            __syncthreads();
        }
    }
    LAS float* scr = (LAS float*)(F.lds + RING_OFF + F.wave * 16384);
    const int gw = blockIdx.x * NWAVES + F.wave, NGW = F.G * NWAVES;
    constexpr int I_IN = (D / 64) * (NPROJ_PAD / 32);
    for (int it = gw; it < I_IN; it += NGW) p0_transpose_item(F.w_in, D, NPROJ, NPROJ_PAD / 32, F.Win_t, 0, scr, it, F.lane);
}
constexpr int LW_OUT = (2048 / 64) * (D / 32), LW_G = (D / 64) * (FF / 32), LW_D = (FF / 64) * (D / 32), LW_ITEMS = LW_OUT + 2 * LW_G + LW_D;
__device__ __forceinline__ void late_weight_item(Frame& F, int r, LAS float* scr) {
    if (r < LW_OUT) { p0_transpose_item(F.w_out, 2048, D, D / 32, F.Wout_t, 0, scr, r, F.lane); return; } r -= LW_OUT;
    if (r < LW_G) { p0_transpose_item(F.w_gate, D, FF, FF / 32, F.Wgu_t, 1, scr, r, F.lane); return; } r -= LW_G;
    if (r < LW_G) { p0_transpose_item(F.w_up, D, FF, FF / 32, F.Wgu_t, 2, scr, r, F.lane); return; } r -= LW_G;
    p0_transpose_item(F.w_down, FF, D, D / 32, F.Wd_t, 0, scr, r, F.lane);
}
constexpr int NGRP = M / 4;
struct Vec16 { f32x4 v[4]; };
__device__ __forceinline__ void ldvec(const float* __restrict__ p, int lane, Vec16& o) {
#pragma unroll
    for (int j = 0; j < 4; ++j) o.v[j] = *((const f32x4*)p + lane + 64 * j);
}
__device__ __forceinline__ float sumsq16(const Vec16& a) { float s = 0.f;
#pragma unroll
    for (int j = 0; j < 4; ++j) s += (a.v[j].x * a.v[j].x + a.v[j].y * a.v[j].y) + (a.v[j].z * a.v[j].z + a.v[j].w * a.v[j].w);
    return s; }
__device__ __forceinline__ void st_bf16_row(bf16* __restrict__ row, int lane, const Vec16& h) {
    unsigned long long* o8 = (unsigned long long*)row + lane;
#pragma unroll
    for (int j = 0; j < 4; ++j) o8[64 * j] = (unsigned long long)pk2(h.v[j].x, h.v[j].y) | ((unsigned long long)pk2(h.v[j].z, h.v[j].w) << 32);
}
__device__ __forceinline__ void p1_hrows(Frame& F) {
    const int gw = blockIdx.x * NWAVES + F.wave, NGW = F.G * NWAVES;
    Vec16 g; ldvec(F.g_mpre, F.lane, g);
    for (int gi = gw; gi < NGRP; gi += NGW) {
        const int m0 = 4 * gi; const float* md = F.mod + (size_t)seq_of(m0) * 6144;
        Vec16 x[4], sh, sc;
#pragma unroll
        for (int r = 0; r < 4; ++r) ldvec(x_row(F, m0 + r), F.lane, x[r]);
        ldvec(md, F.lane, sh); ldvec(md + 1024, F.lane, sc);
#pragma unroll
        for (int r = 0; r < 4; ++r) { const float rstd = 1.0f / sqrtf(wave_sum(sumsq16(x[r])) * (1.f / D) + EPS); Vec16 h;
#pragma unroll
            for (int j = 0; j < 4; ++j) h.v[j] = (x[r].v[j] * rstd) * g.v[j] * (sc.v[j] + 1.0f) + sh.v[j];
            st_bf16_row(F.xn1 + (size_t)(m0 + r) * D, F.lane, h); }
    }
}
__device__ __forceinline__ void unpack8(const v4u q, float (&f)[8]) { f[0] = bflo(q.x); f[1] = bfhi(q.x); f[2] = bflo(q.y); f[3] = bfhi(q.y); f[4] = bflo(q.z); f[5] = bfhi(q.z); f[6] = bflo(q.w); f[7] = bfhi(q.w); }
__device__ __forceinline__ void ld8f(const float* p, float (&f)[8]) { const f32x4 a = *(const f32x4*)p, b = *(const f32x4*)(p + 4); f[0] = a.x; f[1] = a.y; f[2] = a.z; f[3] = a.w; f[4] = b.x; f[5] = b.y; f[6] = b.z; f[7] = b.w; }
__device__ __forceinline__ void st8f(float* p, const float (&f)[8]) { *(f32x4*)p = (f32x4){f[0], f[1], f[2], f[3]}; *(f32x4*)(p + 4) = (f32x4){f[4], f[5], f[6], f[7]}; }
__device__ __forceinline__ void sc_conv_item(Frame& F, int qd, int ch) {
    const int r0 = 4 * qd;
    int b, t0, L; bool samp;
    if (r0 < MP) { b = r0 >> 11; t0 = r0 & 2047; L = SEQ_P; samp = false; } else { const int rr = r0 - MP; b = rr >> 3; t0 = rr & 7; L = SEQ_S; samp = true; }
    const bf16* prow = F.proj + (size_t)r0 * PROJ_LD;
    const bool first = (t0 == 0), lastq = (t0 == L - 4);
    const int c0 = ch * 8;
        v4u qc[6], qx[6], qb[4];
#pragma unroll
        for (int k = 0; k < 6; ++k) { const bf16* pr = prow + (ptrdiff_t)((k < 2 && first) ? 0 : k - 2) * PROJ_LD; qc[k] = *(const v4u*)(pr + C_SCC + c0); qx[k] = *(const v4u*)(pr + C_SCX + c0); }
#pragma unroll
        for (int k = 0; k < 4; ++k) qb[k] = *(const v4u*)(prow + (size_t)k * PROJ_LD + C_SCB + c0);
        float w[3][8];
#pragma unroll
        for (int j = 0; j < 3; ++j) ld8f(F.sc_w + (size_t)j * SCW + c0, w[j]);
        float sbuf[2][8];
#pragma unroll
        for (int k = 0; k < 2; ++k) ld8f(F.st_sc + ((size_t)b * 2 + k) * SCW + c0, sbuf[k]);
        asm volatile("" ::: "memory");
        float u[6][8];
#pragma unroll
        for (int k = 0; k < 6; ++k) {
            float cc[8], xx[8]; unpack8(qc[k], cc); unpack8(qx[k], xx);
#pragma unroll
            for (int i = 0; i < 8; ++i) u[k][i] = cc[i] * xx[i];
            if (k < 2) {
#pragma unroll
                for (int i = 0; i < 8; ++i) u[k][i] = first ? (samp ? sbuf[k][i] : 0.f) : u[k][i]; } }
        if (lastq) { float* op = F.out + (samp ? O_SCS : O_SCP) + ((size_t)b * 2) * SCW + c0; st8f(op, u[4]); st8f(op + SCW, u[5]); }
#pragma unroll
        for (int i4 = 0; i4 < 4; ++i4) { float bb[8]; unpack8(qb[i4], bb); float o[8];
#pragma unroll
            for (int i = 0; i < 8; ++i) o[i] = bb[i] * (w[0][i] * u[i4][i] + w[1][i] * u[i4 + 1][i] + w[2][i] * u[i4 + 2][i]);
            v4u ov; ov.x = pk2(o[0], o[1]); ov.y = pk2(o[2], o[3]); ov.z = pk2(o[4], o[5]); ov.w = pk2(o[6], o[7]);
            *(v4u*)(F.proj + (size_t)(r0 + i4) * PROJ_LD + C_SCB + c0) = ov; }
}
__device__ __forceinline__ void xbc_conv_item(Frame& F, int qd, int chx) {
    const int r0 = 4 * qd;
    int b, t0, L; bool samp;
    if (r0 < MP) { b = r0 >> 11; t0 = r0 & 2047; L = SEQ_P; samp = false; } else { const int rr = r0 - MP; b = rr >> 3; t0 = rr & 7; L = SEQ_S; samp = true; }
    const bf16* prow = F.proj + (size_t)r0 * PROJ_LD;
    const bool first = (t0 == 0), lastq = (t0 == L - 4);
    const int c0 = chx * 8;
        v4u qv[7];
#pragma unroll
        for (int k = 0; k < 7; ++k) qv[k] = *(const v4u*)(prow + (ptrdiff_t)((k < 3 && first) ? 0 : k - 3) * PROJ_LD + C_XBC + c0);
        float w[4][8], bias[8];
#pragma unroll
        for (int j = 0; j < 4; ++j) ld8f(F.cv_w + (size_t)j * XBC + c0, w[j]);
        ld8f(F.cv_b + c0, bias);
        float sbuf[3][8];
#pragma unroll
        for (int k = 0; k < 3; ++k) ld8f(F.st_cv + ((size_t)b * 3 + k) * XBC + c0, sbuf[k]);
        asm volatile("" ::: "memory");
        float xe[7][8];
#pragma unroll
        for (int k = 0; k < 7; ++k) {
            unpack8(qv[k], xe[k]);
            if (k < 3) {
#pragma unroll
                for (int i = 0; i < 8; ++i) xe[k][i] = first ? (samp ? sbuf[k][i] : 0.f) : xe[k][i]; } }
        if (lastq) { float* op = F.out + (samp ? O_CVS : O_CVP) + ((size_t)b * 3) * XBC + c0; st8f(op, xe[4]); st8f(op + XBC, xe[5]); st8f(op + 2 * XBC, xe[6]); }
#pragma unroll
        for (int i4 = 0; i4 < 4; ++i4) { float o[8];
#pragma unroll
            for (int i = 0; i < 8; ++i) o[i] = silu_f(bias[i] + w[0][i] * xe[i4][i] + w[1][i] * xe[i4 + 1][i] + w[2][i] * xe[i4 + 2][i] + w[3][i] * xe[i4 + 3][i]);
            v4u ov; ov.x = pk2(o[0], o[1]); ov.y = pk2(o[2], o[3]); ov.z = pk2(o[4], o[5]); ov.w = pk2(o[6], o[7]);
            *(v4u*)(F.xbcc + (size_t)(r0 + i4) * XBC + c0) = ov; }
}
__device__ __forceinline__ void p3_conv(Frame& F) {
    const int total = (M / 4) * 256;
    for (int idx = blockIdx.x * NTHREADS + F.tid; idx < total; idx += F.G * NTHREADS) xbc_conv_item(F, idx >> 8, idx & 255);
}
__device__ __forceinline__ void scan_item(Frame& F, int s, int h) {
    const int p = F.tid >> 3, nq = F.tid & 7, g = h >> 2;
    const bool samp = s >= BATCH_P; const int b = samp ? s - BATCH_P : s; const int L = samp ? SEQ_S : SEQ_P; const int row0 = samp ? MP + b * SEQ_S : b * SEQ_P;
    float S[16];
    if (samp) { const float* sp = F.st_ssm + (((size_t)b * NH + h) * HP + p) * NS + nq * 16;
#pragma unroll
        for (int i = 0; i < 4; ++i) { const f32x4 a = *(const f32x4*)(sp + 4 * i); S[4 * i] = a.x; S[4 * i + 1] = a.y; S[4 * i + 2] = a.z; S[4 * i + 3] = a.w; } }
    else {
#pragma unroll
        for (int i = 0; i < 16; ++i) S[i] = 0.f; }
    const float Dh = F.d_skip[h];
    for (int t0 = 0; t0 < L; t0 += 8) {
        v4u Bq[8][2], Cq[8][2]; float xv[8], dtv[8], a2v[8];
#pragma unroll
        for (int u = 0; u < 8; ++u) { const int r = row0 + t0 + u; const bf16* xr = F.xbcc + (size_t)r * XBC;
            Bq[u][0] = *(const v4u*)(xr + 1024 + g * NS + nq * 16); Bq[u][1] = *(const v4u*)(xr + 1024 + g * NS + nq * 16 + 8);
            Cq[u][0] = *(const v4u*)(xr + 1536 + g * NS + nq * 16); Cq[u][1] = *(const v4u*)(xr + 1536 + g * NS + nq * 16 + 8);
            xv[u] = bf1(xr[h * HP + p]); dtv[u] = F.dtb[(size_t)r * 32 + h]; a2v[u] = F.dtb[(size_t)r * 32 + 16 + h]; }
#pragma unroll
        for (int u = 0; u < 8; ++u) {
            const float dt = dtv[u], dA = __builtin_amdgcn_exp2f(a2v[u]), xdt = dt * xv[u];
            float Bf[16], Cf[16]; { float t8[8]; unpack8(Bq[u][0], t8);
#pragma unroll
                for (int i = 0; i < 8; ++i) Bf[i] = t8[i];
                unpack8(Bq[u][1], t8);
#pragma unroll
                for (int i = 0; i < 8; ++i) Bf[8 + i] = t8[i];
                unpack8(Cq[u][0], t8);
#pragma unroll
                for (int i = 0; i < 8; ++i) Cf[i] = t8[i];
                unpack8(Cq[u][1], t8);
#pragma unroll
                for (int i = 0; i < 8; ++i) Cf[8 + i] = t8[i]; }
            float y = 0.f;
#pragma unroll
            for (int i = 0; i < 16; ++i) { S[i] = S[i] * dA + xdt * Bf[i]; y += Cf[i] * S[i]; }
            y += __shfl_xor(y, 1); y += __shfl_xor(y, 2); y += __shfl_xor(y, 4);
            y += Dh * xv[u];
            if (nq == 0) F.proj[(size_t)(row0 + t0 + u) * PROJ_LD + C_Y + h * HP + p] = (bf16)f2bf(y);
        }
    }
    float* op = F.out + (samp ? O_SSMS : O_SSMP) + (((size_t)b * NH + h) * HP + p) * NS + nq * 16;
#pragma unroll
    for (int i = 0; i < 4; ++i) *(f32x4*)(op + 4 * i) = (f32x4){S[4 * i], S[4 * i + 1], S[4 * i + 2], S[4 * i + 3]};
}
typedef float f32x16 __attribute__((ext_vector_type(16)));
typedef short bf16x8 __attribute__((ext_vector_type(8)));
constexpr int SSD_Q = 128, SSD_NC = SEQ_P / SSD_Q;
constexpr int SB_STRIDE = 272, SX_STRIDE = 144;
constexpr int L_BS = 0, L_CS = L_BS + SSD_Q * SB_STRIDE, L_XS = L_CS + SSD_Q * SB_STRIDE, L_SB = L_XS + SSD_Q * SX_STRIDE, L_A2 = L_SB + 2 * 16384, L_LA2 = L_A2 + 512, L_PS = L_LA2 + 512, L_WL = L_PS + 512, L_QL = L_WL + 512, L_TT = L_QL + 512, L_SSD_END = L_TT + 64;
static_assert(L_SSD_END <= RING_BYTES, "SSD LDS map");
constexpr float LOG2E = 1.4426950408889634f;
__device__ __forceinline__ void pack_tile(const f32x16& x, bf16x8 (&f)[2]) {
#pragma unroll
    for (int s = 0; s < 2; ++s) { pg8::u32x4 w;
#pragma unroll
        for (int k = 0; k < 4; ++k) w[k] = pk2(x[8 * s + 2 * k], x[8 * s + 2 * k + 1]);
        f[s] = __builtin_bit_cast(bf16x8, w); }
}
__device__ __forceinline__ void ssd_prompt_item(Frame& F, int b, int h) {
    LAS unsigned char* L = F.lds + RING_OFF;
    const int tid = F.tid, lane = F.lane, wid = F.wave, r32 = lane & 31, hh = lane >> 5;
    const int pt = wid >> 2, jj = wid & 3, j = pt ? 3 - jj : jj, q = jj, g = h >> 2;
    const float Dh = F.d_skip[h];
    bf16x8 Id[2];
#pragma unroll
    for (int ks = 0; ks < 2; ++ks)
#pragma unroll
        for (int e = 0; e < 8; ++e) Id[ks][e] = (16 * ks + 8 * hh + e == r32) ? (short)0x3F80 : (short)0;
    for (int i = tid; i < 16384 / 16; i += NTHREADS) *(LAS v4u*)(L + L_SB + i * 16) = (v4u){0u, 0u, 0u, 0u};
    f32x16 S;
#pragma unroll
    for (int i = 0; i < 16; ++i) S[i] = 0.f;
    const bf16* xb = F.xbcc + (size_t)(b * SEQ_P) * XBC;
    const float* dtr = F.dtb + (size_t)(b * SEQ_P) * 32 + h;
    v4u pB[4], pC[4], pX[2]; float pd0 = 0.f, pd1 = 0.f, pa0 = 0.f, pa1 = 0.f;
#define SSD_LOAD(c) do { const bf16* xc = xb + (size_t)(c) * SSD_Q * XBC; \
        _Pragma("unroll") for (int k = 0; k < 4; ++k) { const int qq = tid + NTHREADS * k, row = qq >> 4, ch = qq & 15; \
            pB[k] = *(const v4u*)(xc + (size_t)row * XBC + 1024 + g * NS + ch * 8); pC[k] = *(const v4u*)(xc + (size_t)row * XBC + 1536 + g * NS + ch * 8); } \
        _Pragma("unroll") for (int k = 0; k < 2; ++k) { const int qq = tid + NTHREADS * k, row = qq >> 3, ch = qq & 7; pX[k] = *(const v4u*)(xc + (size_t)row * XBC + h * HP + ch * 8); } \
        if (wid == 0) { const float* dp_ = dtr + (size_t)((c) * SSD_Q + 2 * lane) * 32; pd0 = dp_[0]; pa0 = dp_[16]; pd1 = dp_[32]; pa1 = dp_[48]; } } while (0)
    SSD_LOAD(0);
    for (int c = 0; c < SSD_NC; ++c) {
#pragma unroll
        for (int k = 0; k < 4; ++k) { const int qq = tid + NTHREADS * k, row = qq >> 4, ch = qq & 15;
            *(LAS v4u*)(L + L_BS + row * SB_STRIDE + ch * 16) = pB[k]; *(LAS v4u*)(L + L_CS + row * SB_STRIDE + ch * 16) = pC[k]; }
#pragma unroll
        for (int k = 0; k < 2; ++k) { const int qq = tid + NTHREADS * k, row = qq >> 3, ch = qq & 7; *(LAS v4u*)(L + L_XS + row * SX_STRIDE + ch * 16) = pX[k]; }
        if (wid == 0) {
            const float d0 = pd0, d1 = pd1, a0 = pa0, a1 = pa1;
            float pfx = a0 + a1;
#pragma unroll
            for (int o = 1; o < 64; o <<= 1) { const float t = __shfl_up(pfx, o); if (lane >= o) pfx += t; }
            const float c1 = pfx, c0 = pfx - a1;
            const float ce = __shfl(c1, (lane & 48) + 15), cs = __shfl(c0, lane & 48), cend = __shfl(c1, 63);
            *(LAS float*)(L + L_A2 + (2 * lane) * 4) = c0; *(LAS float*)(L + L_A2 + (2 * lane + 1) * 4) = c1;
            *(LAS float*)(L + L_LA2 + (2 * lane) * 4) = c0 - __log2f(d0); *(LAS float*)(L + L_LA2 + (2 * lane + 1) * 4) = c1 - __log2f(d1);
            *(LAS float*)(L + L_PS + (2 * lane) * 4) = d0 * __builtin_amdgcn_exp2f(ce - c0); *(LAS float*)(L + L_PS + (2 * lane + 1) * 4) = d1 * __builtin_amdgcn_exp2f(ce - c1);
            *(LAS float*)(L + L_QL + (2 * lane) * 4) = __builtin_amdgcn_exp2f(c0 - cs); *(LAS float*)(L + L_QL + (2 * lane + 1) * 4) = __builtin_amdgcn_exp2f(c1 - cs);
            *(LAS float*)(L + L_WL + (2 * lane) * 4) = d0 * __builtin_amdgcn_exp2f(cend - c0); *(LAS float*)(L + L_WL + (2 * lane + 1) * 4) = d1 * __builtin_amdgcn_exp2f(cend - c1);
            { const int ti = (lane >> 2) & 3, tj = lane & 3; const float ei = __shfl(c1, 16 * ti + 15), sj = __shfl(c0, 16 * tj);
              if (lane < 16) *(LAS float*)(L + L_TT + lane * 4) = (ti < tj) ? __builtin_amdgcn_exp2f(sj - ei) : 0.f; }
        }
        LDS_WAIT(); __syncthreads();
        if (c + 1 < SSD_NC) SSD_LOAD(c + 1);
        LAS unsigned char* SBc = L + L_SB + (c & 1) * 16384; LAS unsigned char* SBn = L + L_SB + ((c + 1) & 1) * 16384;
        const float a2end = *(LAS float*)(L + L_A2 + 127 * 4);
#define SSD_T1(i, dst) do { f32x16 acc_; _Pragma("unroll") for (int e = 0; e < 16; ++e) acc_[e] = 0.f; \
            _Pragma("unroll") for (int ks = 0; ks < 2; ++ks) { const bf16x8 a_ = *(const LAS bf16x8*)(L + L_XS + (32 * (i) + r32) * SX_STRIDE + (32 * pt + 16 * ks + 8 * hh) * 2); \
                acc_ = __builtin_amdgcn_mfma_f32_32x32x16_bf16(a_, Id[ks], acc_, 0, 0, 0); } \
            pack_tile(acc_, dst); } while (0)
        const int lrow = 32 * j + r32; const float a2l = *(LAS float*)(L + L_A2 + lrow * 4), ql = *(LAS float*)(L + L_QL + lrow * 4);
        f32x16 Y;
#pragma unroll
        for (int e = 0; e < 16; ++e) Y[e] = 0.f;
#pragma unroll
        for (int qq = 0; qq < 4; ++qq)
#pragma unroll
            for (int s = 0; s < 2; ++s) { const bf16x8 a = *(const LAS bf16x8*)(SBc + ((qq * 2 + pt) * 2 + s) * 1024 + lane * 16);
                const LAS unsigned char* cp = L + L_CS + lrow * SB_STRIDE + (32 * qq + 16 * s + 4 * hh) * 2;
                const v2u c0 = *(const LAS v2u*)cp, c1 = *(const LAS v2u*)(cp + 16);
                const bf16x8 bb = __builtin_bit_cast(bf16x8, ((v4u){c0.x, c0.y, c1.x, c1.y}));
                Y = __builtin_amdgcn_mfma_f32_32x32x16_bf16(a, bb, Y, 0, 0, 0); }
        { const float el = __builtin_amdgcn_exp2f(a2l);
#pragma unroll
            for (int e = 0; e < 16; ++e) Y[e] *= el; }
        for (int i = 0; i <= j; ++i) {
            bf16x8 t1[2]; SSD_T1(i, t1);
            f32x16 X;
#pragma unroll
            for (int e = 0; e < 16; ++e) X[e] = 0.f;
#pragma unroll
            for (int ks = 0; ks < 8; ++ks) { const bf16x8 a = *(const LAS bf16x8*)(L + L_BS + (32 * i + r32) * SB_STRIDE + (16 * ks + 8 * hh) * 2);
                const bf16x8 bb = *(const LAS bf16x8*)(L + L_CS + lrow * SB_STRIDE + (16 * ks + 8 * hh) * 2);
                X = __builtin_amdgcn_mfma_f32_32x32x16_bf16(a, bb, X, 0, 0, 0); }
            if (i == j) {
#pragma unroll
                for (int rg = 0; rg < 4; ++rg) { const int sb = 32 * i + 8 * rg + 4 * hh; const f32x4 la = *(const LAS f32x4*)(L + L_LA2 + sb * 4);
#pragma unroll
                    for (int e = 0; e < 4; ++e) { const int s = sb + e; float v = X[4 * rg + e] * __builtin_amdgcn_exp2f(a2l - la[e]); v = (s <= lrow) ? v : 0.f; v += (s == lrow) ? Dh : 0.f; X[4 * rg + e] = v; } }
            } else { const float qt = ql * *(const LAS float*)(L + L_TT + (i * 4 + j) * 4);
#pragma unroll
                for (int rg = 0; rg < 4; ++rg) { const int sb = 32 * i + 8 * rg + 4 * hh; const f32x4 ps = *(const LAS f32x4*)(L + L_PS + sb * 4);
#pragma unroll
                    for (int e = 0; e < 4; ++e) X[4 * rg + e] *= qt * ps[e]; } }
            bf16x8 xf[2]; pack_tile(X, xf);
#pragma unroll
            for (int s = 0; s < 2; ++s) Y = __builtin_amdgcn_mfma_f32_32x32x16_bf16(t1[s], xf[s], Y, 0, 0, 0);
        }
        { bf16* yrow = F.proj + (size_t)(b * SEQ_P + c * SSD_Q + lrow) * PROJ_LD + C_Y + h * HP + 32 * pt + 4 * hh;
#pragma unroll
            for (int rg = 0; rg < 4; ++rg) { v2u o; o.x = pk2(Y[4 * rg], Y[4 * rg + 1]); o.y = pk2(Y[4 * rg + 2], Y[4 * rg + 3]); *(v2u*)(yrow + 8 * rg) = o; } }
        { const float dec = __builtin_amdgcn_exp2f(a2end);
#pragma unroll
            for (int e = 0; e < 16; ++e) S[e] *= dec; }
        for (int i = 0; i < 4; ++i) {
            bf16x8 t1[2]; SSD_T1(i, t1);
            f32x16 acc;
#pragma unroll
            for (int e = 0; e < 16; ++e) acc[e] = 0.f;
#pragma unroll
            for (int ks = 0; ks < 2; ++ks) { const bf16x8 a = *(const LAS bf16x8*)(L + L_BS + (32 * i + r32) * SB_STRIDE + (32 * q + 16 * ks + 8 * hh) * 2);
                acc = __builtin_amdgcn_mfma_f32_32x32x16_bf16(a, Id[ks], acc, 0, 0, 0); }
#pragma unroll
            for (int rg = 0; rg < 4; ++rg) { const int sb = 32 * i + 8 * rg + 4 * hh; const f32x4 wl = *(const LAS f32x4*)(L + L_WL + sb * 4);
#pragma unroll
                for (int e = 0; e < 4; ++e) acc[4 * rg + e] *= wl[e]; }
            bf16x8 t2[2]; pack_tile(acc, t2);
#pragma unroll
            for (int s = 0; s < 2; ++s) S = __builtin_amdgcn_mfma_f32_32x32x16_bf16(t2[s], t1[s], S, 0, 0, 0);
        }
        if (c + 1 < SSD_NC) { bf16x8 sf[2]; pack_tile(S, sf);
#pragma unroll
            for (int s = 0; s < 2; ++s) *(LAS bf16x8*)(SBn + ((q * 2 + pt) * 2 + s) * 1024 + lane * 16) = sf[s]; }
        else { float* op = F.out + O_SSMP + (((size_t)b * NH + h) * HP + 32 * pt + r32) * NS + 32 * q + 4 * hh;
#pragma unroll
            for (int rg = 0; rg < 4; ++rg) *(f32x4*)(op + 8 * rg) = (f32x4){S[4 * rg], S[4 * rg + 1], S[4 * rg + 2], S[4 * rg + 3]}; }
        LDS_WAIT(); __syncthreads();
    }
#undef SSD_LOAD
#undef SSD_T1
}
__device__ __forceinline__ void ssd_sample_item(Frame& F, int bs, int h) {
    LAS unsigned char* L = F.lds + RING_OFF;
    int tid = F.tid; asm volatile("" : "+v"(tid));
    const int lane = tid & 63, wid = F.wave, r32 = lane & 31, hh = lane >> 5;
    const int pt = wid >> 2, q = wid & 3, g = h >> 2, row0 = MP + bs * SEQ_S;
    const float Dh = F.d_skip[h];
    bf16x8 Id[2];
#pragma unroll
    for (int ks = 0; ks < 2; ++ks)
#pragma unroll
        for (int e = 0; e < 8; ++e) Id[ks][e] = (16 * ks + 8 * hh + e == r32) ? (short)0x3F80 : (short)0;
    const v4u zero4 = (v4u){0u, 0u, 0u, 0u};
    v4u pB = zero4, pC = zero4, pX = zero4; float pd = 0.f, pa = 0.f;
    { const int row = tid >> 4, ch = tid & 15; if (row < SEQ_S) { const bf16* xr = F.xbcc + (size_t)(row0 + row) * XBC; pB = *(const v4u*)(xr + 1024 + g * NS + ch * 8); pC = *(const v4u*)(xr + 1536 + g * NS + ch * 8); } }
    { const int row = tid >> 3, ch = tid & 7; if (tid < 256 && row < SEQ_S) pX = *(const v4u*)(F.xbcc + (size_t)(row0 + row) * XBC + h * HP + ch * 8); }
    if (wid == 0 && lane < SEQ_S) { const float* dp = F.dtb + (size_t)(row0 + lane) * 32 + h; pd = dp[0]; pa = dp[16]; }
    f32x16 S;
    { const float* sp = F.st_ssm + (((size_t)bs * NH + h) * HP + 32 * pt + r32) * NS + 32 * q + 4 * hh;
#pragma unroll
        for (int rg = 0; rg < 4; ++rg) { const f32x4 v = *(const f32x4*)(sp + 8 * rg); S[4 * rg] = v.x; S[4 * rg + 1] = v.y; S[4 * rg + 2] = v.z; S[4 * rg + 3] = v.w; } }
    { const int row = tid >> 4, ch = tid & 15; *(LAS v4u*)(L + L_BS + row * SB_STRIDE + ch * 16) = pB; *(LAS v4u*)(L + L_CS + row * SB_STRIDE + ch * 16) = pC; }
    if (tid < 256) { const int row = tid >> 3, ch = tid & 7; *(LAS v4u*)(L + L_XS + row * SX_STRIDE + ch * 16) = pX; }
    if (wid == 0) {
        float pfx = pa;
#pragma unroll
        for (int o = 1; o < 64; o <<= 1) { const float t = __shfl_up(pfx, o); if (lane >= o) pfx += t; }
        const float cend = __shfl(pfx, 63);
        if (lane < 32) { *(LAS float*)(L + L_A2 + lane * 4) = pfx; *(LAS float*)(L + L_LA2 + lane * 4) = pfx - __log2f(pd); *(LAS float*)(L + L_WL + lane * 4) = pd * __builtin_amdgcn_exp2f(cend - pfx); }
    }
    { bf16x8 sf[2]; pack_tile(S, sf);
#pragma unroll
        for (int s = 0; s < 2; ++s) *(LAS bf16x8*)(L + L_SB + ((q * 2 + pt) * 2 + s) * 1024 + lane * 16) = sf[s]; }
    LDS_WAIT(); __syncthreads();
    const float a2end = *(LAS float*)(L + L_A2 + 31 * 4);
#define SSD_T1S(dst) do { f32x16 acc_; _Pragma("unroll") for (int e = 0; e < 16; ++e) acc_[e] = 0.f; \
        _Pragma("unroll") for (int ks = 0; ks < 2; ++ks) { const bf16x8 a_ = *(const LAS bf16x8*)(L + L_XS + r32 * SX_STRIDE + (32 * pt + 16 * ks + 8 * hh) * 2); \
            acc_ = __builtin_amdgcn_mfma_f32_32x32x16_bf16(a_, Id[ks], acc_, 0, 0, 0); } \
        pack_tile(acc_, dst); } while (0)
    bf16x8 t1[2]; SSD_T1S(t1);
    if (q == 0) {
        const int lrow = r32; const float a2l = *(LAS float*)(L + L_A2 + lrow * 4);
        f32x16 Y;
#pragma unroll
        for (int e = 0; e < 16; ++e) Y[e] = 0.f;
#pragma unroll
        for (int qq = 0; qq < 4; ++qq)
#pragma unroll
            for (int s = 0; s < 2; ++s) { const bf16x8 a = *(const LAS bf16x8*)(L + L_SB + ((qq * 2 + pt) * 2 + s) * 1024 + lane * 16);
                const LAS unsigned char* cp = L + L_CS + lrow * SB_STRIDE + (32 * qq + 16 * s + 4 * hh) * 2;
                const v2u c0 = *(const LAS v2u*)cp, c1 = *(const LAS v2u*)(cp + 16);
                const bf16x8 bb = __builtin_bit_cast(bf16x8, ((v4u){c0.x, c0.y, c1.x, c1.y}));
                Y = __builtin_amdgcn_mfma_f32_32x32x16_bf16(a, bb, Y, 0, 0, 0); }
        { const float el = __builtin_amdgcn_exp2f(a2l);
#pragma unroll
            for (int e = 0; e < 16; ++e) Y[e] *= el; }
        f32x16 X;
#pragma unroll
        for (int e = 0; e < 16; ++e) X[e] = 0.f;
#pragma unroll
        for (int ks = 0; ks < 8; ++ks) { const bf16x8 a = *(const LAS bf16x8*)(L + L_BS + r32 * SB_STRIDE + (16 * ks + 8 * hh) * 2);
            const bf16x8 bb = *(const LAS bf16x8*)(L + L_CS + lrow * SB_STRIDE + (16 * ks + 8 * hh) * 2);
            X = __builtin_amdgcn_mfma_f32_32x32x16_bf16(a, bb, X, 0, 0, 0); }
#pragma unroll
        for (int rg = 0; rg < 4; ++rg) { const int sb = 8 * rg + 4 * hh; const f32x4 la = *(const LAS f32x4*)(L + L_LA2 + sb * 4);
#pragma unroll
            for (int e = 0; e < 4; ++e) { const int s = sb + e; float v = X[4 * rg + e] * __builtin_amdgcn_exp2f(a2l - la[e]); v = (s <= lrow && s < SEQ_S) ? v : 0.f; v += (s == lrow) ? Dh : 0.f; X[4 * rg + e] = v; } }
        bf16x8 xf[2]; pack_tile(X, xf);
#pragma unroll
        for (int s = 0; s < 2; ++s) Y = __builtin_amdgcn_mfma_f32_32x32x16_bf16(t1[s], xf[s], Y, 0, 0, 0);
        if (lrow < SEQ_S) { bf16* yrow = F.proj + (size_t)(row0 + lrow) * PROJ_LD + C_Y + h * HP + 32 * pt + 4 * hh;
#pragma unroll
            for (int rg = 0; rg < 4; ++rg) { v2u o; o.x = pk2(Y[4 * rg], Y[4 * rg + 1]); o.y = pk2(Y[4 * rg + 2], Y[4 * rg + 3]); *(v2u*)(yrow + 8 * rg) = o; } }
    }
    { const float dec = __builtin_amdgcn_exp2f(a2end);
#pragma unroll
        for (int e = 0; e < 16; ++e) S[e] *= dec; }
    { f32x16 acc;
#pragma unroll
        for (int e = 0; e < 16; ++e) acc[e] = 0.f;
#pragma unroll
        for (int ks = 0; ks < 2; ++ks) { const bf16x8 a = *(const LAS bf16x8*)(L + L_BS + r32 * SB_STRIDE + (32 * q + 16 * ks + 8 * hh) * 2);
            acc = __builtin_amdgcn_mfma_f32_32x32x16_bf16(a, Id[ks], acc, 0, 0, 0); }
#pragma unroll
        for (int rg = 0; rg < 4; ++rg) { const int sb = 8 * rg + 4 * hh; const f32x4 wl = *(const LAS f32x4*)(L + L_WL + sb * 4);
#pragma unroll
            for (int e = 0; e < 4; ++e) acc[4 * rg + e] *= wl[e]; }
        bf16x8 t2[2]; pack_tile(acc, t2);
#pragma unroll
        for (int s = 0; s < 2; ++s) S = __builtin_amdgcn_mfma_f32_32x32x16_bf16(t2[s], t1[s], S, 0, 0, 0); }
    { float* op = F.out + O_SSMS + (((size_t)bs * NH + h) * HP + 32 * pt + r32) * NS + 32 * q + 4 * hh;
#pragma unroll
        for (int rg = 0; rg < 4; ++rg) *(f32x4*)(op + 8 * rg) = (f32x4){S[4 * rg], S[4 * rg + 1], S[4 * rg + 2], S[4 * rg + 3]}; }
    LDS_WAIT(); __syncthreads();
#undef SSD_T1S
}
__device__ __forceinline__ void p4_scan(Frame& F) {
    const int np = (F.G >= 256) ? 128 : F.G;
    if ((int)blockIdx.x < np) for (int it = blockIdx.x; it < BATCH_P * NH; it += np) ssd_prompt_item(F, it / NH, it % NH);
    gu32* ctr = F.ctl + CW_SCAN;
    for (;;) {
        __syncthreads();
        if (F.tid == 0) F.MISC[16] = __hip_atomic_fetch_add(ctr, 4u, RLX_AGENT);
        __syncthreads();
        const int base = (int)F.MISC[16];
        if (base >= BATCH_S * NH) break;
#pragma unroll 1
        for (int k = 0; k < 4; ++k) { const int it = base + k; if (it < BATCH_S * NH) ssd_sample_item(F, it / NH, it % NH); }
    }
    constexpr int T_SC = (M / 4) * 128 / 4096, T_LW = LW_ITEMS / 32, NT = T_SC + T_LW;
    static_assert((M / 4) * 128 % 4096 == 0 && LW_ITEMS % 32 == 0, "task sizes");
    for (;;) {
        __syncthreads();
        if (F.tid == 0) F.MISC[16] = __hip_atomic_fetch_add(F.ctl + CW_TASK, 1u, RLX_AGENT);
        __syncthreads();
        const int t = (int)F.MISC[16];
        if (t >= NT) break;
        if (t < T_SC) {
#pragma unroll 1
            for (int k = 0; k < 8; ++k) { const int idx = t * 4096 + k * NTHREADS + F.tid; sc_conv_item(F, idx >> 7, idx & 127); } }
        else { LAS float* scr = (LAS float*)(F.lds + RING_OFF + F.wave * 16384);
#pragma unroll 1
            for (int k = 0; k < 4; ++k) late_weight_item(F, (t - T_SC) * 32 + k * NWAVES + F.wave, scr); }
    }
}
__device__ __forceinline__ void p5_gatenorm(Frame& F) {
    const int gw = blockIdx.x * NWAVES + F.wave, NGW = F.G * NWAVES; constexpr int R5 = 8;
    for (int it0 = gw; it0 < M * NG; it0 += R5 * NGW) {
        v2u yq[R5], zq[R5];
#pragma unroll
        for (int r = 0; r < R5; ++r) { int it = it0 + r * NGW; it = it < M * NG ? it : it0; const bf16* prow = F.proj + (size_t)(it >> 2) * PROJ_LD; const int c = (it & 3) * 256 + 4 * F.lane;
            yq[r] = *(const v2u*)(prow + C_Y + c); zq[r] = *(const v2u*)(prow + C_Z + c); }
        asm volatile("" ::: "memory");
#pragma unroll
        for (int r = 0; r < R5; ++r) { int it = it0 + r * NGW; it = it < M * NG ? it : it0; bf16* prow = F.proj + (size_t)(it >> 2) * PROJ_LD; const int c = (it & 3) * 256 + 4 * F.lane;
            float v[4]; v[0] = bflo(yq[r].x) * silu_f(bflo(zq[r].x)); v[1] = bfhi(yq[r].x) * silu_f(bfhi(zq[r].x)); v[2] = bflo(yq[r].y) * silu_f(bflo(zq[r].y)); v[3] = bfhi(yq[r].y) * silu_f(bfhi(zq[r].y));
            const float ss = wave_sum((v[0] * v[0] + v[1] * v[1]) + (v[2] * v[2] + v[3] * v[3]));
            const float rstd = 1.0f / sqrtf(ss * (1.f / 256.f) + EPS); const f32x4 gg = *(const f32x4*)(F.ssm_g + c);
            v2u o; o.x = pk2(v[0] * rstd * gg.x, v[1] * rstd * gg.y); o.y = pk2(v[2] * rstd * gg.z, v[3] * rstd * gg.w);
            *(v2u*)(prow + C_SCC + c) = o; }
    }
}
__device__ __forceinline__ void ld_bf16_row(const bf16* __restrict__ row, int lane, Vec16& o) {
    const v2u* r = (const v2u*)row + lane; v2u q[4];
#pragma unroll
    for (int j = 0; j < 4; ++j) q[j] = r[64 * j];
#pragma unroll
    for (int j = 0; j < 4; ++j) o.v[j] = (f32x4){bflo(q[j].x), bfhi(q[j].x), bflo(q[j].y), bfhi(q[j].y)};
}
template <int NSL> __device__ __forceinline__ void ld_slab_rows(const float* __restrict__ ps, int ld, int r0, int lane, Vec16 (&v)[4]) {
#pragma unroll
    for (int rp = 0; rp < 4; rp += 2) {
        ldvec(ps + (size_t)(r0 + rp) * ld, lane, v[rp]); ldvec(ps + (size_t)(r0 + rp + 1) * ld, lane, v[rp + 1]);
        for (int s = 1; s < NSL; ++s) { Vec16 t0, t1;
            ldvec(ps + (size_t)(s * MS + r0 + rp) * ld, lane, t0); ldvec(ps + (size_t)(s * MS + r0 + rp + 1) * ld, lane, t1);
#pragma unroll
            for (int j = 0; j < 4; ++j) { v[rp].v[j] += t0.v[j]; v[rp + 1].v[j] += t1.v[j]; } } }
}
__device__ __forceinline__ void p7_rows(Frame& F) {
    const int gw = blockIdx.x * NWAVES + F.wave, NGW = F.G * NWAVES;
    for (int gi = gw; gi < NGRP; gi += NGW) {
        const int m0 = 4 * gi; const float* md = F.mod + (size_t)seq_of(m0) * 6144;
        Vec16 mx[4], x[4], gt, g;
        if (m0 < MP) {
#pragma unroll
            for (int r = 0; r < 4; ++r) ld_bf16_row((const bf16*)F.x1 + (size_t)(m0 + r) * 2 * D, F.lane, mx[r]);
        } else ld_slab_rows<8>(F.slab6, PROJ_LD / 2, m0 - MP, F.lane, mx);
#pragma unroll
        for (int r = 0; r < 4; ++r) ldvec(x_row(F, m0 + r), F.lane, x[r]);
        ldvec(md + 2048, F.lane, gt); ldvec(F.g_mpost, F.lane, g);
        asm volatile("" ::: "memory");
#pragma unroll
        for (int r = 0; r < 4; ++r) { const float rstd = 1.0f / sqrtf(wave_sum(sumsq16(mx[r])) * (1.f / D) + EPS);
#pragma unroll
            for (int j = 0; j < 4; ++j) x[r].v[j] = x[r].v[j] + gt.v[j] * ((mx[r].v[j] * rstd) * g.v[j]); }
        Vec16 sh, sc; ldvec(F.g_fpre, F.lane, g); ldvec(md + 3072, F.lane, sh); ldvec(md + 4096, F.lane, sc);
#pragma unroll
        for (int r = 0; r < 4; ++r) { f32x4* mr = (f32x4*)(F.x1 + (size_t)(m0 + r) * D) + F.lane;
#pragma unroll
            for (int j = 0; j < 4; ++j) mr[64 * j] = x[r].v[j]; }
#pragma unroll
        for (int r = 0; r < 4; ++r) { const float rstd2 = 1.0f / sqrtf(wave_sum(sumsq16(x[r])) * (1.f / D) + EPS); Vec16 h;
#pragma unroll
            for (int j = 0; j < 4; ++j) h.v[j] = (x[r].v[j] * rstd2) * g.v[j] * (sc.v[j] + 1.0f) + sh.v[j];
            st_bf16_row(F.xn2 + (size_t)(m0 + r) * D, F.lane, h); }
    }
}
__device__ __forceinline__ void p10_rows(Frame& F) {
    const int gw = blockIdx.x * NWAVES + F.wave, NGW = F.G * NWAVES;
    Vec16 g; ldvec(F.g_fpost, F.lane, g);
    for (int gi = gw; gi < NGRP; gi += NGW) {
        const int m0 = 4 * gi; const float* md = F.mod + (size_t)seq_of(m0) * 6144;
        Vec16 fv[4], x[4], gt;
        if (m0 < MP) {
#pragma unroll
            for (int r = 0; r < 4; ++r) ld_bf16_row(F.fbuf + (size_t)(m0 + r) * D, F.lane, fv[r]);
        } else ld_slab_rows<11>(F.slab9, D, m0 - MP, F.lane, fv);
#pragma unroll
        for (int r = 0; r < 4; ++r) ldvec(F.out + (size_t)(m0 + r) * D, F.lane, x[r]);
        ldvec(md + 5120, F.lane, gt);
        asm volatile("" ::: "memory");
#pragma unroll
        for (int r = 0; r < 4; ++r) { const float rstd = 1.0f / sqrtf(wave_sum(sumsq16(fv[r])) * (1.f / D) + EPS); f32x4* yr = (f32x4*)(F.out + (size_t)(m0 + r) * D) + F.lane;
#pragma unroll
            for (int j = 0; j < 4; ++j) yr[64 * j] = x[r].v[j] + gt.v[j] * ((fv[r].v[j] * rstd) * g.v[j]); }
    }
}

constexpr int NPHASE = 11;
#ifndef MK_ONE_LAUNCH
#define MK_ONE_LAUNCH 1
#endif
__global__ void __launch_bounds__(NTHREADS, 2) hymba_fwd(Args args) {
    extern __shared__ __attribute__((aligned(16))) unsigned char lds[];
    Frame F;
    F.lds = (LAS unsigned char*)lds;
    F.MISC = (volatile LAS unsigned*)(F.lds + MISC_OFF);
    F.tid = threadIdx.x; F.lane = F.tid & 63; F.wave = __builtin_amdgcn_readfirstlane(F.tid >> 6);
    F.G = gridDim.x;
    unsigned char* ws = args.ws;
    F.ctl = (gu32*)(ws + WS_CTL);
    F.x_p = args.in[0]; F.x_s = args.in[1]; F.c_p = args.in[2]; F.c_s = args.in[3]; F.st_sc = args.in[4]; F.st_cv = args.in[5]; F.st_ssm = args.in[6];
    F.w_ada = args.in[7]; F.b_ada = args.in[8]; F.g_mpre = args.in[9]; F.g_mpost = args.in[10]; F.g_fpre = args.in[11]; F.g_fpost = args.in[12];
    F.w_in = args.in[13]; F.sc_w = args.in[14]; F.cv_w = args.in[15]; F.cv_b = args.in[16]; F.dt_bias = args.in[17]; F.a_log = args.in[18]; F.d_skip = args.in[19];
    F.ssm_g = args.in[20]; F.w_out = args.in[21]; F.w_gate = args.in[22]; F.w_up = args.in[23]; F.w_down = args.in[24];
    F.out = args.out;
    F.mod = (float*)(ws + WS_MOD); F.Win_t = (bf16*)(ws + WS_WIN); F.Wout_t = (bf16*)(ws + WS_WOUT); F.Wgu_t = (bf16*)(ws + WS_WGU); F.Wd_t = (bf16*)(ws + WS_WD);
    F.dtb = (float*)(ws + WS_DT); F.proj = (bf16*)(ws + WS_PROJ); F.act = (bf16*)(ws + WS_ACT); F.xn2 = (bf16*)(ws + WS_XN2); F.fbuf = (bf16*)(ws + WS_F); F.slab6 = (float*)(F.proj + C_XBC); F.slab9 = (float*)(ws + WS_SLAB9);
    F.xn1 = (bf16*)(args.out + O_Y); F.xbcc = (bf16*)(args.out + O_Y); F.x1 = args.out + O_Y;
    for (int u = F.tid; u < (LDS_BYTES - LDSCTL_OFF) / 4; u += NTHREADS) ((LAS unsigned*)(F.lds + LDSCTL_OFF))[u] = 0u;
    __syncthreads();
    XcdBarrier bar; bar.bar = (unsigned*)(F.ctl + CW_BAR); bar.x = 0; bar.st = nullptr;
    const int lo = args.ph_lo, hi = args.ph_hi;
    if (hi - lo > 1) bar = xcd_barrier_post((unsigned*)(F.ctl + CW_BAR), F.MISC + 8);
#define IN(k) (lo <= (k) && (k) < hi)
#define SEAM(k) do { if (IN(k) && IN((k) + 1)) xcd_barrier(bar); } while (0)

    if (IN(0)) { p0_prologue(F); } SEAM(0);
    if (IN(1)) { p1_hrows(F); } SEAM(1);
    if (IN(2)) {
        pg8::Gemm g{F.xn1, F.Win_t, M, NPROJ_PAD, D, D, D}; pg8::StaticOrder S; S.init(M, NPROJ_PAD, F.G, (int)blockIdx.x);
        pg8::EpiProj E{F.proj, PROJ_LD, F.dtb, PROJ_LD / 256, F.dt_bias, F.a_log};
        pg8::gemm_phase<pg8::EpiProj, pg8::StaticOrder, true, true>(F.lds + RING_OFF, g, S, E);
    } SEAM(2);
    if (IN(3)) { p3_conv(F); } SEAM(3);
    if (IN(4)) { p4_scan(F); } SEAM(4);
    if (IN(5)) { p5_gatenorm(F); } SEAM(5);
    if (IN(6)) {
        { pg8::Gemm g{F.proj, F.Wout_t, MP, D, 2048, PROJ_LD, 2048}; pg8::StaticOrder S; S.init(MP, D, F.G, (int)blockIdx.x);
          pg8::EpiBf16Plain E{(bf16*)F.x1, 2 * D};
          pg8::gemm_phase<pg8::EpiBf16Plain, pg8::StaticOrder, true, true>(F.lds + RING_OFF, g, S, E); }
        { int kl = 256; asm volatile("" : "+s"(kl));
          pg8::Gemm g{F.proj, F.Wout_t, M, D, 2048, PROJ_LD, kl}; typedef pg8::SplitKOrder<8, 256, MP / 256, D / 256, 16> SK; SK S{F.G, (int)blockIdx.x};
          pg8::EpiSlabF32 E{F.slab6, PROJ_LD / 2, MP / 256, 256, MS};
          pg8::gemm_phase<pg8::EpiSlabF32, SK, true, true>(F.lds + RING_OFF, g, S, E); }
    } SEAM(6);
    if (IN(7)) { p7_rows(F); } SEAM(7);
    if (IN(8)) {
        pg8::Gemm g{F.xn2, F.Wgu_t, M, NGU, D, D, D}; pg8::StaticOrder S; S.init(M, NGU, F.G, (int)blockIdx.x);
        pg8::EpiSwiGLU E{F.act, FF};
        pg8::gemm_phase<pg8::EpiSwiGLU, pg8::StaticOrder, true, true>(F.lds + RING_OFF, g, S, E);
    } SEAM(8);
    if (IN(9)) {
        { pg8::Gemm g{F.act, F.Wd_t, MP, D, FF, FF, FF}; pg8::StaticOrder S; S.init(MP, D, F.G, (int)blockIdx.x);
          pg8::EpiBf16Plain E{F.fbuf, D};
          pg8::gemm_phase<pg8::EpiBf16Plain, pg8::StaticOrder, true, true>(F.lds + RING_OFF, g, S, E); }
        { int kl = 256; asm volatile("" : "+s"(kl));
          pg8::Gemm g{F.act, F.Wd_t, M, D, FF, FF, kl}; typedef pg8::SplitKOrder<11, 256, MP / 256, D / 256, 16> SK; SK S{F.G, (int)blockIdx.x};
          pg8::EpiSlabF32 E{F.slab9, D, MP / 256, 256, MS};
          pg8::gemm_phase<pg8::EpiSlabF32, SK, true, true>(F.lds + RING_OFF, g, S, E); }
    } SEAM(9);
    if (IN(10)) { p10_rows(F); }
#undef IN
#undef SEAM
}

extern "C" void kernel_launch(void* const* d_in, const int* in_sizes, int n_in, void* d_out, int out_size, void* d_ws, size_t ws_size, hipStream_t stream) {
    static int grid = 0;
    if (grid == 0) {
        if (n_in != 25 || out_size != (int)O_END || ws_size < WS_END) { fprintf(stderr, "kernel_launch: unexpected sizes n_in %d out %d ws %zu; nothing launched\n", n_in, out_size, ws_size); grid = -1; return; }
        int dev = 0, cus = 0, per_cu = 0;
        if (hipGetDevice(&dev) != hipSuccess || hipDeviceGetAttribute(&cus, hipDeviceAttributeMultiprocessorCount, dev) != hipSuccess) { grid = -1; return; }
        if (hipFuncSetAttribute((const void*)hymba_fwd, hipFuncAttributeMaxDynamicSharedMemorySize, LDS_BYTES) != hipSuccess) { fprintf(stderr, "kernel_launch: hipFuncSetAttribute failed\n"); grid = -1; return; }
        if (hipOccupancyMaxActiveBlocksPerMultiprocessor(&per_cu, (const void*)hymba_fwd, NTHREADS, LDS_BYTES) != hipSuccess || per_cu < 1) { fprintf(stderr, "kernel_launch: occupancy query says %d\n", per_cu); per_cu = 1; }
        (void)hipGetLastError();
        grid = cus;
    }
    if (grid < 0) return;
    (void)hipMemsetAsync((char*)d_ws + WS_CTL, 0, CTL_ZERO_BYTES, stream);
    Args a{};
    for (int i = 0; i < 25; ++i) a.in[i] = (const float*)d_in[i];
    a.out = (float*)d_out; a.ws = (unsigned char*)d_ws;
#if MK_ONE_LAUNCH
    a.ph_lo = 0; a.ph_hi = NPHASE;
    hipLaunchKernelGGL(hymba_fwd, dim3(grid), dim3(NTHREADS), LDS_BYTES, stream, a);
#else
    for (int ph = 0; ph < NPHASE; ++ph) { a.ph_lo = ph; a.ph_hi = ph + 1; hipLaunchKernelGGL(hymba_fwd, dim3(grid), dim3(NTHREADS), LDS_BYTES, stream, a); }
#endif
}
```
